# Optimizing an MI355X kernel written in HIP

```python
import jax, jax.numpy as jnp
from jax import lax
import numpy as np

D_MODEL = 1024
BATCH = 8
SEQ = 4096
DEPTH = 2

EXPAND = 2
WIDTH = EXPAND * D_MODEL
HEAD_DIM = 128
A_HEADS = WIDTH // HEAD_DIM
B_HEADS = WIDTH // HEAD_DIM
N_A = DEPTH // 2
N_B = DEPTH - N_A
CHUNK = 64
Q_BLOCK = 128
EPS = 1e-6

kernel_name = "yoco_hgrn2_fox_hybrid"


def _rms(x, g):
    xf = x.astype(jnp.float32)
    y = xf * lax.rsqrt(jnp.mean(xf * xf, axis=-1, keepdims=True) + EPS)
    return (y * g.astype(jnp.float32)).astype(x.dtype)


def _ada(c, w, b):
    return jax.nn.silu(c) @ w + b


def _hgrn2(h, w_in, lb, onorm_g, w_out):
    bsz, s, _ = h.shape
    f32 = jnp.float32
    q, fz, i, g = jnp.split(h @ w_in, 4, axis=-1)
    fz = fz.astype(f32)
    logf = jnp.log(lb + (1.0 - lb) * jax.nn.sigmoid(fz))
    k = (1.0 - lb) * jax.nn.sigmoid(-fz)

    def hc(t):
        return t.reshape(bsz, s // CHUNK, CHUNK, A_HEADS, HEAD_DIM).transpose(0, 3, 1, 2, 4)

    q, k, v, logf = hc(q.astype(f32)), hc(k), hc(i.astype(f32)), hc(logf)
    b = jnp.cumsum(logf, axis=3)
    b_last = b[:, :, :, -1:, :]
    q_dec = q * jnp.exp(b)
    k_in = k * jnp.exp(-b)
    k_st = k * jnp.exp(b_last - b)
    causal = jnp.tril(jnp.ones((CHUNK, CHUNK), dtype=bool))
    att = jnp.where(causal, jnp.einsum('bhnck,bhnsk->bhncs', q_dec, k_in), 0.0)
    o_intra = jnp.einsum('bhncs,bhnsv->bhncv', att, v)

    def step(state, xs):
        qd, ks, vv, dl = xs
        o = jnp.einsum('bhck,bhkv->bhcv', qd, state)
        state = dl[..., None] * state + jnp.einsum('bhck,bhcv->bhkv', ks, vv)
        return state, o

    xs = (jnp.moveaxis(q_dec, 2, 0), jnp.moveaxis(k_st, 2, 0), jnp.moveaxis(v, 2, 0),
          jnp.moveaxis(jnp.exp(b_last[:, :, :, 0, :]), 2, 0))
    s0 = jnp.zeros((bsz, A_HEADS, HEAD_DIM, HEAD_DIM), f32)
    _, o_inter = lax.scan(step, s0, xs)
    o = o_intra + jnp.moveaxis(o_inter, 0, 2)
    o = o.transpose(0, 2, 3, 1, 4).reshape(bsz, s, A_HEADS, HEAD_DIM)
    o = _rms(o, onorm_g.reshape(A_HEADS, HEAD_DIM)).reshape(bsz, s, WIDTH).astype(h.dtype)
    return (o * jax.nn.silu(g)) @ w_out


def _shared_kv(x, c, kv_mod_w, kv_mod_b, kv_norm_g, kv_w, kv_fb, k_norm_g):
    bsz, s, _ = x.shape
    shift, scale = jnp.split(_ada(c, kv_mod_w, kv_mod_b), 2, axis=-1)
    h = _rms(x, kv_norm_g) * (1.0 + scale[:, None]) + shift[:, None]
    proj = h @ kv_w
    k = proj[..., :WIDTH].reshape(bsz, s, B_HEADS, HEAD_DIM)
    v = proj[..., WIDTH:2 * WIDTH].reshape(bsz, s, B_HEADS, HEAD_DIM)
    fl = proj[..., 2 * WIDTH:] + kv_fb
    k = _rms(k, k_norm_g).transpose(0, 2, 1, 3)
    v = v.transpose(0, 2, 1, 3)
    F = jnp.cumsum(jax.nn.log_sigmoid(fl.astype(jnp.float32)), axis=1).transpose(0, 2, 1)
    return k, v, F


def _fox(h, w_in, q_norm_g, w_out, k, v, F):
    bsz, s, _ = h.shape
    q, g = jnp.split(h @ w_in, 2, axis=-1)
    q = _rms(q.reshape(bsz, s, B_HEADS, HEAD_DIM), q_norm_g).transpose(0, 2, 1, 3)
    scale = HEAD_DIM ** -0.5
    outs = []
    for blk in range(s // Q_BLOCK):
        lo, hi = blk * Q_BLOCK, (blk + 1) * Q_BLOCK
        logits = (jnp.einsum('bhqd,bhkd->bhqk', q[:, :, lo:hi], k[:, :, :hi]).astype(jnp.float32) * scale
                  + (F[:, :, lo:hi, None] - F[:, :, None, :hi]))
        mask = (lo + jnp.arange(Q_BLOCK))[:, None] >= jnp.arange(hi)[None, :]
        p = jax.nn.softmax(jnp.where(mask, logits, -jnp.inf), axis=-1)
        outs.append(jnp.einsum('bhqk,bhkd->bhqd', p.astype(v.dtype), v[:, :, :hi]))
    o = jnp.concatenate(outs, axis=2).transpose(0, 2, 1, 3).reshape(bsz, s, WIDTH)
    return (o * jax.nn.silu(g)) @ w_out


def setup_inputs(seed: int = 0) -> dict:
    key = jax.random.key(seed)
    ks = jax.random.split(key, 20)
    n = jax.random.normal
    D, W = D_MODEL, WIDTH
    return {
        "x": n(ks[0], (BATCH, SEQ, D), jnp.float32),
        "c": n(ks[1], (BATCH, D), jnp.float32),
        "mod_w": n(ks[2], (DEPTH, D, 3 * D), jnp.float32) * (0.3 * D ** -0.5),
        "mod_b": n(ks[3], (DEPTH, 3 * D), jnp.float32) * 0.02,
        "norm_g": 1.0 + 0.02 * n(ks[4], (DEPTH, D), jnp.float32),
        "a_w_in": n(ks[5], (N_A, D, 4 * W), jnp.float32) * D ** -0.5,
        "a_lb_logits": 0.5 * n(ks[6], (N_A + 1, W), jnp.float32),
        "a_onorm_g": 1.0 + 0.02 * n(ks[7], (N_A, W), jnp.float32),
        "a_w_out": n(ks[8], (N_A, W, D), jnp.float32) * W ** -0.5,
        "kv_mod_w": n(ks[9], (D, 2 * D), jnp.float32) * (0.3 * D ** -0.5),
        "kv_mod_b": n(ks[10], (2 * D,), jnp.float32) * 0.02,
        "kv_norm_g": 1.0 + 0.02 * n(ks[11], (D,), jnp.float32),
        "kv_w": n(ks[12], (D, 2 * W + B_HEADS), jnp.float32) * D ** -0.5,
        "kv_fb": 2.0 + 0.5 * n(ks[13], (B_HEADS,), jnp.float32),
        "k_norm_g": 1.0 + 0.02 * n(ks[14], (HEAD_DIM,), jnp.float32),
        "b_w_in": n(ks[15], (N_B, D, 2 * W), jnp.float32) * D ** -0.5,
        "b_q_norm_g": 1.0 + 0.02 * n(ks[16], (N_B, HEAD_DIM), jnp.float32),
        "b_w_out": n(ks[17], (N_B, W, D), jnp.float32) * W ** -0.5,
    }


def reference(x, c, mod_w, mod_b, norm_g, a_w_in, a_lb_logits, a_onorm_g, a_w_out,
              kv_mod_w, kv_mod_b, kv_norm_g, kv_w, kv_fb, k_norm_g,
              b_w_in, b_q_norm_g, b_w_out):
    lb_all = jnp.cumsum(jax.nn.softmax(a_lb_logits.astype(jnp.float32), axis=0), axis=0)
    kv = None
    for l in range(DEPTH):
        shift, scale, gate = jnp.split(_ada(c, mod_w[l], mod_b[l]), 3, axis=-1)
        h = _rms(x, norm_g[l]) * (1.0 + scale[:, None]) + shift[:, None]
        if l < N_A:
            y = _hgrn2(h, a_w_in[l], lb_all[l], a_onorm_g[l], a_w_out[l])
        else:
            if l == N_A:
                kv = _shared_kv(x, c, kv_mod_w, kv_mod_b, kv_norm_g, kv_w, kv_fb, k_norm_g)
            j = l - N_A
            y = _fox(h, b_w_in[j], b_q_norm_g[j], b_w_out[j], *kv)
        x = x + gate[:, None] * y
    return x
```

```cpp
#include <hip/hip_runtime.h>
#include <hip/hip_cooperative_groups.h>
#include <cstdio>
#include <cstdint>
namespace cg = cooperative_groups;

#define LAS __attribute__((address_space(3)))
typedef unsigned short bf16_t;
typedef short bf16x8 __attribute__((ext_vector_type(8)));
typedef short s16x4 __attribute__((ext_vector_type(4)));
typedef float f32x4 __attribute__((ext_vector_type(4)));
typedef float f32x16 __attribute__((ext_vector_type(16)));
typedef unsigned u32x4 __attribute__((ext_vector_type(4)));
typedef unsigned u32x2 __attribute__((ext_vector_type(2)));

constexpr int NB = 8, SEQ = 4096, DM = 1024, WD = 2048, NH = 16, HD = 128, BH = NB * NH, TOK = NB * SEQ;
constexpr float EPS = 1e-6f;
constexpr size_t MiB = 1u << 20;
constexpr size_t WS_R0 = 0, WS_R1 = 128 * MiB, WS_R2 = 256 * MiB, WS_XA = 384 * MiB;
constexpr size_t WS_W1 = 448 * MiB, WS_W2 = 464 * MiB, WS_W3KV = 468 * MiB, WS_W3Q = 476 * MiB, WS_W3G = 480 * MiB, WS_W4 = 484 * MiB;
constexpr size_t WS_SM = 488 * MiB;
constexpr size_t WS_MOD0 = WS_SM, WS_MOD1 = WS_SM + 98304, WS_KVMOD = WS_SM + 196608, WS_LB = WS_SM + 262144, WS_WFL = WS_SM + 270336;
constexpr size_t WS_LSG = WS_SM + 1 * MiB, WS_DL = WS_SM + 4 * MiB;
constexpr int LDS_BYTES = 147456;

__device__ __forceinline__ float bf2f(unsigned short h) { return __uint_as_float(((unsigned)h) << 16); }
typedef float f32x2_t __attribute__((ext_vector_type(2))); typedef __bf16 bf16x2_t __attribute__((ext_vector_type(2)));
__device__ __forceinline__ unsigned cvt_pk_bf16(float lo, float hi) { f32x2_t v = {lo, hi}; bf16x2_t b = __builtin_convertvector(v, bf16x2_t); return __builtin_bit_cast(unsigned, b); }
__device__ __forceinline__ unsigned short f2bf(float f) { return (unsigned short)(cvt_pk_bf16(f, 0.f) & 0xffffu); }
__device__ __forceinline__ float wave_sum(float v) {
#pragma unroll
    for (int o = 1; o < 64; o <<= 1) v += __shfl_xor(v, o);
    return v;
}
__device__ __forceinline__ int otid(int wv) { int t = wv * 64 + (int)__builtin_amdgcn_mbcnt_hi(~0u, __builtin_amdgcn_mbcnt_lo(~0u, 0u)); asm volatile("" : "+v"(t)); return t; }
__device__ __forceinline__ float silu_f(float x) { return x * __builtin_amdgcn_rcpf(1.f + __builtin_amdgcn_exp2f(-1.4426950408889634f * x)); }

namespace pg8 {
constexpr int BM = 256, BK = 64, HALF = 128, HTB = HALF * BK * 2, STAGE_BYTES = 8 * HTB, NXCD = 8, WGM = 8;
__host__ __device__ __forceinline__ int lds_byte(int r, int c) { const int st = (r >> 4) * 2 + (c >> 5), rr = r & 15, cc = c & 31, ob = rr * 64 + cc * 2; return st * 1024 + (ob ^ (((ob >> 9) & 1) << 5)); }
__host__ __device__ __forceinline__ void stage_rc(int b, int& R, int& C) { const int st = b / 1024, sb = b % 1024, swz = sb ^ (((sb >> 9) & 1) << 5); R = (st >> 1) * 16 + swz / 64; C = (st & 1) * 32 + (swz % 64) / 2; }
__host__ __device__ __forceinline__ int perm32(int rho) { const int n = rho >> 4, i = rho & 15; return 8 * (i >> 2) + 4 * n + (i & 3); }

struct Unit { int pm, pn; };
struct Gemm { const bf16_t* A; const bf16_t* Bt; int M, N, K; unsigned lda; size_t hsA, bsA; };

struct StaticOrder {
    int nM, nN, nwg, G, c;
    __device__ void init(int M, int N, int G_, int c_) { nM = M / BM; nN = N / BM; nwg = nM * nN; G = G_; c = c_; }
    __device__ bool next(int i, Unit& u) const {
        const long L = (long)i * G + c; if (L >= nwg) return false;
        int wgid = (int)L; { const int q = nwg / NXCD, r = nwg % NXCD, xcd = wgid % NXCD, off = wgid / NXCD; wgid = (xcd < r ? xcd * (q + 1) : r * (q + 1) + (xcd - r) * q) + off; }
        const int nig = WGM * nN, gid = wgid / nig, fm = gid * WGM, gsz = (nM - fm) < WGM ? (nM - fm) : WGM;
        u.pm = fm + ((wgid % nig) % gsz); u.pn = (wgid % nig) / gsz; return true;
    }
};

struct EpiHead {
    bf16_t* base0; size_t tstride;
    __device__ __forceinline__ void operator()(const f32x4 (&acc)[2][2][4][2], const Unit& u, int wr, int wc, int fr, int fq) const {
        const int b = u.pm >> 4, s0 = (u.pm & 15) * 256 + wr * 64 + fr, t = u.pn >> 3, hd0 = (u.pn & 7) * 2;
        bf16_t* base = base0 + (size_t)t * tstride + wc * 32 + 8 * fq;
#pragma unroll
        for (int ai = 0; ai < 2; ++ai)
#pragma unroll
            for (int m = 0; m < 4; ++m)
#pragma unroll
                for (int bj = 0; bj < 2; ++bj) {
                    const f32x4 v0 = acc[ai][bj][m][0], v1 = acc[ai][bj][m][1];
                    u32x4 w; w.x = cvt_pk_bf16(v0[0], v0[1]); w.y = cvt_pk_bf16(v0[2], v0[3]); w.z = cvt_pk_bf16(v1[0], v1[1]); w.w = cvt_pk_bf16(v1[2], v1[3]);
                    *(u32x4*)(base + ((size_t)(b * 16 + hd0 + bj) * SEQ + s0 + ai * HALF + m * 16) * HD) = w;
                }
    }
};
struct EpiHeadNorm {
    bf16_t* base0; size_t tstride; int nnorm; const float* g; LAS float* xch;
    __device__ __forceinline__ void operator()(const f32x4 (&acc)[2][2][4][2], const Unit& u, int wr, int wc, int fr, int fq) const {
        const int b = u.pm >> 4, s0 = (u.pm & 15) * 256 + wr * 64 + fr, t = u.pn >> 3, hd0 = (u.pn & 7) * 2;
        bf16_t* base = base0 + (size_t)t * tstride + wc * 32 + 8 * fq;
        if (t < nnorm) {
#pragma unroll
            for (int ai = 0; ai < 2; ++ai)
#pragma unroll
                for (int m = 0; m < 4; ++m)
#pragma unroll
                    for (int bj = 0; bj < 2; ++bj) { const f32x4 v0 = acc[ai][bj][m][0], v1 = acc[ai][bj][m][1];
                        float sq = ((v0[0] * v0[0] + v0[1] * v0[1]) + (v0[2] * v0[2] + v0[3] * v0[3])) + ((v1[0] * v1[0] + v1[1] * v1[1]) + (v1[2] * v1[2] + v1[3] * v1[3]));
                        sq += __shfl_xor(sq, 16); sq += __shfl_xor(sq, 32);
                        if (fq == 0) xch[((ai * HALF + wr * 64 + m * 16 + fr) * 2 + bj) * 4 + wc] = sq; }
            asm volatile("s_waitcnt lgkmcnt(0)" ::: "memory"); __builtin_amdgcn_s_barrier(); asm volatile("" ::: "memory");
            const f32x4 g0 = *(const f32x4*)(g + wc * 32 + 8 * fq), g1 = *(const f32x4*)(g + wc * 32 + 8 * fq + 4);
#pragma unroll
            for (int ai = 0; ai < 2; ++ai)
#pragma unroll
                for (int m = 0; m < 4; ++m)
#pragma unroll
                    for (int bj = 0; bj < 2; ++bj) {
                        const f32x4 p = *(const LAS f32x4*)(xch + ((ai * HALF + wr * 64 + m * 16 + fr) * 2 + bj) * 4);
                        const float rs = __builtin_amdgcn_rsqf(((p[0] + p[1]) + (p[2] + p[3])) * (1.f / 128.f) + EPS);
                        const f32x4 v0 = acc[ai][bj][m][0] * g0 * rs, v1 = acc[ai][bj][m][1] * g1 * rs;
                        u32x4 w; w.x = cvt_pk_bf16(v0[0], v0[1]); w.y = cvt_pk_bf16(v0[2], v0[3]); w.z = cvt_pk_bf16(v1[0], v1[1]); w.w = cvt_pk_bf16(v1[2], v1[3]);
                        *(u32x4*)(base + ((size_t)(b * 16 + hd0 + bj) * SEQ + s0 + ai * HALF + m * 16) * HD) = w;
                    }
        } else {
#pragma unroll
            for (int ai = 0; ai < 2; ++ai)
#pragma unroll
                for (int m = 0; m < 4; ++m)
#pragma unroll
                    for (int bj = 0; bj < 2; ++bj) {
                        const f32x4 v0 = acc[ai][bj][m][0], v1 = acc[ai][bj][m][1];
                        u32x4 w; w.x = cvt_pk_bf16(v0[0], v0[1]); w.y = cvt_pk_bf16(v0[2], v0[3]); w.z = cvt_pk_bf16(v1[0], v1[1]); w.w = cvt_pk_bf16(v1[2], v1[3]);
                        *(u32x4*)(base + ((size_t)(b * 16 + hd0 + bj) * SEQ + s0 + ai * HALF + m * 16) * HD) = w;
                    }
        }
    }
};
struct EpiMulSilu {
    bf16_t* X;
    __device__ __forceinline__ void operator()(const f32x4 (&acc)[2][2][4][2], const Unit& u, int wr, int wc, int fr, int fq) const {
        const int b = u.pm >> 4, s0 = (u.pm & 15) * 256 + wr * 64 + fr, hd0 = (u.pn & 7) * 2;
        bf16_t* base = X + wc * 32 + 8 * fq;
        u32x4 pre[2][2];
#define EM_PTR(bt, bj) ((u32x4*)(base + ((size_t)(b * 16 + hd0 + (bj)) * SEQ + s0 + ((bt) >> 2) * HALF + ((bt) & 3) * 16) * HD))
        pre[0][0] = *EM_PTR(0, 0); pre[0][1] = *EM_PTR(0, 1);
#pragma unroll
        for (int bt = 0; bt < 8; ++bt) {
            if (bt + 1 < 8) { pre[(bt + 1) & 1][0] = *EM_PTR(bt + 1, 0); pre[(bt + 1) & 1][1] = *EM_PTR(bt + 1, 1); }
            asm volatile("" ::: "memory");
#pragma unroll
            for (int bj = 0; bj < 2; ++bj) {
                const u32x4 x = pre[bt & 1][bj]; const f32x4 v0 = acc[bt >> 2][bj][bt & 3][0], v1 = acc[bt >> 2][bj][bt & 3][1];
                u32x4 w;
                w.x = cvt_pk_bf16(__uint_as_float(x.x << 16) * silu_f(v0[0]), __uint_as_float(x.x & 0xffff0000u) * silu_f(v0[1]));
                w.y = cvt_pk_bf16(__uint_as_float(x.y << 16) * silu_f(v0[2]), __uint_as_float(x.y & 0xffff0000u) * silu_f(v0[3]));
                w.z = cvt_pk_bf16(__uint_as_float(x.z << 16) * silu_f(v1[0]), __uint_as_float(x.z & 0xffff0000u) * silu_f(v1[1]));
                w.w = cvt_pk_bf16(__uint_as_float(x.w << 16) * silu_f(v1[2]), __uint_as_float(x.w & 0xffff0000u) * silu_f(v1[3]));
                *EM_PTR(bt, bj) = w;
            }
            asm volatile("" ::: "memory");
        }
#undef EM_PTR
    }
};
struct EpiRes {
    const float* base; float* out; const float* gate;
    __device__ __forceinline__ void operator()(const f32x4 (&acc)[2][2][4][2], const Unit& u, int wr, int wc, int fr, int fq) const {
        const int b = u.pm >> 4, row0 = u.pm * BM + wr * 64 + fr, col0 = u.pn * BM + wc * 32 + 8 * fq;
        f32x4 gv[2][2];
#pragma unroll
        for (int bj = 0; bj < 2; ++bj)
#pragma unroll
            for (int n = 0; n < 2; ++n) gv[bj][n] = *(const f32x4*)(gate + (size_t)b * 3072 + col0 + bj * HALF + 4 * n);
        f32x4 pre[2][2][2][2];
#define ER_OFF(bt, mm) ((size_t)(row0 + ((bt) >> 1) * HALF + (2 * ((bt) & 1) + (mm)) * 16) * DM + col0)
#define ER_LOAD(bt, sl) do { _Pragma("unroll") for (int mm = 0; mm < 2; ++mm) _Pragma("unroll") for (int bj = 0; bj < 2; ++bj) _Pragma("unroll") for (int n = 0; n < 2; ++n) \
            pre[sl][mm][bj][n] = *(const f32x4*)(base + ER_OFF(bt, mm) + bj * HALF + 4 * n); } while (0)
        ER_LOAD(0, 0);
#pragma unroll
        for (int bt = 0; bt < 4; ++bt) {
            if (bt + 1 < 4) { if (bt & 1) ER_LOAD(bt + 1, 0); else ER_LOAD(bt + 1, 1); }
            asm volatile("" ::: "memory");
#pragma unroll
            for (int mm = 0; mm < 2; ++mm)
#pragma unroll
                for (int bj = 0; bj < 2; ++bj)
#pragma unroll
                    for (int n = 0; n < 2; ++n)
                        *(f32x4*)(out + ER_OFF(bt, mm) + bj * HALF + 4 * n) = pre[bt & 1][mm][bj][n] + gv[bj][n] * acc[bt >> 1][bj][2 * (bt & 1) + mm][n];
            asm volatile("" ::: "memory");
        }
#undef ER_OFF
#undef ER_LOAD
    }
};

template <class Epi, class Sched>
__device__ __forceinline__ void gemm_phase(LAS unsigned char* lds, const Gemm g, const Sched& S, const Epi& E, int wv) {
    const int tid = otid(wv), wid = __builtin_amdgcn_readfirstlane(tid >> 6), lane = tid & 63, wr = wid >> 2, wc = wid & 3, fr = lane & 15, fq = lane >> 4;
    const int K = g.K, nt = K / BK;
    unsigned voffA[2], voffB[2];
#pragma unroll
    for (int i = 0; i < 2; ++i) { int R, C; stage_rc(tid * 16 + i * 8192, R, C); const int Rb = (R & ~31) + perm32(R & 31);
        voffA[i] = (unsigned)R * g.lda + (unsigned)C * 2u; voffB[i] = (unsigned)(Rb * K + C) * 2u; }
    const size_t kstep = (size_t)(BK * 2);
    const size_t hstepA = (size_t)HALF * g.lda, hstepB = (size_t)HALF * K * 2, tstepB = 2 * hstepB, hsA = g.hsA;
    const unsigned ldsw = (unsigned)wid * 1024u;
    const int aoff = lds_byte(wr * 64 + fr, fq * 8), boff = lds_byte(wc * 32 + fr, fq * 8);
#define PG8_SA(b, h) (((b) * 2 + (h)) * HTB)
#define PG8_SB(b, h) ((4 + (b) * 2 + (h)) * HTB)
#define PG8_STAGE(bufoff, gbase, voff) do { _Pragma("unroll") for (int _i = 0; _i < 2; ++_i) \
        __builtin_amdgcn_global_load_lds((const unsigned*)((const char*)(gbase) + (voff)[_i]), (LAS unsigned*)(lds + (bufoff) + ldsw + _i * 8192), 16, 0, 0); } while (0)
#define PG8_LDA(dst, b, h) do { _Pragma("unroll") for (int m = 0; m < 4; ++m) _Pragma("unroll") for (int k = 0; k < 2; ++k) dst[m][k] = *(const LAS bf16x8*)(lds + PG8_SA(b, h) + aoff + m * 2048 + k * 1024); } while (0)
#define PG8_LDB(dst, b, h) do { _Pragma("unroll") for (int n = 0; n < 2; ++n) _Pragma("unroll") for (int k = 0; k < 2; ++k) dst[n][k] = *(const LAS bf16x8*)(lds + PG8_SB(b, h) + boff + n * 2048 + k * 1024); } while (0)
#define PG8_MMA(ai, bj, At, Bt) do { __builtin_amdgcn_s_setprio(1); _Pragma("unroll") for (int m = 0; m < 4; ++m) _Pragma("unroll") for (int n = 0; n < 2; ++n) _Pragma("unroll") for (int k = 0; k < 2; ++k) \
        acc[ai][bj][m][n] = __builtin_amdgcn_mfma_f32_16x16x32_bf16(Bt[n][k], At[m][k], acc[ai][bj][m][n], 0, 0, 0); __builtin_amdgcn_s_setprio(0); } while (0)
#define PG8_WAIT_V(n) asm volatile("s_waitcnt vmcnt(" #n ")" ::: "memory")
#define PG8_WAIT_L(n) asm volatile("s_waitcnt lgkmcnt(" #n ")" ::: "memory")
#define PG8_BAR __builtin_amdgcn_s_barrier()
#define PG8_SCHED __builtin_amdgcn_sched_barrier(0)
#define PG8_ATILE(u) ((const char*)g.A + (size_t)((u).pm >> 4) * g.bsA + (size_t)((u).pm & 15) * 256 * g.lda)
    Unit cur, nxt; int ui = 0;
    if (!S.next(0, cur)) return;
    f32x4 acc[2][2][4][2];
#pragma unroll
    for (int a = 0; a < 2; ++a)
#pragma unroll
        for (int b = 0; b < 2; ++b)
#pragma unroll
            for (int m = 0; m < 4; ++m)
#pragma unroll
                for (int n = 0; n < 2; ++n) acc[a][b][m][n] = (f32x4){0.f, 0.f, 0.f, 0.f};
    bf16x8 At[4][2], B0[2][2], B1[2][2];
    const char* cA = PG8_ATILE(cur); const char* cB = (const char*)g.Bt + (size_t)cur.pn * tstepB;
    PG8_STAGE(PG8_SB(0, 0), cB, voffB); PG8_STAGE(PG8_SB(0, 1), cB + hstepB, voffB); PG8_STAGE(PG8_SA(0, 0), cA, voffA); PG8_STAGE(PG8_SA(0, 1), cA + hstepA, voffA);
    if (wr == 1) PG8_BAR;
    PG8_WAIT_V(2); PG8_BAR;
    PG8_STAGE(PG8_SB(1, 0), cB + kstep, voffB); PG8_STAGE(PG8_SA(1, 0), cA + kstep, voffA); PG8_STAGE(PG8_SB(1, 1), cB + hstepB + kstep, voffB);
    PG8_WAIT_V(6); PG8_BAR;
    for (;;) {
        const bool has_next = S.next(ui + 1, nxt);
        const char* nA = has_next ? PG8_ATILE(nxt) : cA; const char* nB = has_next ? (const char*)g.Bt + (size_t)nxt.pn * tstepB : cB;
        for (int t = 0; t < nt; t += 2) {
            const bool last = (t == nt - 2);
            const char* a1 = cA + (size_t)(t >> 1) * hsA + kstep;
            const char* a2 = last ? nA : cA + (size_t)((t >> 1) + 1) * hsA; const char* b2 = last ? nB : cB + (size_t)(t + 2) * kstep;
            const char* a3 = a2 + kstep; const char* b3 = b2 + kstep;
            PG8_LDB(B0, 0, 0); PG8_LDB(B1, 0, 1); PG8_SCHED; PG8_LDA(At, 0, 0); PG8_STAGE(PG8_SA(1, 1), a1 + hstepA, voffA);
            PG8_WAIT_V(8); PG8_WAIT_L(0); PG8_BAR; PG8_MMA(0, 0, At, B0); PG8_MMA(0, 1, At, B1); PG8_BAR; PG8_SCHED;
            PG8_LDA(At, 0, 1); PG8_STAGE(PG8_SB(0, 0), b2, voffB); PG8_STAGE(PG8_SB(0, 1), b2 + hstepB, voffB); PG8_STAGE(PG8_SA(0, 0), a2, voffA);
            PG8_WAIT_V(8); PG8_WAIT_L(0); PG8_BAR; PG8_MMA(1, 0, At, B0); PG8_MMA(1, 1, At, B1); PG8_BAR; PG8_SCHED;
            PG8_LDB(B0, 1, 0); PG8_LDB(B1, 1, 1); PG8_SCHED; PG8_LDA(At, 1, 0); PG8_STAGE(PG8_SA(0, 1), a2 + hstepA, voffA);
            PG8_WAIT_V(8); PG8_WAIT_L(0); PG8_BAR; PG8_MMA(0, 0, At, B0); PG8_MMA(0, 1, At, B1); PG8_BAR; PG8_SCHED;
            PG8_LDA(At, 1, 1); PG8_STAGE(PG8_SB(1, 0), b3, voffB); PG8_STAGE(PG8_SB(1, 1), b3 + hstepB, voffB); PG8_STAGE(PG8_SA(1, 0), a3, voffA);
            PG8_WAIT_V(8); PG8_WAIT_L(0); PG8_BAR; PG8_MMA(1, 0, At, B0); PG8_MMA(1, 1, At, B1); PG8_BAR; PG8_SCHED;
        }
        if (wr == 0) PG8_BAR;
        E(acc, cur, wr, wc, fr, fq);
        if (!has_next) break;
#pragma unroll
        for (int a = 0; a < 2; ++a)
#pragma unroll
            for (int b = 0; b < 2; ++b)
#pragma unroll
                for (int m = 0; m < 4; ++m)
#pragma unroll
                    for (int n = 0; n < 2; ++n) acc[a][b][m][n] = (f32x4){0.f, 0.f, 0.f, 0.f};
        cur = nxt; cA = nA; cB = nB; ++ui;
        if (wr == 1) PG8_BAR;
    }
    PG8_WAIT_V(0);
    PG8_BAR;
#undef PG8_SA
#undef PG8_SB
#undef PG8_STAGE
#undef PG8_LDA
#undef PG8_LDB
#undef PG8_MMA
#undef PG8_WAIT_V
#undef PG8_WAIT_L
#undef PG8_BAR
#undef PG8_SCHED
#undef PG8_ATILE
}
}

namespace att {
constexpr int D = 128, NW = 8, QBLK = 32, KVBLK = 64, QB = NW * QBLK;
constexpr int SHM_V = KVBLK * D * 2, SHM_K = KVBLK * D * 2;
constexpr int OFF_WS = 2 * SHM_V + 2 * SHM_K, OFF_G = OFF_WS + NW * 64 * 4, ATT_LDS = OFF_G + 512;
constexpr float SCALE = 0.08838834764831845f, C2 = 1.4426950408889634f * SCALE, THR2 = 24.f;
#define KSWZ(row, colB) ((row) * 256 + ((colB) ^ (((row) & 7) << 4)))
#define SBAR() __builtin_amdgcn_sched_barrier(0)
__device__ __forceinline__ int v_st(int k, int c) { const int kk = (k & ~0xC) | ((k & 4) << 1) | ((k & 8) >> 1); return ((kk >> 3) * 4 + (c >> 5)) * 512 + ((kk & 7) * 32 + (c & 31)) * 2; }
__device__ __forceinline__ int v_rd_base(int lane) { return ((lane & 3) << 3) | (((lane >> 2) & 3) << 6) | (((lane >> 4) & 1) << 5) | (((lane >> 5) & 1) << 8); }
constexpr int v_rd_off(int d0, int ks, int half) { return d0 * 512 + ks * 4096 + half * 2048; }
__device__ __forceinline__ int crow(int r, int hi) { return (r & 3) + 8 * (r >> 2) + 4 * hi; }
__device__ __forceinline__ bf16x8 load8(const bf16_t* p) { return *reinterpret_cast<const bf16x8*>(p); }
__device__ __forceinline__ void mask_tile(f32x16& p0, f32x16& p1, int dq, unsigned W) {
    const float NEG = -__builtin_inff();
#pragma unroll
    for (int r = 0; r < 16; ++r) {
        const int c = (r & 3) + 8 * (r >> 2);
        if ((unsigned)(dq - c) >= W) p0[r] = NEG;
        if ((unsigned)(dq - c - 32) >= W) p1[r] = NEG;
    }
}
__device__ __forceinline__ void partialSM(f32x16& p0, f32x16& p1, float& m_reg, float& mn, float& alpha) {
    float pmax = p0[0];
#pragma unroll
    for (int r = 1; r < 16; ++r) pmax = fmaxf(pmax, p0[r]);
#pragma unroll
    for (int r = 0; r < 16; ++r) pmax = fmaxf(pmax, p1[r]);
    { auto rr = __builtin_amdgcn_permlane32_swap(__float_as_uint(pmax), __float_as_uint(pmax), false, false);
      pmax = fmaxf(__uint_as_float(rr[0]), __uint_as_float(rr[1])); }
    if (__builtin_expect(__all((pmax - m_reg) * C2 <= THR2), 1)) { mn = m_reg; alpha = 1.f; }
    else { mn = fmaxf(m_reg, pmax); alpha = __builtin_amdgcn_exp2f((m_reg - mn) * C2); m_reg = mn; }
    const float mnL = -mn * C2;
#pragma unroll
    for (int r = 0; r < 16; ++r) { p0[r] = fmaf(p0[r], C2, mnL); p1[r] = fmaf(p1[r], C2, mnL); }
#pragma unroll
    for (int r = 0; r < 16; ++r) p0[r] = __builtin_amdgcn_exp2f(p0[r]);
}
__device__ __forceinline__ void finishSM(f32x16& p0, f32x16& p1, float alpha, float& l_reg, bf16x8& pa0, bf16x8& pa1, bf16x8& pa2, bf16x8& pa3) {
#pragma unroll
    for (int r = 0; r < 16; ++r) p1[r] = __builtin_amdgcn_exp2f(p1[r]);
    float ps = 0;
#pragma unroll
    for (int r = 0; r < 16; ++r) ps += p0[r];
#pragma unroll
    for (int r = 0; r < 16; ++r) ps += p1[r];
    { auto rr = __builtin_amdgcn_permlane32_swap(__float_as_uint(ps), __float_as_uint(ps), false, false);
      ps = __uint_as_float(rr[0]) + __uint_as_float(rr[1]); }
    l_reg = l_reg * alpha + ps;
#define PK4(P, B_, OUT) do { unsigned a0 = cvt_pk_bf16(P[B_+0], P[B_+1]), a1 = cvt_pk_bf16(P[B_+2], P[B_+3]);                          \
        unsigned b0 = cvt_pk_bf16(P[B_+4], P[B_+5]), b1 = cvt_pk_bf16(P[B_+6], P[B_+7]);                                             \
        auto r0 = __builtin_amdgcn_permlane32_swap(a0, b0, false, false); auto r1 = __builtin_amdgcn_permlane32_swap(a1, b1, false, false); \
        u32x4 w = {r0[0], r1[0], r0[1], r1[1]}; OUT = *reinterpret_cast<bf16x8*>(&w); } while (0)
    PK4(p0, 0, pa0); PK4(p0, 8, pa1); PK4(p1, 0, pa2); PK4(p1, 8, pa3);
#undef PK4
}
template <int KB>
__device__ __forceinline__ void qkt(f32x16& p0, f32x16& p1, const char* K_lds, int r32, int hi, const bf16x8* qr, const float* gl) {
#pragma unroll
    for (int i = 0; i < 4; ++i) { const f32x4 g0 = *(const f32x4*)(gl + 8 * i + 4 * hi), g1 = *(const f32x4*)(gl + 32 + 8 * i + 4 * hi);
#pragma unroll
        for (int j = 0; j < 4; ++j) { p0[4 * i + j] = g0[j]; p1[4 * i + j] = g1[j]; } }
    const char* kb[4];
#pragma unroll
    for (int dd = 0; dd < 4; ++dd) kb[dd] = K_lds + KB * SHM_K + KSWZ(r32, (dd * 16 + hi * 8) * 2);
#pragma unroll
    for (int d0 = 0; d0 < 8; ++d0) { const char* a = kb[d0 & 3] + (d0 >> 2) * 128;
        bf16x8 b0 = *reinterpret_cast<const bf16x8*>(a);
        bf16x8 b1 = *reinterpret_cast<const bf16x8*>(a + 32 * 256);
        p0 = __builtin_amdgcn_mfma_f32_32x32x16_bf16(b0, qr[d0], p0, 0, 0, 0);
        p1 = __builtin_amdgcn_mfma_f32_32x32x16_bf16(b1, qr[d0], p1, 0, 0, 0); }
}
template <int VB>
__device__ __forceinline__ void pv_tile(f32x16* o, int vb0, bf16x8 pa0, bf16x8 pa1, bf16x8 pa2, bf16x8 pa3) {
#define TRRD(dst, off) asm volatile("ds_read_b64_tr_b16 %0, %1 offset:%2" : "=&v"(dst) : "v"(vb0), "i"(off) : "memory")
#define PV_D0(d0) do { s16x4 l0, l1, l2, l3, h0, h1, h2, h3; constexpr int b_ = VB * SHM_V + v_rd_off(d0, 0, 0); \
        TRRD(l0, b_); TRRD(h0, b_ + 2048); TRRD(l1, b_ + 4096); TRRD(h1, b_ + 6144); TRRD(l2, b_ + 8192); TRRD(h2, b_ + 10240); TRRD(l3, b_ + 12288); TRRD(h3, b_ + 14336); \
        asm volatile("s_waitcnt lgkmcnt(0)" ::: "memory"); SBAR();   \
        o[d0] = __builtin_amdgcn_mfma_f32_32x32x16_bf16(pa0, (bf16x8){l0[0], l0[1], l0[2], l0[3], h0[0], h0[1], h0[2], h0[3]}, o[d0], 0, 0, 0);   \
        o[d0] = __builtin_amdgcn_mfma_f32_32x32x16_bf16(pa1, (bf16x8){l1[0], l1[1], l1[2], l1[3], h1[0], h1[1], h1[2], h1[3]}, o[d0], 0, 0, 0);   \
        o[d0] = __builtin_amdgcn_mfma_f32_32x32x16_bf16(pa2, (bf16x8){l2[0], l2[1], l2[2], l2[3], h2[0], h2[1], h2[2], h2[3]}, o[d0], 0, 0, 0);   \
        o[d0] = __builtin_amdgcn_mfma_f32_32x32x16_bf16(pa3, (bf16x8){l3[0], l3[1], l3[2], l3[3], h3[0], h3[1], h3[2], h3[3]}, o[d0], 0, 0, 0); } while (0)
    PV_D0(0); PV_D0(1); PV_D0(2); PV_D0(3);
#undef PV_D0
#undef TRRD
}
struct BlockRef { const bf16_t* Q; const bf16_t* K; const bf16_t* V; const float* G; bf16_t* O; int P0, jlo; };
struct Seam { bf16x8 qr[8]; bf16x8 st_v0, st_v1, st_k0, st_k1; float sg; };
#define ROW(p, k0, rr) ((p) + (size_t)((k0) + (rr)) * D + sc)
#define VMW() asm volatile("s_waitcnt vmcnt(0)" ::: "memory")
#define VMWN(n) asm volatile("s_waitcnt vmcnt(%0)" :: "i"(n) : "memory")
#define SLOAD_H(Kp, Vp, Gp, k0) do { S.st_v0 = load8(ROW(Vp, k0, sr)); S.st_v1 = load8(ROW(Vp, k0, 32 + sr));              \
                         S.st_k0 = load8(ROW(Kp, k0, sr)); S.st_k1 = load8(ROW(Kp, k0, 32 + sr)); S.sg = (Gp)[(k0) + (tid & 63)]; } while (0)
#define SWRITE_HK(bf) do { *(bf16x8*)(K_lds + (bf) * SHM_K + kws) = S.st_k0; *(bf16x8*)(K_lds + (bf) * SHM_K + kws + 32 * 256) = S.st_k1; \
                           if (tid < 64) G_lds[(bf) * 64 + tid] = S.sg; } while (0)
#define SWRITE_HV(bf) do { *(bf16x8*)(V_lds + (bf) * SHM_V + vst0) = S.st_v0; *(bf16x8*)(V_lds + (bf) * SHM_V + vst1) = S.st_v1; } while (0)
#define SWRITE_H(bf) do { SWRITE_HV(bf); SWRITE_HK(bf); } while (0)
__device__ __forceinline__ void prime(const BlockRef& cur, char* lds, Seam& S, int wv) {
    const int tid = otid(wv), wid = __builtin_amdgcn_readfirstlane(tid >> 6), lane = tid & 63, r32 = lane & 31, hi = lane >> 5;
    const int sr = tid >> 4, sc = (tid & 15) * 8, kws = KSWZ(sr, sc * 2); char* K_lds = lds + 2 * SHM_V; float* G_lds = (float*)(lds + OFF_G);
#pragma unroll
    for (int d0 = 0; d0 < 8; ++d0) S.qr[d0] = load8(cur.Q + (size_t)(wid * QBLK + r32) * D + d0 * 16 + hi * 8);
    SLOAD_H(cur.K, cur.V, cur.G, cur.jlo * KVBLK); VMW(); SWRITE_HK(0);
    __syncthreads();
}
__device__ __forceinline__ void block(const BlockRef& cur, const BlockRef& nxt, char* lds, Seam& S, int wv) {
    const int tid = otid(wv), wid = __builtin_amdgcn_readfirstlane(tid >> 6), lane = tid & 63, r32 = lane & 31, hi = lane >> 5;
    const int W = SEQ;
    const int j_hi = (cur.P0 + QB - 1) / KVBLK + 1;
    const int j_lo = cur.jlo, NT = j_hi - j_lo, kbn = nxt.jlo * KVBLK;
    const int qlo = cur.P0 + wid * QBLK, qm = qlo + r32 - 4 * hi;
    char* V_lds = lds; char* K_lds = lds + 2 * SHM_V; float* G_lds = (float*)(lds + OFF_G);
    float* ws = (float*)(lds + OFF_WS) + wid * 64; float* li_l = ws, * al_l = ws + 32;
    float m_reg = -1e30f, l_reg = 0; f32x16 o[4] = {};
    const int sr = tid >> 4, sc = (tid & 15) * 8, vst0 = v_st(sr, sc), vst1 = v_st(32 + sr, sc), kws = KSWZ(sr, sc * 2);
    const int vb0 = (int)(uintptr_t)V_lds + v_rd_base(lane);
    const bf16_t* Kh = cur.K; const bf16_t* Vh = cur.V; const float* Gh = cur.G;
#define RESC(a) do { if (__any((a) < 1.f)) { if (hi == 0) al_l[r32] = (a); asm volatile("s_waitcnt lgkmcnt(0)" ::: "memory");              \
                     _Pragma("unroll") for (int d_ = 0; d_ < 4; ++d_) _Pragma("unroll") for (int r = 0; r < 16; ++r) o[d_][r] *= al_l[crow(r, hi)]; } } while (0)
#define KBASE(t) ((j_lo + (t)) * KVBLK)
#define MASKT(P0_, P1_, t) do { const int kb_ = KBASE(t); if (kb_ + KVBLK - 1 > qlo) mask_tile(P0_, P1_, qm - kb_, (unsigned)W); } while (0)
    constexpr int NQL = 8;
#define SEAM_K0() do { VMWN(NQL); SWRITE_HK(0); SBAR(); } while (0)
    f32x16 pA0, pA1, pB0, pB1; float mnA, mnB, alA, alB; bf16x8 pa0, pa1, pa2, pa3;
    SWRITE_HV(0); SBAR();
    if (NT > 1) SLOAD_H(Kh, Vh, Gh, KBASE(1));
    SBAR(); qkt<0>(pA0, pA1, K_lds, r32, hi, S.qr, G_lds);
    MASKT(pA0, pA1, 0); partialSM(pA0, pA1, m_reg, mnA, alA);
    if (NT > 1) { VMW(); SWRITE_H(1); }
    __syncthreads();
#define HALF_STEP(PX0, PX1, mnX, alX, PY0, PY1, alY, t, KB, VB, SB) do {                                                      \
        SBAR(); qkt<KB>(PX0, PX1, K_lds, r32, hi, S.qr, G_lds + (KB) * 64);                                             \
        finishSM(PY0, PY1, alY, l_reg, pa0, pa1, pa2, pa3); SBAR();                                                           \
        if ((t) + 1 < NT) { SLOAD_H(Kh, Vh, Gh, KBASE((t) + 1)); SBAR(); }                                               \
        pv_tile<VB>(o, vb0, pa0, pa1, pa2, pa3); MASKT(PX0, PX1, (t)); partialSM(PX0, PX1, m_reg, mnX, alX);                                        \
        __syncthreads();                                                                                                      \
        if ((t) + 1 < NT) { VMW(); SWRITE_H(SB); }                                                                          \
        RESC(alX); __syncthreads(); } while (0)
    for (int t = 1; t + 1 < NT; t += 2) {
        HALF_STEP(pB0, pB1, mnB, alB, pA0, pA1, alA, t, 1, 0, 0);
        HALF_STEP(pA0, pA1, mnA, alA, pB0, pB1, alB, t + 1, 0, 1, 1);
    }
    const bool even = (NT & 1) == 0;
    if (even) { SBAR(); qkt<1>(pB0, pB1, K_lds, r32, hi, S.qr, G_lds + 64); SBAR(); }
    SLOAD_H(nxt.K, nxt.V, nxt.G, kbn); SBAR();
#pragma unroll
    for (int d0 = 0; d0 < 8; ++d0) S.qr[d0] = load8(nxt.Q + (size_t)(wid * QBLK + r32) * D + d0 * 16 + hi * 8);
    SBAR();
    finishSM(pA0, pA1, alA, l_reg, pa0, pa1, pa2, pa3); SBAR();
    pv_tile<0>(o, vb0, pa0, pa1, pa2, pa3);
    if (even) { MASKT(pB0, pB1, NT - 1); partialSM(pB0, pB1, m_reg, mnB, alB); __syncthreads(); RESC(alB);
        finishSM(pB0, pB1, alB, l_reg, pa0, pa1, pa2, pa3); SBAR(); pv_tile<1>(o, vb0, pa0, pa1, pa2, pa3); }
    SBAR(); SEAM_K0();
    if (hi == 0) li_l[r32] = l_reg; asm volatile("s_waitcnt lgkmcnt(0)" ::: "memory");
    float rli[16];
#pragma unroll
    for (int r = 0; r < 16; ++r) rli[r] = __builtin_amdgcn_rcpf(li_l[crow(r, hi)]);
    bf16_t* Ow = cur.O + (size_t)(wid * QBLK) * D;
#pragma unroll
    for (int r = 0; r < 16; ++r) { const int orow = crow(r, hi);
#pragma unroll
        for (int d0 = 0; d0 < 4; ++d0) { const float v = o[d0][r] * rli[r];
            const float vn = __shfl_xor(v, 1);
            if ((r32 & 1) == 0) *(unsigned*)(Ow + (size_t)orow * D + d0 * 32 + r32) = cvt_pk_bf16(v, vn); } }
    __syncthreads();
#undef RESC
#undef KBASE
#undef MASKT
#undef SEAM_K0
#undef HALF_STEP
}
#undef ROW
#undef VMW
#undef VMWN
#undef SLOAD_H
#undef SWRITE_HK
#undef SWRITE_HV
#undef SWRITE_H
struct Item { int bh, qb0, qb1; };
__device__ __forceinline__ Item decode(int L) {
    const int c = L & 255, i = L >> 8, xcd = c & 7, cc = c >> 3, gi = (cc & 1) + 2 * i, qb = ((cc >> 1) + 2 * i + (i >> 2)) & 15;
    Item it; it.bh = ((xcd - gi) & 7) * 16 + gi; it.qb0 = qb; it.qb1 = qb; return it;
}
__device__ __forceinline__ BlockRef mkref(const Item& it, int pass, const bf16_t* Q, const bf16_t* K, const bf16_t* V, const float* G, const int* JLO, bf16_t* O, bf16_t* Odummy, bool dummy) {
    const int qb = pass ? it.qb1 : it.qb0; BlockRef r;
    r.Q = Q + ((size_t)it.bh * SEQ + (size_t)qb * QB) * D; r.O = dummy ? Odummy : O + ((size_t)it.bh * SEQ + (size_t)qb * QB) * D;
    r.K = K + (size_t)it.bh * SEQ * D; r.V = V + (size_t)it.bh * SEQ * D; r.G = G + (size_t)it.bh * SEQ; r.P0 = qb * QB; r.jlo = JLO[it.bh * 16 + qb]; return r;
}
__device__ __forceinline__ Item decode_q(int xq, int t) { Item it; const int gi = t & 15, qb = 15 - (t >> 4); it.bh = ((xq - gi) & 7) * 16 + gi; it.qb0 = qb; it.qb1 = qb; return it; }
__device__ __forceinline__ void phase(char* lds, const bf16_t* Q, const bf16_t* K, const bf16_t* V, const float* G, const int* JLO, bf16_t* O, unsigned* qcnt, int wv) {
    const int tid = otid(wv), xq = blockIdx.x & 7; unsigned* cnt = qcnt + xq * 16;
    volatile int* qw = (volatile int*)(lds + ATT_LDS);
    if (tid == 0) { qw[0] = (int)__hip_atomic_fetch_add(cnt, 1u, __ATOMIC_RELAXED, __HIP_MEMORY_SCOPE_AGENT); qw[1] = (int)__hip_atomic_fetch_add(cnt, 1u, __ATOMIC_RELAXED, __HIP_MEMORY_SCOPE_AGENT); }
    __syncthreads();
    int tcur = __builtin_amdgcn_readfirstlane(qw[0]), tnxt = __builtin_amdgcn_readfirstlane(qw[1]);
    __syncthreads();
    if (tcur >= 256) return;
    BlockRef cur = mkref(decode_q(xq, tcur), 0, Q, K, V, G, JLO, O, O, false);
    Seam S;
    prime(cur, lds, S, wv);
    for (int itn = 0;; ++itn) {
        const bool last = tnxt >= 256;
        const BlockRef nxt = last ? cur : mkref(decode_q(xq, tnxt), 0, Q, K, V, G, JLO, O, O, false);
        if (tid == 0) qw[itn & 1] = (int)__hip_atomic_fetch_add(cnt, 1u, __ATOMIC_RELAXED, __HIP_MEMORY_SCOPE_AGENT);
        block(cur, nxt, lds, S, wv);
        if (last) break;
        cur = nxt; tcur = tnxt; tnxt = __builtin_amdgcn_readfirstlane(qw[itn & 1]);
    }
}
#undef SBAR
}

struct Args {
    const float *x, *c, *mod_w, *mod_b, *norm_g, *a_w_in, *a_lb, *a_onorm_g, *a_w_out, *kv_mod_w, *kv_mod_b, *kv_norm_g, *kv_w, *kv_fb, *k_norm_g, *b_w_in, *b_q_norm_g, *b_w_out;
    float* out; unsigned char* ws; int one, pad;
};

__device__ __forceinline__ void transpose_item(const float* W, int K, int ldw, int N, bf16_t* WT, float* scr, int item, int lane) {
    const int nblk = N / 32, kb = item / nblk, nb = item % nblk, k0 = 64 * kb, n0 = 32 * nb;
#pragma unroll 8
    for (int i = 0; i < 32; ++i) { const int kk = 2 * i + (lane >> 5); scr[kk * 33 + (lane & 31)] = W[(size_t)(k0 + kk) * ldw + n0 + (lane & 31)]; }
    asm volatile("s_waitcnt lgkmcnt(0)" ::: "memory");
    const int c = lane & 7;
#pragma unroll
    for (int j = 0; j < 4; ++j) { const int n = (lane >> 3) + 8 * j; const float* s = scr + (8 * c) * 33 + n;
        u32x4 o; o.x = cvt_pk_bf16(s[0 * 33], s[1 * 33]); o.y = cvt_pk_bf16(s[2 * 33], s[3 * 33]); o.z = cvt_pk_bf16(s[4 * 33], s[5 * 33]); o.w = cvt_pk_bf16(s[6 * 33], s[7 * 33]);
        *(u32x4*)(WT + (size_t)(n0 + n) * K + k0 + 8 * c) = o; }
    asm volatile("s_waitcnt lgkmcnt(0)" ::: "memory");
}

__device__ __forceinline__ void p0_prologue(const Args& a, char* lds, int wv) {
    const int tid = otid(wv), lane = tid & 63, wave = tid >> 6, G = gridDim.x;
    unsigned char* ws = a.ws;
    float* sc = (float*)lds;
    float* red = (float*)(lds + 32768);
    for (int i = tid; i < NB * DM; i += 512) sc[i] = silu_f(a.c[i]);
    __syncthreads();
    for (int cgp = blockIdx.x; cgp < 256; cgp += G) {
        const int n0 = cgp * 32; const float* Wm; const float* bias; float* outp; int ldn, nloc;
        if (n0 < 3072) { Wm = a.mod_w; bias = a.mod_b; outp = (float*)(ws + WS_MOD0); ldn = 3072; nloc = n0; }
        else if (n0 < 6144) { Wm = a.mod_w + (size_t)DM * 3072; bias = a.mod_b + 3072; outp = (float*)(ws + WS_MOD1); ldn = 3072; nloc = n0 - 3072; }
        else { Wm = a.kv_mod_w; bias = a.kv_mod_b; outp = (float*)(ws + WS_KVMOD); ldn = 2048; nloc = n0 - 6144; }
        const int col = lane & 31, ksub = wave * 2 + (lane >> 5);
        float accb[8];
#pragma unroll
        for (int b = 0; b < 8; ++b) accb[b] = 0.f;
#pragma unroll 8
        for (int kk = 0; kk < 64; ++kk) { const int k = ksub * 64 + kk; const float w = Wm[(size_t)k * ldn + nloc + col];
#pragma unroll
            for (int b = 0; b < 8; ++b) accb[b] = fmaf(sc[b * DM + k], w, accb[b]); }
#pragma unroll
        for (int b = 0; b < 8; ++b) red[(ksub * 8 + b) * 32 + col] = accb[b];
        __syncthreads();
        if (tid < 256) { const int b = tid >> 5, cc = tid & 31; float s = bias[nloc + cc];
#pragma unroll
            for (int j = 0; j < 16; ++j) s += red[(j * 8 + b) * 32 + cc];
            outp[(size_t)b * ldn + nloc + cc] = s; }
        __syncthreads();
    }
    const int gtid = blockIdx.x * 512 + tid, NT = G * 512;
    for (int j = gtid; j < WD; j += NT) ((float*)(ws + WS_LB))[j] = 1.f / (1.f + __expf(a.a_lb[WD + j] - a.a_lb[j]));
    for (int i = gtid; i < NH * DM; i += NT) { const int h = i >> 10, k = i & 1023; ((float*)(ws + WS_WFL))[i] = a.kv_w[(size_t)k * 4112 + 4096 + h]; }
    __syncthreads();
    float* scr = (float*)(lds + wave * 16384);
    const int gw = blockIdx.x * 8 + wave, NGW = G * 8;
    constexpr int I1 = 16 * 256, I2 = 32 * 32, I3 = 16 * 128, I4 = 16 * 128, I5 = 32 * 32, NIT = I1 + I2 + I3 + I4 + I5;
    for (int it = gw; it < NIT; it += NGW) {
        int r = it;
        if (r < I1) { transpose_item(a.a_w_in, 1024, 8192, 8192, (bf16_t*)(ws + WS_W1), scr, r, lane); continue; } r -= I1;
        if (r < I2) { transpose_item(a.a_w_out, 2048, 1024, 1024, (bf16_t*)(ws + WS_W2), scr, r, lane); continue; } r -= I2;
        if (r < I3) { transpose_item(a.kv_w, 1024, 4112, 4096, (bf16_t*)(ws + WS_W3KV), scr, r, lane); continue; } r -= I3;
        if (r < I4) { transpose_item(a.b_w_in, 1024, 4096, 4096, (bf16_t*)(ws + WS_W3Q), scr, r, lane); continue; } r -= I4;
        transpose_item(a.b_w_out, 2048, 1024, 1024, (bf16_t*)(ws + WS_W4), scr, r, lane);
    }
}

template <bool FL, bool DUAL>
__device__ __forceinline__ void norm_phase(const float* x, const float* g, const float* shiftp, const float* scalep, int mstride, bf16_t* outp,
                                           const float* g2, const float* shiftp2, const float* scalep2, int mstride2, bf16_t* outp2,
                                           const float* wfl_g, const float* fb, float* LS, char* lds, int wv) {
    const int tid = otid(wv), lane = tid & 63, wave = tid >> 6;
    float* wfl = (float*)lds;
    if (FL) { for (int i = tid; i < NH * DM / 4; i += 512) ((f32x4*)wfl)[i] = ((const f32x4*)wfl_g)[i]; __syncthreads(); }
    const int gw = blockIdx.x * 8 + wave, NGW = gridDim.x * 8, rpw = (((TOK + NGW - 1) / NGW) + 3) & ~3;
    int curb = -1; f32x4 al[4], be[4], al2[4], be2[4];
    for (int i0 = 0; i0 < rpw; i0 += 4) {
        const int m0 = gw * rpw + i0; if (m0 >= TOK) break;
        const int b = m0 >> 12;
        if (b != curb) { curb = b;
#pragma unroll
            for (int j = 0; j < 4; ++j) { const int col = 4 * lane + 256 * j; const f32x4 gg = *(const f32x4*)(g + col), sc = *(const f32x4*)(scalep + (size_t)b * mstride + col);
                al[j] = gg * (sc + 1.f); be[j] = *(const f32x4*)(shiftp + (size_t)b * mstride + col);
                if (DUAL) { const f32x4 gg2 = *(const f32x4*)(g2 + col), sc2 = *(const f32x4*)(scalep2 + (size_t)b * mstride2 + col);
                    al2[j] = gg2 * (sc2 + 1.f); be2[j] = *(const f32x4*)(shiftp2 + (size_t)b * mstride2 + col); } } }
        f32x4 v[4][4];
#pragma unroll
        for (int q = 0; q < 4; ++q) { const f32x4* xr = (const f32x4*)(x + (size_t)(m0 + q) * DM) + lane;
#pragma unroll
            for (int j = 0; j < 4; ++j) v[q][j] = xr[64 * j]; }
#pragma unroll
        for (int q = 0; q < 4; ++q) { float s2 = 0.f;
#pragma unroll
            for (int j = 0; j < 4; ++j) s2 += (v[q][j].x * v[q][j].x + v[q][j].y * v[q][j].y) + (v[q][j].z * v[q][j].z + v[q][j].w * v[q][j].w);
            const float rstd = __builtin_amdgcn_rsqf(wave_sum(s2) * (1.f / DM) + EPS);
            unsigned long long* o8 = (unsigned long long*)(outp + (size_t)(m0 + q) * DM) + lane;
            unsigned long long* o82 = (unsigned long long*)(outp2 + (size_t)(m0 + q) * DM) + lane;
#pragma unroll
            for (int j = 0; j < 4; ++j) { const f32x4 xh = v[q][j] * rstd;
                if (DUAL) { const f32x4 w2 = xh * al2[j] + be2[j];
                    o82[64 * j] = (unsigned long long)cvt_pk_bf16(w2.x, w2.y) | ((unsigned long long)cvt_pk_bf16(w2.z, w2.w) << 32); }
                v[q][j] = xh * al[j] + be[j];
                o8[64 * j] = (unsigned long long)cvt_pk_bf16(v[q][j].x, v[q][j].y) | ((unsigned long long)cvt_pk_bf16(v[q][j].z, v[q][j].w) << 32); } }
        if (FL) {
            float mine[4] = {0.f, 0.f, 0.f, 0.f};
#pragma unroll 2
            for (int h = 0; h < NH; ++h) { f32x4 w[4];
#pragma unroll
                for (int j = 0; j < 4; ++j) w[j] = *(const f32x4*)(wfl + h * DM + 4 * lane + 256 * j);
#pragma unroll
                for (int q = 0; q < 4; ++q) { float p = 0.f;
#pragma unroll
                    for (int j = 0; j < 4; ++j) p += (v[q][j].x * w[j].x + v[q][j].y * w[j].y) + (v[q][j].z * w[j].z + v[q][j].w * w[j].w);
                    p = wave_sum(p); if (lane == h) mine[q] = p; } }
            if (lane < NH) { const float fbv = fb[lane];
#pragma unroll
                for (int q = 0; q < 4; ++q) { const float z = mine[q] + fbv; const float ls = z < 0.f ? z - log1pf(__expf(z)) : -log1pf(__expf(-z));
                    LS[(size_t)(b * NH + lane) * SEQ + ((m0 + q) & (SEQ - 1))] = ls; } }
        }
    }
}

__device__ __forceinline__ void cumsum_phase(float* LS, int* JLO, const float* kg, const float* qg, char* lds, int wv) {
    const int tid = otid(wv), lane = tid & 63, wave = tid >> 6; float* wtot = (float*)lds; float* gl = (float*)(lds + 1024);
    float mk = fmaxf(fabsf(kg[lane]), fabsf(kg[lane + 64])), mq = fmaxf(fabsf(qg[lane]), fabsf(qg[lane + 64]));
#pragma unroll
    for (int o = 1; o < 64; o <<= 1) { mk = fmaxf(mk, __shfl_xor(mk, o)); mq = fmaxf(mq, __shfl_xor(mq, o)); }
    const float TH = (40.f + 2.f * (1.05f * 128.f * 1.4426950408889634f * 0.08838834764831845f * mk * mq)) / (1.4426950408889634f * 0.08838834764831845f);
    for (int bh = blockIdx.x; bh < BH; bh += gridDim.x) {
        float* p = LS + (size_t)bh * SEQ + tid * 8; f32x4 a = *(f32x4*)p, b = *(f32x4*)(p + 4);
        float v[8] = {a.x, a.y, a.z, a.w, b.x, b.y, b.z, b.w};
#pragma unroll
        for (int i = 1; i < 8; ++i) v[i] += v[i - 1];
        float run = v[7];
#pragma unroll
        for (int o = 1; o < 64; o <<= 1) { const float t = __shfl_up(run, o); if (lane >= o) run += t; }
        if (lane == 63) wtot[wave] = run;
        __syncthreads();
        float off = run - v[7];
        for (int w = 0; w < wave; ++w) off += wtot[w];
        const float k = -11.313708498984761f;
        a = (f32x4){(v[0] + off) * k, (v[1] + off) * k, (v[2] + off) * k, (v[3] + off) * k}; b = (f32x4){(v[4] + off) * k, (v[5] + off) * k, (v[6] + off) * k, (v[7] + off) * k};
        *(f32x4*)p = a; *(f32x4*)(p + 4) = b;
        *(f32x4*)(gl + tid * 8) = a; *(f32x4*)(gl + tid * 8 + 4) = b;
        __syncthreads();
#pragma unroll
        for (int rep = 0; rep < 2; ++rep) { const int qb = wave + 8 * rep, P0 = qb * 256;
            const bool skip = (64 * lane + 63 < P0) && (gl[P0] - gl[64 * lane + 63] > TH);
            const unsigned long long mask = __ballot(skip);
            if (lane == 0) JLO[bh * 16 + qb] = __popcll(mask); }
        __syncthreads();
    }
}

__device__ __forceinline__ void p4_scan(const Args& a, char* lds, int dry, int wv) {
    const int tid = otid(wv), lane = tid & 63, w = tid >> 6, r = lane & 15, gq = lane >> 4, vg = w & 3, kh = w >> 2;
    unsigned char* ws = a.ws;
    bf16_t* R0 = (bf16_t*)(ws + WS_R0); const bf16_t* R1 = (const bf16_t*)(ws + WS_R1); const bf16_t* R2 = (const bf16_t*)(ws + WS_R2);
    const float* LB = (const float*)(ws + WS_LB);
    constexpr int BUF = 45568, O_QD = 0, O_KT = 17408, O_AT = 35840, O_DL = 45056, O_XS = 2 * BUF, O_PART = O_XS + 32768, O_V = O_PART + 2048;
    typedef short v4i16_t __attribute__((ext_vector_type(4)));
    const LAS char* const vtr0 = (const LAS char*)(LAS unsigned char*)(lds) + O_V + (8 * gq + (r >> 2)) * 272 + (32 * vg + 4 * (r & 3)) * 2;
    const int pk0 = 4 * (tid & 31), prg = tid >> 5, pc0 = 4 * prg;
    bf16_t* const tf = (bf16_t*)(lds + O_V);
    for (int bh = blockIdx.x; bh < BH; bh += gridDim.x) {
        const int h = bh & 15;
        const f32x4 og0 = *(const f32x4*)(a.a_onorm_g + h * HD + 32 * vg + 4 * gq), og1 = *(const f32x4*)(a.a_onorm_g + h * HD + 32 * vg + 16 + 4 * gq);
        const f32x4 lbv4 = *(const f32x4*)(LB + h * HD + pk0), om4 = 1.f - lbv4;
        f32x4 st[4][2];
#pragma unroll
        for (int i = 0; i < 4; ++i) { st[i][0] = (f32x4){0.f, 0.f, 0.f, 0.f}; st[i][1] = (f32x4){0.f, 0.f, 0.f, 0.f}; }
        u32x4 sqA[2], sfA[2], svA[2], sqB[2], sfB[2], svB[2]; bf16x8 vb[2][2];
        char* const xs_own = lds + O_XS + w * 4096 + lane * 16; const char* const xs_par = lds + O_XS + (w ^ 4) * 4096 + lane * 16;
        { const u32x4 z = {0u, 0u, 0u, 0u};
#pragma unroll
          for (int f = 0; f < 4; ++f) *(u32x4*)(xs_own + f * 1024) = z; }
#define P4_LOAD(X, n_) do { const size_t blk_ = ((size_t)bh * SEQ + (size_t)(n_) * 64) * HD; \
            _Pragma("unroll") for (int rep = 0; rep < 2; ++rep) { const int i = tid + rep * 512; sq##X[rep] = *(const u32x4*)(R0 + blk_ + (size_t)i * 8); sf##X[rep] = *(const u32x4*)(R1 + blk_ + (size_t)i * 8); sv##X[rep] = *(const u32x4*)(R2 + blk_ + (size_t)i * 8); } } while (0)
#define P4_WRITE_RAW(X, bf_) do { char* B_ = lds + (bf_) * BUF; \
            _Pragma("unroll") for (int rep = 0; rep < 2; ++rep) { const int i = tid + rep * 512; *(u32x4*)(B_ + O_QD + (i >> 4) * 272 + (i & 15) * 16) = sq##X[rep]; *(u32x4*)(lds + O_V + (i >> 4) * 272 + (i & 15) * 16) = sf##X[rep]; } } while (0)
#define P4_WRITE_V(X) do { _Pragma("unroll") for (int rep = 0; rep < 2; ++rep) { const int i = tid + rep * 512; *(u32x4*)(lds + O_V + (i >> 4) * 272 + (i & 15) * 16) = sv##X[rep]; } } while (0)
#define P4_PREP(X, bf_) do { char* B_ = lds + (bf_) * BUF; bf16_t* tq = (bf16_t*)(B_ + O_QD); float* part2 = (float*)(B_ + O_AT); \
              \
            float ee[4][4]; f32x4 run = {1.f, 1.f, 1.f, 1.f}; \
            _Pragma("unroll") for (int i = 0; i < 4; ++i) { u32x2* pf = (u32x2*)(tf + (pc0 + i) * 136 + pk0); const u32x2 wz = *pf; \
                const f32x4 fz = {__uint_as_float(wz.x << 16), __uint_as_float(wz.x & 0xffff0000u), __uint_as_float(wz.y << 16), __uint_as_float(wz.y & 0xffff0000u)}; f32x4 kq; \
                _Pragma("unroll") for (int j = 0; j < 4; ++j) { const float sg = __builtin_amdgcn_rcpf(1.f + __expf(-fz[j])); const float f = lbv4[j] + om4[j] * sg; run[j] *= f; ee[i][j] = run[j]; kq[j] = 1.f - f; } \
                u32x2 wk; wk.x = cvt_pk_bf16(kq[0], kq[1]); wk.y = cvt_pk_bf16(kq[2], kq[3]); *pf = wk; } \
            *(f32x4*)(part2 + prg * 128 + pk0) = run; \
            __syncthreads(); \
            f32x4 offp = {1.f, 1.f, 1.f, 1.f}, totp = {1.f, 1.f, 1.f, 1.f}; \
            _Pragma("unroll") for (int g = 0; g < 16; ++g) { const f32x4 pg = *(const f32x4*)(part2 + g * 128 + pk0); totp = totp * pg; if (g < prg) offp = offp * pg; } \
            float ks_[4][4]; \
            _Pragma("unroll") for (int i = 0; i < 4; ++i) { u32x2* pq = (u32x2*)(tq + (pc0 + i) * 136 + pk0); u32x2* pf = (u32x2*)(tf + (pc0 + i) * 136 + pk0); const u32x2 wq = *pq, wk = *pf; \
                const f32x4 qv = {__uint_as_float(wq.x << 16), __uint_as_float(wq.x & 0xffff0000u), __uint_as_float(wq.y << 16), __uint_as_float(wq.y & 0xffff0000u)}; \
                const f32x4 kv = {__uint_as_float(wk.x << 16), __uint_as_float(wk.x & 0xffff0000u), __uint_as_float(wk.y << 16), __uint_as_float(wk.y & 0xffff0000u)}; f32x4 qd, ki; \
                _Pragma("unroll") for (int j = 0; j < 4; ++j) { const float ea = offp[j] * ee[i][j]; const float ie = __builtin_amdgcn_rcpf(ea); qd[j] = qv[j] * ea; ki[j] = kv[j] * ie; ks_[j][i] = ki[j] * totp[j]; } \
                u32x2 o1, o2; o1.x = cvt_pk_bf16(qd[0], qd[1]); o1.y = cvt_pk_bf16(qd[2], qd[3]); o2.x = cvt_pk_bf16(ki[0], ki[1]); o2.y = cvt_pk_bf16(ki[2], ki[3]); *pq = o1; *pf = o2; } \
            _Pragma("unroll") for (int j = 0; j < 4; ++j) { u32x2 wk; wk.x = cvt_pk_bf16(ks_[j][0], ks_[j][1]); wk.y = cvt_pk_bf16(ks_[j][2], ks_[j][3]); *(u32x2*)(B_ + O_KT + (pk0 + j) * 144 + pc0 * 2) = wk; } \
            if (prg == 0) *(f32x4*)(B_ + O_DL + pk0 * 4) = totp; \
            __syncthreads(); \
            { const int mt = w >> 1, nt0 = (w & 1) * 2; f32x4 acc2[2] = {{0.f, 0.f, 0.f, 0.f}, {0.f, 0.f, 0.f, 0.f}}; \
              _Pragma("unroll") for (int ks = 0; ks < 4; ++ks) { const bf16x8 Aq = *(const bf16x8*)(tq + (16 * mt + r) * 136 + ks * 32 + gq * 8); \
                  _Pragma("unroll") for (int j = 0; j < 2; ++j) { const bf16x8 Bk = *(const bf16x8*)(tf + (16 * (nt0 + j) + r) * 136 + ks * 32 + gq * 8); \
                      acc2[j] = __builtin_amdgcn_mfma_f32_16x16x32_bf16(Aq, Bk, acc2[j], 0, 0, 0); } } \
              bf16_t* ap = (bf16_t*)(B_ + O_AT); \
              __syncthreads();     \
              _Pragma("unroll") for (int j = 0; j < 2; ++j) { const int s_ = 16 * (nt0 + j) + r; \
                  _Pragma("unroll") for (int rg = 0; rg < 4; ++rg) { const int c = 16 * mt + 4 * gq + rg; ap[c * 72 + s_] = (s_ <= c) ? f2bf(acc2[j][rg]) : (bf16_t)0; } } } \
            P4_WRITE_V(X); \
            __syncthreads(); } while (0)
#define P4_PACK(DST, ksl, vt) do { u32x4 bw_; bw_.x = cvt_pk_bf16(st[2 * (ksl)][vt][0], st[2 * (ksl)][vt][1]); bw_.y = cvt_pk_bf16(st[2 * (ksl)][vt][2], st[2 * (ksl)][vt][3]); \
            bw_.z = cvt_pk_bf16(st[2 * (ksl) + 1][vt][0], st[2 * (ksl) + 1][vt][1]); bw_.w = cvt_pk_bf16(st[2 * (ksl) + 1][vt][2], st[2 * (ksl) + 1][vt][3]); DST = bw_; } while (0)
#define P4_STEP(n_, CUR, X, Y) do { const char* B = lds + (CUR) * BUF; \
            _Pragma("unroll") for (int vt = 0; vt < 2; ++vt) _Pragma("unroll") for (int cs = 0; cs < 2; ++cs) { \
                const v4i16_t lo_ = __builtin_amdgcn_ds_read_tr16_b64_v4i16((LAS v4i16_t*)(vtr0 + cs * 32 * 272 + vt * 32)); \
                const v4i16_t hi_ = __builtin_amdgcn_ds_read_tr16_b64_v4i16((LAS v4i16_t*)(vtr0 + cs * 32 * 272 + vt * 32 + 4 * 272)); \
                vb[vt][cs] = (bf16x8){lo_[0], lo_[1], lo_[2], lo_[3], hi_[0], hi_[1], hi_[2], hi_[3]}; } \
            P4_LOAD(X, ((n_) + 2 < 64) ? (n_) + 2 : 63); \
            f32x4 oo[2][2]; \
            _Pragma("unroll") for (int ml = 0; ml < 2; ++ml) { oo[ml][0] = (f32x4){0.f, 0.f, 0.f, 0.f}; oo[ml][1] = (f32x4){0.f, 0.f, 0.f, 0.f}; \
                _Pragma("unroll") for (int ks = 0; ks < 2; ++ks) { const bf16x8 Bq = *(const bf16x8*)(B + O_AT + (32 * kh + 16 * ml + r) * 144 + ks * 64 + gq * 16); \
                    _Pragma("unroll") for (int vt = 0; vt < 2; ++vt) oo[ml][vt] = __builtin_amdgcn_mfma_f32_16x16x32_bf16(vb[vt][ks], Bq, oo[ml][vt], 0, 0, 0); } } \
            _Pragma("unroll") for (int hf = 0; hf < 2; ++hf) _Pragma("unroll") for (int ksl = 0; ksl < 2; ++ksl) { const int ksg = 2 * (hf == 0 ? kh : 1 - kh) + ksl; u32x4 sf_[2]; \
                _Pragma("unroll") for (int vt = 0; vt < 2; ++vt) { if (hf == 0) P4_PACK(sf_[vt], ksl, vt); else sf_[vt] = *(const u32x4*)(xs_par + (ksl * 2 + vt) * 1024); } \
                _Pragma("unroll") for (int ml = 0; ml < 2; ++ml) { const char* qa = B + O_QD + (32 * kh + 16 * ml + r) * 272 + ksg * 64 + gq * 8; \
                    const u32x2 a0 = *(const u32x2*)qa, a1 = *(const u32x2*)(qa + 32); const u32x4 aw = {a0.x, a0.y, a1.x, a1.y}; \
                    _Pragma("unroll") for (int vt = 0; vt < 2; ++vt) oo[ml][vt] = __builtin_amdgcn_mfma_f32_16x16x32_bf16(__builtin_bit_cast(bf16x8, sf_[vt]), __builtin_bit_cast(bf16x8, aw), oo[ml][vt], 0, 0, 0); } } \
            float* part = (float*)(lds + O_PART) + (CUR) * 256; \
            _Pragma("unroll") for (int ml = 0; ml < 2; ++ml) { float s_ = 0.f; \
                _Pragma("unroll") for (int vt = 0; vt < 2; ++vt) s_ += (oo[ml][vt][0] * oo[ml][vt][0] + oo[ml][vt][1] * oo[ml][vt][1]) + (oo[ml][vt][2] * oo[ml][vt][2] + oo[ml][vt][3] * oo[ml][vt][3]); \
                s_ += __shfl_xor(s_, 16); s_ += __shfl_xor(s_, 32); if (gq == 0) part[(32 * kh + 16 * ml + r) * 4 + vg] = s_; } \
            _Pragma("unroll") for (int i = 0; i < 4; ++i) { const f32x4 dlv = *(const f32x4*)(B + O_DL + (64 * kh + 16 * i + 4 * gq) * 4); st[i][0] = st[i][0] * dlv; st[i][1] = st[i][1] * dlv; \
                _Pragma("unroll") for (int cs = 0; cs < 2; ++cs) { const bf16x8 A = *(const bf16x8*)(B + O_KT + (64 * kh + 16 * i + r) * 144 + cs * 64 + gq * 16); \
                    _Pragma("unroll") for (int vt = 0; vt < 2; ++vt) st[i][vt] = __builtin_amdgcn_mfma_f32_16x16x32_bf16(A, vb[vt][cs], st[i][vt], 0, 0, 0); } } \
            __syncthreads(); \
            _Pragma("unroll") for (int ksl = 0; ksl < 2; ++ksl) _Pragma("unroll") for (int vt = 0; vt < 2; ++vt) { u32x4 t_; P4_PACK(t_, ksl, vt); *(u32x4*)(xs_own + (ksl * 2 + vt) * 1024) = t_; } \
            P4_WRITE_RAW(Y, (CUR) ^ 1); \
            __syncthreads(); \
            { bf16_t* op = R0 + ((size_t)bh * SEQ + (size_t)(n_) * 64) * HD + 32 * vg + 4 * gq; \
              _Pragma("unroll") for (int ml = 0; ml < 2; ++ml) { const int c = 32 * kh + 16 * ml + r; const f32x4 p0 = *(const f32x4*)(part + c * 4); \
                const float rs = __builtin_amdgcn_rsqf(((p0.x + p0.y) + (p0.z + p0.w)) * (1.f / HD) + EPS); \
                const f32x4 ov0 = oo[ml][0] * og0 * rs, ov1 = oo[ml][1] * og1 * rs; u32x2 pk0, pk1; pk0.x = cvt_pk_bf16(ov0[0], ov0[1]); pk0.y = cvt_pk_bf16(ov0[2], ov0[3]); pk1.x = cvt_pk_bf16(ov1[0], ov1[1]); pk1.y = cvt_pk_bf16(ov1[2], ov1[3]); \
                if (!dry) { *(u32x2*)(op + (size_t)c * HD) = pk0; *(u32x2*)(op + (size_t)c * HD + 16) = pk1; } else asm volatile("" :: "v"(pk0), "v"(pk1)); } } \
            P4_PREP(Y, (CUR) ^ 1); } while (0)
        P4_LOAD(A, 0); P4_LOAD(B, 1); P4_WRITE_RAW(A, 0);
        __syncthreads();
        P4_PREP(A, 0);
        for (int n = 0; n < 64; n += 2) { P4_STEP(n, 0, A, B); P4_STEP(n + 1, 1, B, A); }
        __syncthreads();
#undef P4_LOAD
#undef P4_WRITE_RAW
#undef P4_WRITE_V
#undef P4_PREP
#undef P4_PACK
#undef P4_STEP
    }
}

#define XB_TMO      128
#define XB_XCNT(j)  (256  + 64 * (j))
#define XB_XSUB(j)  (1280 + 64 * (j))
#define XB_XGEN(j)  (2304 + 64 * (j))
#define XB_TOP      3328
#define XB_TOPGEN   3392
#define XCD_BAR_WORDS 3456
#define XB_SPIN_CAP (1u << 22)
__device__ __forceinline__ unsigned xb_ld(unsigned* p)              { return __hip_atomic_load(p, __ATOMIC_RELAXED, __HIP_MEMORY_SCOPE_AGENT); }
__device__ __forceinline__ unsigned xb_add(unsigned* p, unsigned v) { return __hip_atomic_fetch_add(p, v, __ATOMIC_RELAXED, __HIP_MEMORY_SCOPE_AGENT); }
__device__ __forceinline__ unsigned xb_xcc_id() { return (unsigned)__builtin_amdgcn_s_getreg((3 << 11) | 20) & 0xFu; }
#define XB_SPIN(cond, bar) do { unsigned _sp = 0; while (cond) { __builtin_amdgcn_s_sleep(1); \
    if ((++_sp & 255u) == 0u) { if (xb_ld(&(bar)[XB_TMO])) break; if (_sp > XB_SPIN_CAP) { atomicAdd(&(bar)[XB_TMO], 1u); break; } } } } while (0)
struct XcdBarrier { unsigned* bar; unsigned x; volatile LAS unsigned* st; };
__device__ __forceinline__ XcdBarrier xcd_barrier_post(unsigned* bar, volatile LAS unsigned* st) {
    XcdBarrier b; b.bar = bar; b.x = xb_xcc_id(); b.st = st;
    if (threadIdx.x == 0) (void)xb_add(&bar[XB_XCNT(b.x)], 1u);
    return b;
}
__device__ __forceinline__ void xcd_barrier_complete(unsigned* bar, unsigned x, unsigned& nloc, unsigned& nx) {
    const unsigned G = gridDim.x * gridDim.y * gridDim.z;
    unsigned sum, cnt, mine, sp = 0u;
    for (;;) {
        sum = 0u; cnt = 0u; mine = 0u;
#pragma unroll
        for (unsigned j = 0; j < 16; ++j) { const unsigned c = xb_ld(&bar[XB_XCNT(j)]); sum += c; cnt += (c > 0u) ? 1u : 0u; mine = (j == x) ? c : mine; }
        if (sum == G) break;
        __builtin_amdgcn_s_sleep(1);
        if ((++sp & 255u) == 0u) { if (xb_ld(&bar[XB_TMO])) break; if (sp > XB_SPIN_CAP) { atomicAdd(&bar[XB_TMO], 1u); break; } }
    }
    nloc = mine > 0u ? mine : 1u; nx = cnt > 0u ? cnt : 1u;
}
__device__ __forceinline__ void xcd_barrier(unsigned* bar_, volatile LAS unsigned* st_, int wv) {
    const int tid0 = otid(wv);
    asm volatile("" : "+s"(bar_));
    XcdBarrier b; b.bar = bar_; b.st = st_; b.x = 0;
    asm volatile("s_waitcnt vmcnt(0)" ::: "memory");
    __syncthreads();
    if (tid0 == 0) {
        unsigned* bar = b.bar; b.x = xb_xcc_id();
        __builtin_amdgcn_s_waitcnt(0);
        unsigned nloc = b.st[0], nx = b.st[1];
        if (nloc == 0u) { xcd_barrier_complete(bar, b.x, nloc, nx); b.st[0] = nloc; b.st[1] = nx; }
        const unsigned old = xb_add(&bar[XB_XSUB(b.x)], 1u);
        const unsigned gen = old / nloc;
        if (old + 1u == (gen + 1u) * nloc) {
            __builtin_amdgcn_fence(__ATOMIC_RELEASE, "agent");
            asm volatile("s_waitcnt vmcnt(0)" ::: "memory");
            const unsigned og = xb_add(&bar[XB_TOP], 1u);
            const unsigned tg = og / nx;
            if (og + 1u == (tg + 1u) * nx) xb_add(&bar[XB_TOPGEN], 1u);
            else XB_SPIN(xb_ld(&bar[XB_TOPGEN]) == tg, bar);
            __builtin_amdgcn_fence(__ATOMIC_ACQUIRE, "agent");
            xb_add(&bar[XB_XGEN(b.x)], 1u);
            asm volatile("s_waitcnt vmcnt(0)" ::: "memory");
        } else {
            XB_SPIN(xb_ld(&bar[XB_XGEN(b.x)]) == gen, bar);
            __builtin_amdgcn_fence(__ATOMIC_ACQUIRE, "agent");
            asm volatile("s_waitcnt vmcnt(0)" ::: "memory");
        }
    }
    __syncthreads();
}

__global__ void __launch_bounds__(512, 2) yoco_fwd(Args a) {
    extern __shared__ __attribute__((aligned(16))) unsigned char lds_raw[];
    char* lds = (char*)lds_raw; LAS unsigned char* ldsl = (LAS unsigned char*)lds_raw;
    cg::grid_group grid = cg::this_grid();
    const int wv = __builtin_amdgcn_readfirstlane((int)threadIdx.x >> 6);
    unsigned char* ws = a.ws;
    bf16_t* R0 = (bf16_t*)(ws + WS_R0); bf16_t* R1 = (bf16_t*)(ws + WS_R1); bf16_t* R2 = (bf16_t*)(ws + WS_R2);
    bf16_t* XA = (bf16_t*)(ws + WS_XA); bf16_t* H0 = (bf16_t*)a.out;
    const float* MOD0 = (const float*)(ws + WS_MOD0); const float* MOD1 = (const float*)(ws + WS_MOD1); const float* KVMOD = (const float*)(ws + WS_KVMOD);
    float* LSG = (float*)(ws + WS_LSG);
    const int G = gridDim.x, c = blockIdx.x;
    constexpr size_t TS = 64 * MiB;

    unsigned* barw = (unsigned*)(ws + WS_SM + 786432);
    volatile LAS unsigned* bst = (volatile LAS unsigned*)(ldsl + 143360);
    if (threadIdx.x == 0) { bst[0] = 0u; bst[1] = 0u; }
    if (a.one == 0) grid.sync();
    (void)xcd_barrier_post(barw, bst);
#define GSYNC() xcd_barrier((unsigned*)(a.ws + WS_SM + 786432), (volatile LAS unsigned*)(ldsl + 143360), wv)
    p0_prologue(a, lds, wv);
    GSYNC();
    norm_phase<false, false>(a.x, a.norm_g, MOD0, MOD0 + 1024, 3072, H0, nullptr, nullptr, nullptr, 0, nullptr, nullptr, nullptr, nullptr, lds, wv);
    GSYNC();
    { pg8::Gemm g{H0, (const bf16_t*)(ws + WS_W1), TOK, 6144, DM, 2048u, 256, (size_t)4096 * 2048}; pg8::StaticOrder S; S.init(TOK, 6144, G, c);
      pg8::EpiHead E{R0, TS}; pg8::gemm_phase(ldsl, g, S, E, wv);
    }
    GSYNC();
    p4_scan(a, lds, 0, wv);
    GSYNC();
    { pg8::Gemm g{H0, (const bf16_t*)(ws + WS_W1) + (size_t)6144 * DM, TOK, 2048, DM, 2048u, 256, (size_t)4096 * 2048}; pg8::StaticOrder S; S.init(TOK, 2048, G, c);
      pg8::EpiMulSilu E{R0}; pg8::gemm_phase(ldsl, g, S, E, wv); }
    GSYNC();
    { pg8::Gemm g{R0, (const bf16_t*)(ws + WS_W2), TOK, DM, WD, 256u, (size_t)SEQ * 256, (size_t)16 * SEQ * 256}; pg8::StaticOrder S; S.init(TOK, DM, G, c);
      pg8::EpiRes E{a.x, a.out, MOD0 + 2048}; pg8::gemm_phase(ldsl, g, S, E, wv);
    }
    GSYNC();
    norm_phase<true, true>(a.out, a.kv_norm_g, KVMOD, KVMOD + 1024, 2048, R0, a.norm_g + DM, MOD1, MOD1 + 1024, 3072, XA, (const float*)(ws + WS_WFL), a.kv_fb, LSG, lds, wv);
    GSYNC();
    cumsum_phase(LSG, (int*)(ws + WS_SM + 802816), a.k_norm_g, a.b_q_norm_g, lds, wv);
    { pg8::Gemm g{R0, (const bf16_t*)(ws + WS_W3KV), TOK, 4096, DM, 2048u, 256, (size_t)4096 * 2048}; pg8::StaticOrder S; S.init(TOK, 4096, G, c);
      pg8::EpiHeadNorm E{R1, TS, 1, a.k_norm_g, (LAS float*)(ldsl + 131072)}; pg8::gemm_phase(ldsl, g, S, E, wv);
    }
    GSYNC();
    { pg8::Gemm g{XA, (const bf16_t*)(ws + WS_W3Q), TOK, 2048, DM, 2048u, 256, (size_t)4096 * 2048}; pg8::StaticOrder S; S.init(TOK, 2048, G, c);
      pg8::EpiHeadNorm E{R0, TS, 1, a.b_q_norm_g, (LAS float*)(ldsl + 131072)}; pg8::gemm_phase(ldsl, g, S, E, wv); }
    GSYNC();
    att::phase(lds, R0, R1, R2, LSG, (const int*)(ws + WS_SM + 802816), R0, (unsigned*)(ws + WS_SM + 786432) + 3584, wv);
    GSYNC();
    { pg8::Gemm g{XA, (const bf16_t*)(ws + WS_W3G), TOK, 2048, DM, 2048u, 256, (size_t)4096 * 2048}; pg8::StaticOrder S; S.init(TOK, 2048, G, c);
      pg8::EpiMulSilu E{R0}; pg8::gemm_phase(ldsl, g, S, E, wv); }
    GSYNC();
    { pg8::Gemm g{R0, (const bf16_t*)(ws + WS_W4), TOK, DM, WD, 256u, (size_t)SEQ * 256, (size_t)16 * SEQ * 256}; pg8::StaticOrder S; S.init(TOK, DM, G, c);
      pg8::EpiRes E{a.out, a.out, MOD1 + 2048}; pg8::gemm_phase(ldsl, g, S, E, wv); }
}

extern "C" void kernel_launch(void* const* d_in, const int* in_sizes, int n_in, void* d_out, int out_size, void* d_ws, size_t ws_size, hipStream_t stream) {
    static int grid = 0;
    if (grid == 0) {
        int dev = 0, cus = 0, per_cu = 0;
        hipGetDevice(&dev); hipDeviceGetAttribute(&cus, hipDeviceAttributeMultiprocessorCount, dev);
        hipFuncSetAttribute((const void*)yoco_fwd, hipFuncAttributeMaxDynamicSharedMemorySize, LDS_BYTES);
        hipOccupancyMaxActiveBlocksPerMultiprocessor(&per_cu, (const void*)yoco_fwd, 512, LDS_BYTES);
        (void)hipGetLastError();
        if (cus <= 0) cus = 256;
        grid = cus;
        if (per_cu < 1) fprintf(stderr, "kernel_launch: occupancy query reports %d blocks/CU\n", per_cu);
        if (ws_size < 512 * MiB) fprintf(stderr, "kernel_launch: workspace too small (%zu)\n", ws_size);
    }
    if (hipMemsetAsync((char*)d_ws + WS_SM + 786432, 0, 16384, stream) != hipSuccess) fprintf(stderr, "kernel_launch: memset of barrier words failed\n");
    Args a{};
    const float** pp = (const float**)&a;
    for (int i = 0; i < 18; ++i) pp[i] = (const float*)d_in[i];
    a.out = (float*)d_out; a.ws = (unsigned char*)d_ws; a.one = 1;
    void* args[] = {&a};
    hipError_t e = hipLaunchCooperativeKernel((const void*)yoco_fwd, dim3(grid), dim3(512), args, LDS_BYTES, stream);
    if (e != hipSuccess) fprintf(stderr, "cooperative launch failed: %s (grid %d)\n", hipGetErrorString(e), grid);
}
```

```cpp
#include <hip/hip_runtime.h>
#include <hip/hip_cooperative_groups.h>
#include <cstdio>
#include <cstdint>
namespace cg = cooperative_groups;

#define LAS __attribute__((address_space(3)))
typedef unsigned short bf16_t;
typedef short bf16x8 __attribute__((ext_vector_type(8)));
typedef short s16x4 __attribute__((ext_vector_type(4)));
typedef float f32x4 __attribute__((ext_vector_type(4)));
typedef float f32x16 __attribute__((ext_vector_type(16)));
typedef unsigned u32x4 __attribute__((ext_vector_type(4)));
typedef unsigned u32x2 __attribute__((ext_vector_type(2)));

constexpr int NB = 8, SEQ = 4096, DM = 1024, WD = 2048, NH = 16, HD = 128, BH = NB * NH, TOK = NB * SEQ;
constexpr float EPS = 1e-6f;
constexpr size_t MiB = 1u << 20;
constexpr size_t WS_R0 = 0, WS_R1 = 128 * MiB, WS_R2 = 256 * MiB, WS_XA = 384 * MiB;
constexpr size_t WS_W1 = 448 * MiB, WS_W2 = 464 * MiB, WS_W3KV = 468 * MiB, WS_W3Q = 476 * MiB, WS_W3G = 480 * MiB, WS_W4 = 484 * MiB;
constexpr size_t WS_SM = 488 * MiB;
constexpr size_t WS_MOD0 = WS_SM, WS_MOD1 = WS_SM + 98304, WS_KVMOD = WS_SM + 196608, WS_LB = WS_SM + 262144, WS_WFL = WS_SM + 270336;
constexpr size_t WS_LSG = WS_SM + 1 * MiB, WS_DL = WS_SM + 4 * MiB;
constexpr int LDS_BYTES = 147456;

__device__ __forceinline__ float bf2f(unsigned short h) { return __uint_as_float(((unsigned)h) << 16); }
typedef float f32x2_t __attribute__((ext_vector_type(2))); typedef __bf16 bf16x2_t __attribute__((ext_vector_type(2)));
__device__ __forceinline__ unsigned cvt_pk_bf16(float lo, float hi) { f32x2_t v = {lo, hi}; bf16x2_t b = __builtin_convertvector(v, bf16x2_t); return __builtin_bit_cast(unsigned, b); }
__device__ __forceinline__ unsigned short f2bf(float f) { return (unsigned short)(cvt_pk_bf16(f, 0.f) & 0xffffu); }
__device__ __forceinline__ float wave_sum(float v) {
#pragma unroll
    for (int o = 1; o < 64; o <<= 1) v += __shfl_xor(v, o);
    return v;
}
__device__ __forceinline__ int otid(int wv) { int t = wv * 64 + (int)__builtin_amdgcn_mbcnt_hi(~0u, __builtin_amdgcn_mbcnt_lo(~0u, 0u)); asm volatile("" : "+v"(t)); return t; }
__device__ __forceinline__ float silu_f(float x) { return x * __builtin_amdgcn_rcpf(1.f + __builtin_amdgcn_exp2f(-1.4426950408889634f * x)); }

namespace pg8 {
constexpr int BM = 256, BK = 64, HALF = 128, HTB = HALF * BK * 2, STAGE_BYTES = 8 * HTB, NXCD = 8, WGM = 8;
__host__ __device__ __forceinline__ int lds_byte(int r, int c) { const int st = (r >> 4) * 2 + (c >> 5), rr = r & 15, cc = c & 31, ob = rr * 64 + cc * 2; return st * 1024 + (ob ^ (((ob >> 9) & 1) << 5)); }
__host__ __device__ __forceinline__ void stage_rc(int b, int& R, int& C) { const int st = b / 1024, sb = b % 1024, swz = sb ^ (((sb >> 9) & 1) << 5); R = (st >> 1) * 16 + swz / 64; C = (st & 1) * 32 + (swz % 64) / 2; }
__host__ __device__ __forceinline__ int perm32(int rho) { const int n = rho >> 4, i = rho & 15; return 8 * (i >> 2) + 4 * n + (i & 3); }

struct Unit { int pm, pn; };
struct Gemm { const bf16_t* A; const bf16_t* Bt; int M, N, K; unsigned lda; size_t hsA, bsA; };

struct StaticOrder {
    int nM, nN, nwg, G, c;
    __device__ void init(int M, int N, int G_, int c_) { nM = M / BM; nN = N / BM; nwg = nM * nN; G = G_; c = c_; }
    __device__ bool next(int i, Unit& u) const {
        const long L = (long)i * G + c; if (L >= nwg) return false;
        int wgid = (int)L; { const int q = nwg / NXCD, r = nwg % NXCD, xcd = wgid % NXCD, off = wgid / NXCD; wgid = (xcd < r ? xcd * (q + 1) : r * (q + 1) + (xcd - r) * q) + off; }
        const int nig = WGM * nN, gid = wgid / nig, fm = gid * WGM, gsz = (nM - fm) < WGM ? (nM - fm) : WGM;
        u.pm = fm + ((wgid % nig) % gsz); u.pn = (wgid % nig) / gsz; return true;
    }
};

struct EpiHead {
    bf16_t* base0; size_t tstride;
    __device__ __forceinline__ void operator()(const f32x4 (&acc)[2][2][4][2], const Unit& u, int wr, int wc, int fr, int fq) const {
        const int b = u.pm >> 4, s0 = (u.pm & 15) * 256 + wr * 64 + fr, t = u.pn >> 3, hd0 = (u.pn & 7) * 2;
        bf16_t* base = base0 + (size_t)t * tstride + wc * 32 + 8 * fq;
#pragma unroll
        for (int ai = 0; ai < 2; ++ai)
#pragma unroll
            for (int m = 0; m < 4; ++m)
#pragma unroll
                for (int bj = 0; bj < 2; ++bj) {
                    const f32x4 v0 = acc[ai][bj][m][0], v1 = acc[ai][bj][m][1];
                    u32x4 w; w.x = cvt_pk_bf16(v0[0], v0[1]); w.y = cvt_pk_bf16(v0[2], v0[3]); w.z = cvt_pk_bf16(v1[0], v1[1]); w.w = cvt_pk_bf16(v1[2], v1[3]);
                    *(u32x4*)(base + ((size_t)(b * 16 + hd0 + bj) * SEQ + s0 + ai * HALF + m * 16) * HD) = w;
                }
    }
};
struct EpiHeadNorm {
    bf16_t* base0; size_t tstride; int nnorm; const float* g; LAS float* xch;
    __device__ __forceinline__ void operator()(const f32x4 (&acc)[2][2][4][2], const Unit& u, int wr, int wc, int fr, int fq) const {
        const int b = u.pm >> 4, s0 = (u.pm & 15) * 256 + wr * 64 + fr, t = u.pn >> 3, hd0 = (u.pn & 7) * 2;
        bf16_t* base = base0 + (size_t)t * tstride + wc * 32 + 8 * fq;
        if (t < nnorm) {
#pragma unroll
            for (int ai = 0; ai < 2; ++ai)
#pragma unroll
                for (int m = 0; m < 4; ++m)
#pragma unroll
                    for (int bj = 0; bj < 2; ++bj) { const f32x4 v0 = acc[ai][bj][m][0], v1 = acc[ai][bj][m][1];
                        float sq = ((v0[0] * v0[0] + v0[1] * v0[1]) + (v0[2] * v0[2] + v0[3] * v0[3])) + ((v1[0] * v1[0] + v1[1] * v1[1]) + (v1[2] * v1[2] + v1[3] * v1[3]));
                        sq += __shfl_xor(sq, 16); sq += __shfl_xor(sq, 32);
                        if (fq == 0) xch[((ai * HALF + wr * 64 + m * 16 + fr) * 2 + bj) * 4 + wc] = sq; }
            asm volatile("s_waitcnt lgkmcnt(0)" ::: "memory"); __builtin_amdgcn_s_barrier(); asm volatile("" ::: "memory");
            const f32x4 g0 = *(const f32x4*)(g + wc * 32 + 8 * fq), g1 = *(const f32x4*)(g + wc * 32 + 8 * fq + 4);
#pragma unroll
            for (int ai = 0; ai < 2; ++ai)
#pragma unroll
                for (int m = 0; m < 4; ++m)
#pragma unroll
                    for (int bj = 0; bj < 2; ++bj) {
                        const f32x4 p = *(const LAS f32x4*)(xch + ((ai * HALF + wr * 64 + m * 16 + fr) * 2 + bj) * 4);
                        const float rs = __builtin_amdgcn_rsqf(((p[0] + p[1]) + (p[2] + p[3])) * (1.f / 128.f) + EPS);
                        const f32x4 v0 = acc[ai][bj][m][0] * g0 * rs, v1 = acc[ai][bj][m][1] * g1 * rs;
                        u32x4 w; w.x = cvt_pk_bf16(v0[0], v0[1]); w.y = cvt_pk_bf16(v0[2], v0[3]); w.z = cvt_pk_bf16(v1[0], v1[1]); w.w = cvt_pk_bf16(v1[2], v1[3]);
                        *(u32x4*)(base + ((size_t)(b * 16 + hd0 + bj) * SEQ + s0 + ai * HALF + m * 16) * HD) = w;
                    }
        } else {
#pragma unroll
            for (int ai = 0; ai < 2; ++ai)
#pragma unroll
                for (int m = 0; m < 4; ++m)
#pragma unroll
                    for (int bj = 0; bj < 2; ++bj) {
                        const f32x4 v0 = acc[ai][bj][m][0], v1 = acc[ai][bj][m][1];
                        u32x4 w; w.x = cvt_pk_bf16(v0[0], v0[1]); w.y = cvt_pk_bf16(v0[2], v0[3]); w.z = cvt_pk_bf16(v1[0], v1[1]); w.w = cvt_pk_bf16(v1[2], v1[3]);
                        *(u32x4*)(base + ((size_t)(b * 16 + hd0 + bj) * SEQ + s0 + ai * HALF + m * 16) * HD) = w;
                    }
        }
    }
};
struct EpiMulSilu {
    bf16_t* X;
    __device__ __forceinline__ void operator()(const f32x4 (&acc)[2][2][4][2], const Unit& u, int wr, int wc, int fr, int fq) const {
        const int b = u.pm >> 4, s0 = (u.pm & 15) * 256 + wr * 64 + fr, hd0 = (u.pn & 7) * 2;
        bf16_t* base = X + wc * 32 + 8 * fq;
        u32x4 pre[2][2];
#define EM_PTR(bt, bj) ((u32x4*)(base + ((size_t)(b * 16 + hd0 + (bj)) * SEQ + s0 + ((bt) >> 2) * HALF + ((bt) & 3) * 16) * HD))
        pre[0][0] = *EM_PTR(0, 0); pre[0][1] = *EM_PTR(0, 1);
#pragma unroll
        for (int bt = 0; bt < 8; ++bt) {
            if (bt + 1 < 8) { pre[(bt + 1) & 1][0] = *EM_PTR(bt + 1, 0); pre[(bt + 1) & 1][1] = *EM_PTR(bt + 1, 1); }
            asm volatile("" ::: "memory");
#pragma unroll
            for (int bj = 0; bj < 2; ++bj) {
                const u32x4 x = pre[bt & 1][bj]; const f32x4 v0 = acc[bt >> 2][bj][bt & 3][0], v1 = acc[bt >> 2][bj][bt & 3][1];
                u32x4 w;
                w.x = cvt_pk_bf16(__uint_as_float(x.x << 16) * silu_f(v0[0]), __uint_as_float(x.x & 0xffff0000u) * silu_f(v0[1]));
                w.y = cvt_pk_bf16(__uint_as_float(x.y << 16) * silu_f(v0[2]), __uint_as_float(x.y & 0xffff0000u) * silu_f(v0[3]));
                w.z = cvt_pk_bf16(__uint_as_float(x.z << 16) * silu_f(v1[0]), __uint_as_float(x.z & 0xffff0000u) * silu_f(v1[1]));
                w.w = cvt_pk_bf16(__uint_as_float(x.w << 16) * silu_f(v1[2]), __uint_as_float(x.w & 0xffff0000u) * silu_f(v1[3]));
                *EM_PTR(bt, bj) = w;
            }
            asm volatile("" ::: "memory");
        }
#undef EM_PTR
    }
};
struct EpiRes {
    const float* base; float* out; const float* gate;
    __device__ __forceinline__ void operator()(const f32x4 (&acc)[2][2][4][2], const Unit& u, int wr, int wc, int fr, int fq) const {
        const int b = u.pm >> 4, row0 = u.pm * BM + wr * 64 + fr, col0 = u.pn * BM + wc * 32 + 8 * fq;
        f32x4 gv[2][2];
#pragma unroll
        for (int bj = 0; bj < 2; ++bj)
#pragma unroll
            for (int n = 0; n < 2; ++n) gv[bj][n] = *(const f32x4*)(gate + (size_t)b * 3072 + col0 + bj * HALF + 4 * n);
        f32x4 pre[2][2][2][2];
#define ER_OFF(bt, mm) ((size_t)(row0 + ((bt) >> 1) * HALF + (2 * ((bt) & 1) + (mm)) * 16) * DM + col0)
#define ER_LOAD(bt, sl) do { _Pragma("unroll") for (int mm = 0; mm < 2; ++mm) _Pragma("unroll") for (int bj = 0; bj < 2; ++bj) _Pragma("unroll") for (int n = 0; n < 2; ++n) \
            pre[sl][mm][bj][n] = *(const f32x4*)(base + ER_OFF(bt, mm) + bj * HALF + 4 * n); } while (0)
        ER_LOAD(0, 0);
#pragma unroll
        for (int bt = 0; bt < 4; ++bt) {
            if (bt + 1 < 4) { if (bt & 1) ER_LOAD(bt + 1, 0); else ER_LOAD(bt + 1, 1); }
            asm volatile("" ::: "memory");
#pragma unroll
            for (int mm = 0; mm < 2; ++mm)
#pragma unroll
                for (int bj = 0; bj < 2; ++bj)
#pragma unroll
                    for (int n = 0; n < 2; ++n)
                        *(f32x4*)(out + ER_OFF(bt, mm) + bj * HALF + 4 * n) = pre[bt & 1][mm][bj][n] + gv[bj][n] * acc[bt >> 1][bj][2 * (bt & 1) + mm][n];
            asm volatile("" ::: "memory");
        }
#undef ER_OFF
#undef ER_LOAD
    }
};

template <class Epi, class Sched>
__device__ __forceinline__ void gemm_phase(LAS unsigned char* lds, const Gemm g, const Sched& S, const Epi& E, int wv) {
    const int tid = otid(wv), wid = __builtin_amdgcn_readfirstlane(tid >> 6), lane = tid & 63, wr = wid >> 2, wc = wid & 3, fr = lane & 15, fq = lane >> 4;
    const int K = g.K, nt = K / BK;
    unsigned voffA[2], voffB[2];
#pragma unroll
    for (int i = 0; i < 2; ++i) { int R, C; stage_rc(tid * 16 + i * 8192, R, C); const int Rb = (R & ~31) + perm32(R & 31);
        voffA[i] = (unsigned)R * g.lda + (unsigned)C * 2u; voffB[i] = (unsigned)(Rb * K + C) * 2u; }
    const size_t kstep = (size_t)(BK * 2);
    const size_t hstepA = (size_t)HALF * g.lda, hstepB = (size_t)HALF * K * 2, tstepB = 2 * hstepB, hsA = g.hsA;
    const unsigned ldsw = (unsigned)wid * 1024u;
    const int aoff = lds_byte(wr * 64 + fr, fq * 8), boff = lds_byte(wc * 32 + fr, fq * 8);
#define PG8_SA(b, h) (((b) * 2 + (h)) * HTB)
#define PG8_SB(b, h) ((4 + (b) * 2 + (h)) * HTB)
#define PG8_STAGE(bufoff, gbase, voff) do { _Pragma("unroll") for (int _i = 0; _i < 2; ++_i) \
        __builtin_amdgcn_global_load_lds((const unsigned*)((const char*)(gbase) + (voff)[_i]), (LAS unsigned*)(lds + (bufoff) + ldsw + _i * 8192), 16, 0, 0); } while (0)
#define PG8_LDA(dst, b, h) do { _Pragma("unroll") for (int m = 0; m < 4; ++m) _Pragma("unroll") for (int k = 0; k < 2; ++k) dst[m][k] = *(const LAS bf16x8*)(lds + PG8_SA(b, h) + aoff + m * 2048 + k * 1024); } while (0)
#define PG8_LDB(dst, b, h) do { _Pragma("unroll") for (int n = 0; n < 2; ++n) _Pragma("unroll") for (int k = 0; k < 2; ++k) dst[n][k] = *(const LAS bf16x8*)(lds + PG8_SB(b, h) + boff + n * 2048 + k * 1024); } while (0)
#define PG8_MMA(ai, bj, At, Bt) do { __builtin_amdgcn_s_setprio(1); _Pragma("unroll") for (int m = 0; m < 4; ++m) _Pragma("unroll") for (int n = 0; n < 2; ++n) _Pragma("unroll") for (int k = 0; k < 2; ++k) \
        acc[ai][bj][m][n] = __builtin_amdgcn_mfma_f32_16x16x32_bf16(Bt[n][k], At[m][k], acc[ai][bj][m][n], 0, 0, 0); __builtin_amdgcn_s_setprio(0); } while (0)
#define PG8_WAIT_V(n) asm volatile("s_waitcnt vmcnt(" #n ")" ::: "memory")
#define PG8_WAIT_L(n) asm volatile("s_waitcnt lgkmcnt(" #n ")" ::: "memory")
#define PG8_BAR __builtin_amdgcn_s_barrier()
#define PG8_SCHED __builtin_amdgcn_sched_barrier(0)
#define PG8_ATILE(u) ((const char*)g.A + (size_t)((u).pm >> 4) * g.bsA + (size_t)((u).pm & 15) * 256 * g.lda)
    Unit cur, nxt; int ui = 0;
    if (!S.next(0, cur)) return;
    f32x4 acc[2][2][4][2];
#pragma unroll
    for (int a = 0; a < 2; ++a)
#pragma unroll
        for (int b = 0; b < 2; ++b)
#pragma unroll
            for (int m = 0; m < 4; ++m)
#pragma unroll
                for (int n = 0; n < 2; ++n) acc[a][b][m][n] = (f32x4){0.f, 0.f, 0.f, 0.f};
    bf16x8 At[4][2], B0[2][2], B1[2][2];
    const char* cA = PG8_ATILE(cur); const char* cB = (const char*)g.Bt + (size_t)cur.pn * tstepB;
    PG8_STAGE(PG8_SB(0, 0), cB, voffB); PG8_STAGE(PG8_SB(0, 1), cB + hstepB, voffB); PG8_STAGE(PG8_SA(0, 0), cA, voffA); PG8_STAGE(PG8_SA(0, 1), cA + hstepA, voffA);
    if (wr == 1) PG8_BAR;
    PG8_WAIT_V(2); PG8_BAR;
    PG8_STAGE(PG8_SB(1, 0), cB + kstep, voffB); PG8_STAGE(PG8_SA(1, 0), cA + kstep, voffA); PG8_STAGE(PG8_SB(1, 1), cB + hstepB + kstep, voffB);
    PG8_WAIT_V(6); PG8_BAR;
    for (;;) {
        const bool has_next = S.next(ui + 1, nxt);
        const char* nA = has_next ? PG8_ATILE(nxt) : cA; const char* nB = has_next ? (const char*)g.Bt + (size_t)nxt.pn * tstepB : cB;
        for (int t = 0; t < nt; t += 2) {
            const bool last = (t == nt - 2);
            const char* a1 = cA + (size_t)(t >> 1) * hsA + kstep;
            const char* a2 = last ? nA : cA + (size_t)((t >> 1) + 1) * hsA; const char* b2 = last ? nB : cB + (size_t)(t + 2) * kstep;
            const char* a3 = a2 + kstep; const char* b3 = b2 + kstep;
            PG8_LDB(B0, 0, 0); PG8_LDB(B1, 0, 1); PG8_SCHED; PG8_LDA(At, 0, 0); PG8_STAGE(PG8_SA(1, 1), a1 + hstepA, voffA);
            PG8_WAIT_V(8); PG8_WAIT_L(0); PG8_BAR; PG8_MMA(0, 0, At, B0); PG8_MMA(0, 1, At, B1); PG8_BAR; PG8_SCHED;
            PG8_LDA(At, 0, 1); PG8_STAGE(PG8_SB(0, 0), b2, voffB); PG8_STAGE(PG8_SB(0, 1), b2 + hstepB, voffB); PG8_STAGE(PG8_SA(0, 0), a2, voffA);
            PG8_WAIT_V(8); PG8_WAIT_L(0); PG8_BAR; PG8_MMA(1, 0, At, B0); PG8_MMA(1, 1, At, B1); PG8_BAR; PG8_SCHED;
            PG8_LDB(B0, 1, 0); PG8_LDB(B1, 1, 1); PG8_SCHED; PG8_LDA(At, 1, 0); PG8_STAGE(PG8_SA(0, 1), a2 + hstepA, voffA);
            PG8_WAIT_V(8); PG8_WAIT_L(0); PG8_BAR; PG8_MMA(0, 0, At, B0); PG8_MMA(0, 1, At, B1); PG8_BAR; PG8_SCHED;
            PG8_LDA(At, 1, 1); PG8_STAGE(PG8_SB(1, 0), b3, voffB); PG8_STAGE(PG8_SB(1, 1), b3 + hstepB, voffB); PG8_STAGE(PG8_SA(1, 0), a3, voffA);
            PG8_WAIT_V(8); PG8_WAIT_L(0); PG8_BAR; PG8_MMA(1, 0, At, B0); PG8_MMA(1, 1, At, B1); PG8_BAR; PG8_SCHED;
        }
        if (wr == 0) PG8_BAR;
        E(acc, cur, wr, wc, fr, fq);
        if (!has_next) break;
#pragma unroll
        for (int a = 0; a < 2; ++a)
#pragma unroll
            for (int b = 0; b < 2; ++b)
#pragma unroll
                for (int m = 0; m < 4; ++m)
#pragma unroll
                    for (int n = 0; n < 2; ++n) acc[a][b][m][n] = (f32x4){0.f, 0.f, 0.f, 0.f};
        cur = nxt; cA = nA; cB = nB; ++ui;
        if (wr == 1) PG8_BAR;
    }
    PG8_WAIT_V(0);
    PG8_BAR;
#undef PG8_SA
#undef PG8_SB
#undef PG8_STAGE
#undef PG8_LDA
#undef PG8_LDB
#undef PG8_MMA
#undef PG8_WAIT_V
#undef PG8_WAIT_L
#undef PG8_BAR
#undef PG8_SCHED
#undef PG8_ATILE
}
}

namespace att {
constexpr int D = 128, NW = 8, QBLK = 32, KVBLK = 64, QB = NW * QBLK;
constexpr int SHM_V = KVBLK * D * 2, SHM_K = KVBLK * D * 2;
constexpr int OFF_WS = 2 * SHM_V + 2 * SHM_K, OFF_G = OFF_WS + NW * 64 * 4, ATT_LDS = OFF_G + 512;
constexpr float SCALE = 0.08838834764831845f, C2 = 1.4426950408889634f * SCALE, THR2 = 24.f;
#define KSWZ(row, colB) ((row) * 256 + ((colB) ^ (((row) & 7) << 4)))
#define SBAR() __builtin_amdgcn_sched_barrier(0)
__device__ __forceinline__ int v_st(int k, int c) { const int kk = (k & ~0xC) | ((k & 4) << 1) | ((k & 8) >> 1); return ((kk >> 3) * 4 + (c >> 5)) * 512 + ((kk & 7) * 32 + (c & 31)) * 2; }
__device__ __forceinline__ int v_rd_base(int lane) { return ((lane & 3) << 3) | (((lane >> 2) & 3) << 6) | (((lane >> 4) & 1) << 5) | (((lane >> 5) & 1) << 8); }
constexpr int v_rd_off(int d0, int ks, int half) { return d0 * 512 + ks * 4096 + half * 2048; }
__device__ __forceinline__ int crow(int r, int hi) { return (r & 3) + 8 * (r >> 2) + 4 * hi; }
__device__ __forceinline__ bf16x8 load8(const bf16_t* p) { return *reinterpret_cast<const bf16x8*>(p); }
__device__ __forceinline__ void mask_tile(f32x16& p0, f32x16& p1, int dq, unsigned W) {
    const float NEG = -__builtin_inff();
#pragma unroll
    for (int r = 0; r < 16; ++r) {
        const int c = (r & 3) + 8 * (r >> 2);
        if ((unsigned)(dq - c) >= W) p0[r] = NEG;
        if ((unsigned)(dq - c - 32) >= W) p1[r] = NEG;
    }
}
__device__ __forceinline__ void partialSM(f32x16& p0, f32x16& p1, float& m_reg, float& mn, float& alpha) {
    float pmax = p0[0];
#pragma unroll
    for (int r = 1; r < 16; ++r) pmax = fmaxf(pmax, p0[r]);
#pragma unroll
    for (int r = 0; r < 16; ++r) pmax = fmaxf(pmax, p1[r]);
    { auto rr = __builtin_amdgcn_permlane32_swap(__float_as_uint(pmax), __float_as_uint(pmax), false, false);
      pmax = fmaxf(__uint_as_float(rr[0]), __uint_as_float(rr[1])); }
    if (__builtin_expect(__all((pmax - m_reg) * C2 <= THR2), 1)) { mn = m_reg; alpha = 1.f; }
    else { mn = fmaxf(m_reg, pmax); alpha = __builtin_amdgcn_exp2f((m_reg - mn) * C2); m_reg = mn; }
    const float mnL = -mn * C2;
#pragma unroll
    for (int r = 0; r < 16; ++r) { p0[r] = fmaf(p0[r], C2, mnL); p1[r] = fmaf(p1[r], C2, mnL); }
#pragma unroll
    for (int r = 0; r < 16; ++r) p0[r] = __builtin_amdgcn_exp2f(p0[r]);
}
__device__ __forceinline__ void finishSM(f32x16& p0, f32x16& p1, float alpha, float& l_reg, bf16x8& pa0, bf16x8& pa1, bf16x8& pa2, bf16x8& pa3) {
#pragma unroll
    for (int r = 0; r < 16; ++r) p1[r] = __builtin_amdgcn_exp2f(p1[r]);
    float ps = 0;
#pragma unroll
    for (int r = 0; r < 16; ++r) ps += p0[r];
#pragma unroll
    for (int r = 0; r < 16; ++r) ps += p1[r];
    { auto rr = __builtin_amdgcn_permlane32_swap(__float_as_uint(ps), __float_as_uint(ps), false, false);
      ps = __uint_as_float(rr[0]) + __uint_as_float(rr[1]); }
    l_reg = l_reg * alpha + ps;
#define PK4(P, B_, OUT) do { unsigned a0 = cvt_pk_bf16(P[B_+0], P[B_+1]), a1 = cvt_pk_bf16(P[B_+2], P[B_+3]);                          \
        unsigned b0 = cvt_pk_bf16(P[B_+4], P[B_+5]), b1 = cvt_pk_bf16(P[B_+6], P[B_+7]);                                             \
        auto r0 = __builtin_amdgcn_permlane32_swap(a0, b0, false, false); auto r1 = __builtin_amdgcn_permlane32_swap(a1, b1, false, false); \
        u32x4 w = {r0[0], r1[0], r0[1], r1[1]}; OUT = *reinterpret_cast<bf16x8*>(&w); } while (0)
    PK4(p0, 0, pa0); PK4(p0, 8, pa1); PK4(p1, 0, pa2); PK4(p1, 8, pa3);
#undef PK4
}
template <int KB>
__device__ __forceinline__ void qkt(f32x16& p0, f32x16& p1, const char* K_lds, int r32, int hi, const bf16x8* qr, const float* gl) {
#pragma unroll
    for (int i = 0; i < 4; ++i) { const f32x4 g0 = *(const f32x4*)(gl + 8 * i + 4 * hi), g1 = *(const f32x4*)(gl + 32 + 8 * i + 4 * hi);
#pragma unroll
        for (int j = 0; j < 4; ++j) { p0[4 * i + j] = g0[j]; p1[4 * i + j] = g1[j]; } }
    const char* kb[4];
#pragma unroll
    for (int dd = 0; dd < 4; ++dd) kb[dd] = K_lds + KB * SHM_K + KSWZ(r32, (dd * 16 + hi * 8) * 2);
#pragma unroll
    for (int d0 = 0; d0 < 8; ++d0) { const char* a = kb[d0 & 3] + (d0 >> 2) * 128;
        bf16x8 b0 = *reinterpret_cast<const bf16x8*>(a);
        bf16x8 b1 = *reinterpret_cast<const bf16x8*>(a + 32 * 256);
        p0 = __builtin_amdgcn_mfma_f32_32x32x16_bf16(b0, qr[d0], p0, 0, 0, 0);
        p1 = __builtin_amdgcn_mfma_f32_32x32x16_bf16(b1, qr[d0], p1, 0, 0, 0); }
}
template <int VB>
__device__ __forceinline__ void pv_tile(f32x16* o, int vb0, bf16x8 pa0, bf16x8 pa1, bf16x8 pa2, bf16x8 pa3) {
#define TRRD(dst, off) asm volatile("ds_read_b64_tr_b16 %0, %1 offset:%2" : "=&v"(dst) : "v"(vb0), "i"(off) : "memory")
#define PV_D0(d0) do { s16x4 l0, l1, l2, l3, h0, h1, h2, h3; constexpr int b_ = VB * SHM_V + v_rd_off(d0, 0, 0); \
        TRRD(l0, b_); TRRD(h0, b_ + 2048); TRRD(l1, b_ + 4096); TRRD(h1, b_ + 6144); TRRD(l2, b_ + 8192); TRRD(h2, b_ + 10240); TRRD(l3, b_ + 12288); TRRD(h3, b_ + 14336); \
        asm volatile("s_waitcnt lgkmcnt(0)" ::: "memory"); SBAR();   \
        o[d0] = __builtin_amdgcn_mfma_f32_32x32x16_bf16(pa0, (bf16x8){l0[0], l0[1], l0[2], l0[3], h0[0], h0[1], h0[2], h0[3]}, o[d0], 0, 0, 0);   \
        o[d0] = __builtin_amdgcn_mfma_f32_32x32x16_bf16(pa1, (bf16x8){l1[0], l1[1], l1[2], l1[3], h1[0], h1[1], h1[2], h1[3]}, o[d0], 0, 0, 0);   \
        o[d0] = __builtin_amdgcn_mfma_f32_32x32x16_bf16(pa2, (bf16x8){l2[0], l2[1], l2[2], l2[3], h2[0], h2[1], h2[2], h2[3]}, o[d0], 0, 0, 0);   \
        o[d0] = __builtin_amdgcn_mfma_f32_32x32x16_bf16(pa3, (bf16x8){l3[0], l3[1], l3[2], l3[3], h3[0], h3[1], h3[2], h3[3]}, o[d0], 0, 0, 0); } while (0)
    PV_D0(0); PV_D0(1); PV_D0(2); PV_D0(3);
#undef PV_D0
#undef TRRD
}
struct BlockRef { const bf16_t* Q; const bf16_t* K; const bf16_t* V; const float* G; bf16_t* O; int P0, jlo; };
struct Seam { bf16x8 qr[8]; bf16x8 st_v0, st_v1, st_k0, st_k1; float sg; };
#define ROW(p, k0, rr) ((p) + (size_t)((k0) + (rr)) * D + sc)
#define VMW() asm volatile("s_waitcnt vmcnt(0)" ::: "memory")
#define VMWN(n) asm volatile("s_waitcnt vmcnt(%0)" :: "i"(n) : "memory")
#define SLOAD_H(Kp, Vp, Gp, k0) do { S.st_v0 = load8(ROW(Vp, k0, sr)); S.st_v1 = load8(ROW(Vp, k0, 32 + sr));              \
                         S.st_k0 = load8(ROW(Kp, k0, sr)); S.st_k1 = load8(ROW(Kp, k0, 32 + sr)); S.sg = (Gp)[(k0) + (tid & 63)]; } while (0)
#define SWRITE_HK(bf) do { *(bf16x8*)(K_lds + (bf) * SHM_K + kws) = S.st_k0; *(bf16x8*)(K_lds + (bf) * SHM_K + kws + 32 * 256) = S.st_k1; \
                           if (tid < 64) G_lds[(bf) * 64 + tid] = S.sg; } while (0)
#define SWRITE_HV(bf) do { *(bf16x8*)(V_lds + (bf) * SHM_V + vst0) = S.st_v0; *(bf16x8*)(V_lds + (bf) * SHM_V + vst1) = S.st_v1; } while (0)
#define SWRITE_H(bf) do { SWRITE_HV(bf); SWRITE_HK(bf); } while (0)
__device__ __forceinline__ void prime(const BlockRef& cur, char* lds, Seam& S, int wv) {
    const int tid = otid(wv), wid = __builtin_amdgcn_readfirstlane(tid >> 6), lane = tid & 63, r32 = lane & 31, hi = lane >> 5;
    const int sr = tid >> 4, sc = (tid & 15) * 8, kws = KSWZ(sr, sc * 2); char* K_lds = lds + 2 * SHM_V; float* G_lds = (float*)(lds + OFF_G);
#pragma unroll
    for (int d0 = 0; d0 < 8; ++d0) S.qr[d0] = load8(cur.Q + (size_t)(wid * QBLK + r32) * D + d0 * 16 + hi * 8);
    SLOAD_H(cur.K, cur.V, cur.G, cur.jlo * KVBLK); VMW(); SWRITE_HK(0);
    __syncthreads();
}
__device__ __forceinline__ void block(const BlockRef& cur, const BlockRef& nxt, char* lds, Seam& S, int wv) {
    const int tid = otid(wv), wid = __builtin_amdgcn_readfirstlane(tid >> 6), lane = tid & 63, r32 = lane & 31, hi = lane >> 5;
    const int W = SEQ;
    const int j_hi = (cur.P0 + QB - 1) / KVBLK + 1;
    const int j_lo = cur.jlo, NT = j_hi - j_lo, kbn = nxt.jlo * KVBLK;
    const int qlo = cur.P0 + wid * QBLK, qm = qlo + r32 - 4 * hi;
    char* V_lds = lds; char* K_lds = lds + 2 * SHM_V; float* G_lds = (float*)(lds + OFF_G);
    float* ws = (float*)(lds + OFF_WS) + wid * 64; float* li_l = ws, * al_l = ws + 32;
    float m_reg = -1e30f, l_reg = 0; f32x16 o[4] = {};
    const int sr = tid >> 4, sc = (tid & 15) * 8, vst0 = v_st(sr, sc), vst1 = v_st(32 + sr, sc), kws = KSWZ(sr, sc * 2);
    const int vb0 = (int)(uintptr_t)V_lds + v_rd_base(lane);
    const bf16_t* Kh = cur.K; const bf16_t* Vh = cur.V; const float* Gh = cur.G;
#define RESC(a) do { if (__any((a) < 1.f)) { if (hi == 0) al_l[r32] = (a); asm volatile("s_waitcnt lgkmcnt(0)" ::: "memory");              \
                     _Pragma("unroll") for (int d_ = 0; d_ < 4; ++d_) _Pragma("unroll") for (int r = 0; r < 16; ++r) o[d_][r] *= al_l[crow(r, hi)]; } } while (0)
#define KBASE(t) ((j_lo + (t)) * KVBLK)
#define MASKT(P0_, P1_, t) do { const int kb_ = KBASE(t); if (kb_ + KVBLK - 1 > qlo) mask_tile(P0_, P1_, qm - kb_, (unsigned)W); } while (0)
    constexpr int NQL = 8;
#define SEAM_K0() do { VMWN(NQL); SWRITE_HK(0); SBAR(); } while (0)
    f32x16 pA0, pA1, pB0, pB1; float mnA, mnB, alA, alB; bf16x8 pa0, pa1, pa2, pa3;
    SWRITE_HV(0); SBAR();
    if (NT > 1) SLOAD_H(Kh, Vh, Gh, KBASE(1));
    SBAR(); qkt<0>(pA0, pA1, K_lds, r32, hi, S.qr, G_lds);
    MASKT(pA0, pA1, 0); partialSM(pA0, pA1, m_reg, mnA, alA);
    if (NT > 1) { VMW(); SWRITE_H(1); }
    __syncthreads();
#define HALF_STEP(PX0, PX1, mnX, alX, PY0, PY1, alY, t, KB, VB, SB) do {                                                      \
        SBAR(); qkt<KB>(PX0, PX1, K_lds, r32, hi, S.qr, G_lds + (KB) * 64);                                             \
        finishSM(PY0, PY1, alY, l_reg, pa0, pa1, pa2, pa3); SBAR();                                                           \
        if ((t) + 1 < NT) { SLOAD_H(Kh, Vh, Gh, KBASE((t) + 1)); SBAR(); }                                               \
        pv_tile<VB>(o, vb0, pa0, pa1, pa2, pa3); MASKT(PX0, PX1, (t)); partialSM(PX0, PX1, m_reg, mnX, alX);                                        \
        __syncthreads();                                                                                                      \
        if ((t) + 1 < NT) { VMW(); SWRITE_H(SB); }                                                                          \
        RESC(alX); __syncthreads(); } while (0)
    for (int t = 1; t + 1 < NT; t += 2) {
        HALF_STEP(pB0, pB1, mnB, alB, pA0, pA1, alA, t, 1, 0, 0);
        HALF_STEP(pA0, pA1, mnA, alA, pB0, pB1, alB, t + 1, 0, 1, 1);
    }
    const bool even = (NT & 1) == 0;
    if (even) { SBAR(); qkt<1>(pB0, pB1, K_lds, r32, hi, S.qr, G_lds + 64); SBAR(); }
    SLOAD_H(nxt.K, nxt.V, nxt.G, kbn); SBAR();
#pragma unroll
    for (int d0 = 0; d0 < 8; ++d0) S.qr[d0] = load8(nxt.Q + (size_t)(wid * QBLK + r32) * D + d0 * 16 + hi * 8);
    SBAR();
    finishSM(pA0, pA1, alA, l_reg, pa0, pa1, pa2, pa3); SBAR();
    pv_tile<0>(o, vb0, pa0, pa1, pa2, pa3);
    if (even) { MASKT(pB0, pB1, NT - 1); partialSM(pB0, pB1, m_reg, mnB, alB); __syncthreads(); RESC(alB);
        finishSM(pB0, pB1, alB, l_reg, pa0, pa1, pa2, pa3); SBAR(); pv_tile<1>(o, vb0, pa0, pa1, pa2, pa3); }
    SBAR(); SEAM_K0();
    if (hi == 0) li_l[r32] = l_reg; asm volatile("s_waitcnt lgkmcnt(0)" ::: "memory");
    float rli[16];
#pragma unroll
    for (int r = 0; r < 16; ++r) rli[r] = __builtin_amdgcn_rcpf(li_l[crow(r, hi)]);
    bf16_t* Ow = cur.O + (size_t)(wid * QBLK) * D;
#pragma unroll
    for (int r = 0; r < 16; ++r) { const int orow = crow(r, hi);
#pragma unroll
        for (int d0 = 0; d0 < 4; ++d0) { const float v = o[d0][r] * rli[r];
            const float vn = __shfl_xor(v, 1);
            if ((r32 & 1) == 0) *(unsigned*)(Ow + (size_t)orow * D + d0 * 32 + r32) = cvt_pk_bf16(v, vn); } }
    __syncthreads();
#undef RESC
#undef KBASE
#undef MASKT
#undef SEAM_K0
#undef HALF_STEP
}
#undef ROW
#undef VMW
#undef VMWN
#undef SLOAD_H
#undef SWRITE_HK
#undef SWRITE_HV
#undef SWRITE_H
struct Item { int bh, qb0, qb1; };
__device__ __forceinline__ Item decode(int L) {
    const int c = L & 255, i = L >> 8, xcd = c & 7, cc = c >> 3, gi = (cc & 1) + 2 * i, qb = ((cc >> 1) + 2 * i + (i >> 2)) & 15;
    Item it; it.bh = ((xcd - gi) & 7) * 16 + gi; it.qb0 = qb; it.qb1 = qb; return it;
}
__device__ __forceinline__ BlockRef mkref(const Item& it, int pass, const bf16_t* Q, const bf16_t* K, const bf16_t* V, const float* G, const int* JLO, bf16_t* O, bf16_t* Odummy, bool dummy) {
    const int qb = pass ? it.qb1 : it.qb0; BlockRef r;
    r.Q = Q + ((size_t)it.bh * SEQ + (size_t)qb * QB) * D; r.O = dummy ? Odummy : O + ((size_t)it.bh * SEQ + (size_t)qb * QB) * D;
    r.K = K + (size_t)it.bh * SEQ * D; r.V = V + (size_t)it.bh * SEQ * D; r.G = G + (size_t)it.bh * SEQ; r.P0 = qb * QB; r.jlo = JLO[it.bh * 16 + qb]; return r;
}
__device__ __forceinline__ void phase(char* lds, const bf16_t* Q, const bf16_t* K, const bf16_t* V, const float* G, const int* JLO, bf16_t* O, bf16_t* Odummy, int total, int wv) {
    const int stride = gridDim.x;
    int L = blockIdx.x; if (L >= total) return;
    Item it = decode(L); int pass = 0;
    BlockRef cur = mkref(it, 0, Q, K, V, G, JLO, O, Odummy, false);
    Seam S;
    prime(cur, lds, S, wv);
    for (;;) {
        const bool more_pass = pass == 0 && it.qb1 != it.qb0, more_item = L + stride < total, last = !more_pass && !more_item;
        Item itn = it; int passn = pass + 1, Ln = L;
        if (!more_pass) { passn = 0; Ln = more_item ? L + stride : L; itn = decode(Ln); }
        const BlockRef nxt = last ? cur : mkref(itn, passn, Q, K, V, G, JLO, O, Odummy, false);
        block(cur, nxt, lds, S, wv);
        if (last) break;
        cur = nxt; it = itn; pass = passn; L = Ln;
    }
}
#undef SBAR
}

struct Args {
    const float *x, *c, *mod_w, *mod_b, *norm_g, *a_w_in, *a_lb, *a_onorm_g, *a_w_out, *kv_mod_w, *kv_mod_b, *kv_norm_g, *kv_w, *kv_fb, *k_norm_g, *b_w_in, *b_q_norm_g, *b_w_out;
    float* out; unsigned char* ws; int one, pad;
};

__device__ __forceinline__ void transpose_item(const float* W, int K, int ldw, int N, bf16_t* WT, float* scr, int item, int lane) {
    const int nblk = N / 32, kb = item / nblk, nb = item % nblk, k0 = 64 * kb, n0 = 32 * nb;
#pragma unroll 8
    for (int i = 0; i < 32; ++i) { const int kk = 2 * i + (lane >> 5); scr[kk * 33 + (lane & 31)] = W[(size_t)(k0 + kk) * ldw + n0 + (lane & 31)]; }
    asm volatile("s_waitcnt lgkmcnt(0)" ::: "memory");
    const int c = lane & 7;
#pragma unroll
    for (int j = 0; j < 4; ++j) { const int n = (lane >> 3) + 8 * j; const float* s = scr + (8 * c) * 33 + n;
        u32x4 o; o.x = cvt_pk_bf16(s[0 * 33], s[1 * 33]); o.y = cvt_pk_bf16(s[2 * 33], s[3 * 33]); o.z = cvt_pk_bf16(s[4 * 33], s[5 * 33]); o.w = cvt_pk_bf16(s[6 * 33], s[7 * 33]);
        *(u32x4*)(WT + (size_t)(n0 + n) * K + k0 + 8 * c) = o; }
    asm volatile("s_waitcnt lgkmcnt(0)" ::: "memory");
}

__device__ __forceinline__ void p0_prologue(const Args& a, char* lds, int wv) {
    const int tid = otid(wv), lane = tid & 63, wave = tid >> 6, G = gridDim.x;
    unsigned char* ws = a.ws;
    float* sc = (float*)lds;
    float* red = (float*)(lds + 32768);
    for (int i = tid; i < NB * DM; i += 512) sc[i] = silu_f(a.c[i]);
    __syncthreads();
    for (int cgp = blockIdx.x; cgp < 256; cgp += G) {
        const int n0 = cgp * 32; const float* Wm; const float* bias; float* outp; int ldn, nloc;
        if (n0 < 3072) { Wm = a.mod_w; bias = a.mod_b; outp = (float*)(ws + WS_MOD0); ldn = 3072; nloc = n0; }
        else if (n0 < 6144) { Wm = a.mod_w + (size_t)DM * 3072; bias = a.mod_b + 3072; outp = (float*)(ws + WS_MOD1); ldn = 3072; nloc = n0 - 3072; }
        else { Wm = a.kv_mod_w; bias = a.kv_mod_b; outp = (float*)(ws + WS_KVMOD); ldn = 2048; nloc = n0 - 6144; }
        const int col = lane & 31, ksub = wave * 2 + (lane >> 5);
        float accb[8];
#pragma unroll
        for (int b = 0; b < 8; ++b) accb[b] = 0.f;
#pragma unroll 8
        for (int kk = 0; kk < 64; ++kk) { const int k = ksub * 64 + kk; const float w = Wm[(size_t)k * ldn + nloc + col];
#pragma unroll
            for (int b = 0; b < 8; ++b) accb[b] = fmaf(sc[b * DM + k], w, accb[b]); }
#pragma unroll
        for (int b = 0; b < 8; ++b) red[(ksub * 8 + b) * 32 + col] = accb[b];
        __syncthreads();
        if (tid < 256) { const int b = tid >> 5, cc = tid & 31; float s = bias[nloc + cc];
#pragma unroll
            for (int j = 0; j < 16; ++j) s += red[(j * 8 + b) * 32 + cc];
            outp[(size_t)b * ldn + nloc + cc] = s; }
        __syncthreads();
    }
    const int gtid = blockIdx.x * 512 + tid, NT = G * 512;
    for (int j = gtid; j < WD; j += NT) ((float*)(ws + WS_LB))[j] = 1.f / (1.f + __expf(a.a_lb[WD + j] - a.a_lb[j]));
    for (int i = gtid; i < NH * DM; i += NT) { const int h = i >> 10, k = i & 1023; ((float*)(ws + WS_WFL))[i] = a.kv_w[(size_t)k * 4112 + 4096 + h]; }
    __syncthreads();
    float* scr = (float*)(lds + wave * 16384);
    const int gw = blockIdx.x * 8 + wave, NGW = G * 8;
    constexpr int I1 = 16 * 256, I2 = 32 * 32, I3 = 16 * 128, I4 = 16 * 128, I5 = 32 * 32, NIT = I1 + I2 + I3 + I4 + I5;
    for (int it = gw; it < NIT; it += NGW) {
        int r = it;
        if (r < I1) { transpose_item(a.a_w_in, 1024, 8192, 8192, (bf16_t*)(ws + WS_W1), scr, r, lane); continue; } r -= I1;
        if (r < I2) { transpose_item(a.a_w_out, 2048, 1024, 1024, (bf16_t*)(ws + WS_W2), scr, r, lane); continue; } r -= I2;
        if (r < I3) { transpose_item(a.kv_w, 1024, 4112, 4096, (bf16_t*)(ws + WS_W3KV), scr, r, lane); continue; } r -= I3;
        if (r < I4) { transpose_item(a.b_w_in, 1024, 4096, 4096, (bf16_t*)(ws + WS_W3Q), scr, r, lane); continue; } r -= I4;
        transpose_item(a.b_w_out, 2048, 1024, 1024, (bf16_t*)(ws + WS_W4), scr, r, lane);
    }
}

template <bool FL, bool DUAL>
__device__ __forceinline__ void norm_phase(const float* x, const float* g, const float* shiftp, const float* scalep, int mstride, bf16_t* outp,
                                           const float* g2, const float* shiftp2, const float* scalep2, int mstride2, bf16_t* outp2,
                                           const float* wfl_g, const float* fb, float* LS, char* lds, int wv) {
    const int tid = otid(wv), lane = tid & 63, wave = tid >> 6;
    float* wfl = (float*)lds;
    if (FL) { for (int i = tid; i < NH * DM / 4; i += 512) ((f32x4*)wfl)[i] = ((const f32x4*)wfl_g)[i]; __syncthreads(); }
    const int gw = blockIdx.x * 8 + wave, NGW = gridDim.x * 8, rpw = (((TOK + NGW - 1) / NGW) + 3) & ~3;
    int curb = -1; f32x4 al[4], be[4], al2[4], be2[4];
    for (int i0 = 0; i0 < rpw; i0 += 4) {
        const int m0 = gw * rpw + i0; if (m0 >= TOK) break;
        const int b = m0 >> 12;
        if (b != curb) { curb = b;
#pragma unroll
            for (int j = 0; j < 4; ++j) { const int col = 4 * lane + 256 * j; const f32x4 gg = *(const f32x4*)(g + col), sc = *(const f32x4*)(scalep + (size_t)b * mstride + col);
                al[j] = gg * (sc + 1.f); be[j] = *(const f32x4*)(shiftp + (size_t)b * mstride + col);
                if (DUAL) { const f32x4 gg2 = *(const f32x4*)(g2 + col), sc2 = *(const f32x4*)(scalep2 + (size_t)b * mstride2 + col);
                    al2[j] = gg2 * (sc2 + 1.f); be2[j] = *(const f32x4*)(shiftp2 + (size_t)b * mstride2 + col); } } }
        f32x4 v[4][4];
#pragma unroll
        for (int q = 0; q < 4; ++q) { const f32x4* xr = (const f32x4*)(x + (size_t)(m0 + q) * DM) + lane;
#pragma unroll
            for (int j = 0; j < 4; ++j) v[q][j] = xr[64 * j]; }
#pragma unroll
        for (int q = 0; q < 4; ++q) { float s2 = 0.f;
#pragma unroll
            for (int j = 0; j < 4; ++j) s2 += (v[q][j].x * v[q][j].x + v[q][j].y * v[q][j].y) + (v[q][j].z * v[q][j].z + v[q][j].w * v[q][j].w);
            const float rstd = __builtin_amdgcn_rsqf(wave_sum(s2) * (1.f / DM) + EPS);
            unsigned long long* o8 = (unsigned long long*)(outp + (size_t)(m0 + q) * DM) + lane;
            unsigned long long* o82 = (unsigned long long*)(outp2 + (size_t)(m0 + q) * DM) + lane;
#pragma unroll
            for (int j = 0; j < 4; ++j) { const f32x4 xh = v[q][j] * rstd;
                if (DUAL) { const f32x4 w2 = xh * al2[j] + be2[j];
                    o82[64 * j] = (unsigned long long)cvt_pk_bf16(w2.x, w2.y) | ((unsigned long long)cvt_pk_bf16(w2.z, w2.w) << 32); }
                v[q][j] = xh * al[j] + be[j];
                o8[64 * j] = (unsigned long long)cvt_pk_bf16(v[q][j].x, v[q][j].y) | ((unsigned long long)cvt_pk_bf16(v[q][j].z, v[q][j].w) << 32); } }
        if (FL) {
            float mine[4] = {0.f, 0.f, 0.f, 0.f};
#pragma unroll 2
            for (int h = 0; h < NH; ++h) { f32x4 w[4];
#pragma unroll
                for (int j = 0; j < 4; ++j) w[j] = *(const f32x4*)(wfl + h * DM + 4 * lane + 256 * j);
#pragma unroll
                for (int q = 0; q < 4; ++q) { float p = 0.f;
#pragma unroll
                    for (int j = 0; j < 4; ++j) p += (v[q][j].x * w[j].x + v[q][j].y * w[j].y) + (v[q][j].z * w[j].z + v[q][j].w * w[j].w);
                    p = wave_sum(p); if (lane == h) mine[q] = p; } }
            if (lane < NH) { const float fbv = fb[lane];
#pragma unroll
                for (int q = 0; q < 4; ++q) { const float z = mine[q] + fbv; const float ls = z < 0.f ? z - log1pf(__expf(z)) : -log1pf(__expf(-z));
                    LS[(size_t)(b * NH + lane) * SEQ + ((m0 + q) & (SEQ - 1))] = ls; } }
        }
    }
}

__device__ __forceinline__ void cumsum_phase(float* LS, int* JLO, const float* kg, const float* qg, char* lds, int wv) {
    const int tid = otid(wv), lane = tid & 63, wave = tid >> 6; float* wtot = (float*)lds; float* gl = (float*)(lds + 1024);
    float mk = fmaxf(fabsf(kg[lane]), fabsf(kg[lane + 64])), mq = fmaxf(fabsf(qg[lane]), fabsf(qg[lane + 64]));
#pragma unroll
    for (int o = 1; o < 64; o <<= 1) { mk = fmaxf(mk, __shfl_xor(mk, o)); mq = fmaxf(mq, __shfl_xor(mq, o)); }
    const float TH = (40.f + 2.f * (1.05f * 128.f * 1.4426950408889634f * 0.08838834764831845f * mk * mq)) / (1.4426950408889634f * 0.08838834764831845f);
    for (int bh = blockIdx.x; bh < BH; bh += gridDim.x) {
        float* p = LS + (size_t)bh * SEQ + tid * 8; f32x4 a = *(f32x4*)p, b = *(f32x4*)(p + 4);
        float v[8] = {a.x, a.y, a.z, a.w, b.x, b.y, b.z, b.w};
#pragma unroll
        for (int i = 1; i < 8; ++i) v[i] += v[i - 1];
        float run = v[7];
#pragma unroll
        for (int o = 1; o < 64; o <<= 1) { const float t = __shfl_up(run, o); if (lane >= o) run += t; }
        if (lane == 63) wtot[wave] = run;
        __syncthreads();
        float off = run - v[7];
        for (int w = 0; w < wave; ++w) off += wtot[w];
        const float k = -11.313708498984761f;
        a = (f32x4){(v[0] + off) * k, (v[1] + off) * k, (v[2] + off) * k, (v[3] + off) * k}; b = (f32x4){(v[4] + off) * k, (v[5] + off) * k, (v[6] + off) * k, (v[7] + off) * k};
        *(f32x4*)p = a; *(f32x4*)(p + 4) = b;
        *(f32x4*)(gl + tid * 8) = a; *(f32x4*)(gl + tid * 8 + 4) = b;
        __syncthreads();
#pragma unroll
        for (int rep = 0; rep < 2; ++rep) { const int qb = wave + 8 * rep, P0 = qb * 256;
            const bool skip = (64 * lane + 63 < P0) && (gl[P0] - gl[64 * lane + 63] > TH);
            const unsigned long long mask = __ballot(skip);
            if (lane == 0) JLO[bh * 16 + qb] = __popcll(mask); }
        __syncthreads();
    }
}

__device__ __forceinline__ void p4_scan(const Args& a, char* lds, int dry, int wv) {
    const int tid = otid(wv), lane = tid & 63, w = tid >> 6, r = lane & 15, gq = lane >> 4, vg = w & 3, kh = w >> 2;
    unsigned char* ws = a.ws;
    bf16_t* R0 = (bf16_t*)(ws + WS_R0); const bf16_t* R1 = (const bf16_t*)(ws + WS_R1); const bf16_t* R2 = (const bf16_t*)(ws + WS_R2);
    const float* LB = (const float*)(ws + WS_LB);
    constexpr int BUF = 45568, O_QD = 0, O_KT = 17408, O_AT = 35840, O_DL = 45056, O_XS = 2 * BUF, O_PART = O_XS + 32768, O_V = O_PART + 2048;
    typedef short v4i16_t __attribute__((ext_vector_type(4)));
    const LAS char* const vtr0 = (const LAS char*)(LAS unsigned char*)(lds) + O_V + (8 * gq + (r >> 2)) * 272 + (32 * vg + 4 * (r & 3)) * 2;
    const int pk0 = 4 * (tid & 31), prg = tid >> 5, pc0 = 4 * prg;
    bf16_t* const tf = (bf16_t*)(lds + O_V);
    for (int bh = blockIdx.x; bh < BH; bh += gridDim.x) {
        const int h = bh & 15;
        const f32x4 og0 = *(const f32x4*)(a.a_onorm_g + h * HD + 32 * vg + 4 * gq), og1 = *(const f32x4*)(a.a_onorm_g + h * HD + 32 * vg + 16 + 4 * gq);
        const f32x4 lbv4 = *(const f32x4*)(LB + h * HD + pk0), om4 = 1.f - lbv4;
        f32x4 st[4][2];
#pragma unroll
        for (int i = 0; i < 4; ++i) { st[i][0] = (f32x4){0.f, 0.f, 0.f, 0.f}; st[i][1] = (f32x4){0.f, 0.f, 0.f, 0.f}; }
        u32x4 sqA[2], sfA[2], svA[2], sqB[2], sfB[2], svB[2]; bf16x8 vb[2][2];
        char* const xs_own = lds + O_XS + w * 4096 + lane * 16; const char* const xs_par = lds + O_XS + (w ^ 4) * 4096 + lane * 16;
        { const u32x4 z = {0u, 0u, 0u, 0u};
#pragma unroll
          for (int f = 0; f < 4; ++f) *(u32x4*)(xs_own + f * 1024) = z; }
#define P4_LOAD(X, n_) do { const size_t blk_ = ((size_t)bh * SEQ + (size_t)(n_) * 64) * HD; \
            _Pragma("unroll") for (int rep = 0; rep < 2; ++rep) { const int i = tid + rep * 512; sq##X[rep] = *(const u32x4*)(R0 + blk_ + (size_t)i * 8); sf##X[rep] = *(const u32x4*)(R1 + blk_ + (size_t)i * 8); sv##X[rep] = *(const u32x4*)(R2 + blk_ + (size_t)i * 8); } } while (0)
#define P4_WRITE_RAW(X, bf_) do { char* B_ = lds + (bf_) * BUF; \
            _Pragma("unroll") for (int rep = 0; rep < 2; ++rep) { const int i = tid + rep * 512; *(u32x4*)(B_ + O_QD + (i >> 4) * 272 + (i & 15) * 16) = sq##X[rep]; *(u32x4*)(lds + O_V + (i >> 4) * 272 + (i & 15) * 16) = sf##X[rep]; } } while (0)
#define P4_WRITE_V(X) do { _Pragma("unroll") for (int rep = 0; rep < 2; ++rep) { const int i = tid + rep * 512; *(u32x4*)(lds + O_V + (i >> 4) * 272 + (i & 15) * 16) = sv##X[rep]; } } while (0)
#define P4_PREP(X, bf_) do { char* B_ = lds + (bf_) * BUF; bf16_t* tq = (bf16_t*)(B_ + O_QD); float* part2 = (float*)(B_ + O_AT); \
              \
            float ee[4][4]; f32x4 run = {1.f, 1.f, 1.f, 1.f}; \
            _Pragma("unroll") for (int i = 0; i < 4; ++i) { u32x2* pf = (u32x2*)(tf + (pc0 + i) * 136 + pk0); const u32x2 wz = *pf; \
                const f32x4 fz = {__uint_as_float(wz.x << 16), __uint_as_float(wz.x & 0xffff0000u), __uint_as_float(wz.y << 16), __uint_as_float(wz.y & 0xffff0000u)}; f32x4 kq; \
                _Pragma("unroll") for (int j = 0; j < 4; ++j) { const float sg = __builtin_amdgcn_rcpf(1.f + __expf(-fz[j])); const float f = lbv4[j] + om4[j] * sg; run[j] *= f; ee[i][j] = run[j]; kq[j] = 1.f - f; } \
                u32x2 wk; wk.x = cvt_pk_bf16(kq[0], kq[1]); wk.y = cvt_pk_bf16(kq[2], kq[3]); *pf = wk; } \
            *(f32x4*)(part2 + prg * 128 + pk0) = run; \
            __syncthreads(); \
            if (tid < 32) { f32x4 pa_ = {1.f, 1.f, 1.f, 1.f};     \
                _Pragma("unroll") for (int g = 0; g < 16; ++g) { f32x4* pp_ = (f32x4*)(part2 + g * 128 + 4 * tid); const f32x4 pg = *pp_; *pp_ = pa_; pa_ = pa_ * pg; } \
                *(f32x4*)(part2 + 16 * 128 + 4 * tid) = pa_; } \
            __syncthreads(); \
            const f32x4 offp = *(const f32x4*)(part2 + prg * 128 + pk0), totp = *(const f32x4*)(part2 + 16 * 128 + pk0); \
            float ks_[4][4]; \
            _Pragma("unroll") for (int i = 0; i < 4; ++i) { u32x2* pq = (u32x2*)(tq + (pc0 + i) * 136 + pk0); u32x2* pf = (u32x2*)(tf + (pc0 + i) * 136 + pk0); const u32x2 wq = *pq, wk = *pf; \
                const f32x4 qv = {__uint_as_float(wq.x << 16), __uint_as_float(wq.x & 0xffff0000u), __uint_as_float(wq.y << 16), __uint_as_float(wq.y & 0xffff0000u)}; \
                const f32x4 kv = {__uint_as_float(wk.x << 16), __uint_as_float(wk.x & 0xffff0000u), __uint_as_float(wk.y << 16), __uint_as_float(wk.y & 0xffff0000u)}; f32x4 qd, ki; \
                _Pragma("unroll") for (int j = 0; j < 4; ++j) { const float ea = offp[j] * ee[i][j]; const float ie = __builtin_amdgcn_rcpf(ea); qd[j] = qv[j] * ea; ki[j] = kv[j] * ie; ks_[j][i] = ki[j] * totp[j]; } \
                u32x2 o1, o2; o1.x = cvt_pk_bf16(qd[0], qd[1]); o1.y = cvt_pk_bf16(qd[2], qd[3]); o2.x = cvt_pk_bf16(ki[0], ki[1]); o2.y = cvt_pk_bf16(ki[2], ki[3]); *pq = o1; *pf = o2; } \
            _Pragma("unroll") for (int j = 0; j < 4; ++j) { u32x2 wk; wk.x = cvt_pk_bf16(ks_[j][0], ks_[j][1]); wk.y = cvt_pk_bf16(ks_[j][2], ks_[j][3]); *(u32x2*)(B_ + O_KT + (pk0 + j) * 144 + pc0 * 2) = wk; } \
            if (prg == 0) *(f32x4*)(B_ + O_DL + pk0 * 4) = totp; \
            __syncthreads(); \
            { const int mt = w >> 1, nt0 = (w & 1) * 2; f32x4 acc2[2] = {{0.f, 0.f, 0.f, 0.f}, {0.f, 0.f, 0.f, 0.f}}; \
              _Pragma("unroll") for (int ks = 0; ks < 4; ++ks) { const bf16x8 Aq = *(const bf16x8*)(tq + (16 * mt + r) * 136 + ks * 32 + gq * 8); \
                  _Pragma("unroll") for (int j = 0; j < 2; ++j) { const bf16x8 Bk = *(const bf16x8*)(tf + (16 * (nt0 + j) + r) * 136 + ks * 32 + gq * 8); \
                      acc2[j] = __builtin_amdgcn_mfma_f32_16x16x32_bf16(Aq, Bk, acc2[j], 0, 0, 0); } } \
              bf16_t* ap = (bf16_t*)(B_ + O_AT); \
              __syncthreads();     \
              _Pragma("unroll") for (int j = 0; j < 2; ++j) { const int s_ = 16 * (nt0 + j) + r; \
                  _Pragma("unroll") for (int rg = 0; rg < 4; ++rg) { const int c = 16 * mt + 4 * gq + rg; ap[c * 72 + s_] = (s_ <= c) ? f2bf(acc2[j][rg]) : (bf16_t)0; } } } \
            P4_WRITE_V(X); \
            __syncthreads(); } while (0)
#define P4_PACK(DST, ksl, vt) do { u32x4 bw_; bw_.x = cvt_pk_bf16(st[2 * (ksl)][vt][0], st[2 * (ksl)][vt][1]); bw_.y = cvt_pk_bf16(st[2 * (ksl)][vt][2], st[2 * (ksl)][vt][3]); \
            bw_.z = cvt_pk_bf16(st[2 * (ksl) + 1][vt][0], st[2 * (ksl) + 1][vt][1]); bw_.w = cvt_pk_bf16(st[2 * (ksl) + 1][vt][2], st[2 * (ksl) + 1][vt][3]); DST = bw_; } while (0)
#define P4_STEP(n_, CUR, X, Y) do { const char* B = lds + (CUR) * BUF; \
            _Pragma("unroll") for (int vt = 0; vt < 2; ++vt) _Pragma("unroll") for (int cs = 0; cs < 2; ++cs) { \
                const v4i16_t lo_ = __builtin_amdgcn_ds_read_tr16_b64_v4i16((LAS v4i16_t*)(vtr0 + cs * 32 * 272 + vt * 32)); \
                const v4i16_t hi_ = __builtin_amdgcn_ds_read_tr16_b64_v4i16((LAS v4i16_t*)(vtr0 + cs * 32 * 272 + vt * 32 + 4 * 272)); \
                vb[vt][cs] = (bf16x8){lo_[0], lo_[1], lo_[2], lo_[3], hi_[0], hi_[1], hi_[2], hi_[3]}; } \
            P4_LOAD(X, ((n_) + 2 < 64) ? (n_) + 2 : 63); \
            f32x4 oo[2][2]; \
            _Pragma("unroll") for (int ml = 0; ml < 2; ++ml) { oo[ml][0] = (f32x4){0.f, 0.f, 0.f, 0.f}; oo[ml][1] = (f32x4){0.f, 0.f, 0.f, 0.f}; \
                _Pragma("unroll") for (int ks = 0; ks < 2; ++ks) { const bf16x8 Bq = *(const bf16x8*)(B + O_AT + (32 * kh + 16 * ml + r) * 144 + ks * 64 + gq * 16); \
                    _Pragma("unroll") for (int vt = 0; vt < 2; ++vt) oo[ml][vt] = __builtin_amdgcn_mfma_f32_16x16x32_bf16(vb[vt][ks], Bq, oo[ml][vt], 0, 0, 0); } } \
            _Pragma("unroll") for (int hf = 0; hf < 2; ++hf) _Pragma("unroll") for (int ksl = 0; ksl < 2; ++ksl) { const int ksg = 2 * (hf == 0 ? kh : 1 - kh) + ksl; u32x4 sf_[2]; \
                _Pragma("unroll") for (int vt = 0; vt < 2; ++vt) { if (hf == 0) P4_PACK(sf_[vt], ksl, vt); else sf_[vt] = *(const u32x4*)(xs_par + (ksl * 2 + vt) * 1024); } \
                _Pragma("unroll") for (int ml = 0; ml < 2; ++ml) { const char* qa = B + O_QD + (32 * kh + 16 * ml + r) * 272 + ksg * 64 + gq * 8; \
                    const u32x2 a0 = *(const u32x2*)qa, a1 = *(const u32x2*)(qa + 32); const u32x4 aw = {a0.x, a0.y, a1.x, a1.y}; \
                    _Pragma("unroll") for (int vt = 0; vt < 2; ++vt) oo[ml][vt] = __builtin_amdgcn_mfma_f32_16x16x32_bf16(__builtin_bit_cast(bf16x8, sf_[vt]), __builtin_bit_cast(bf16x8, aw), oo[ml][vt], 0, 0, 0); } } \
            float* part = (float*)(lds + O_PART) + (CUR) * 256; \
            _Pragma("unroll") for (int ml = 0; ml < 2; ++ml) { float s_ = 0.f; \
                _Pragma("unroll") for (int vt = 0; vt < 2; ++vt) s_ += (oo[ml][vt][0] * oo[ml][vt][0] + oo[ml][vt][1] * oo[ml][vt][1]) + (oo[ml][vt][2] * oo[ml][vt][2] + oo[ml][vt][3] * oo[ml][vt][3]); \
                s_ += __shfl_xor(s_, 16); s_ += __shfl_xor(s_, 32); if (gq == 0) part[(32 * kh + 16 * ml + r) * 4 + vg] = s_; } \
            _Pragma("unroll") for (int i = 0; i < 4; ++i) { const f32x4 dlv = *(const f32x4*)(B + O_DL + (64 * kh + 16 * i + 4 * gq) * 4); st[i][0] = st[i][0] * dlv; st[i][1] = st[i][1] * dlv; \
                _Pragma("unroll") for (int cs = 0; cs < 2; ++cs) { const bf16x8 A = *(const bf16x8*)(B + O_KT + (64 * kh + 16 * i + r) * 144 + cs * 64 + gq * 16); \
                    _Pragma("unroll") for (int vt = 0; vt < 2; ++vt) st[i][vt] = __builtin_amdgcn_mfma_f32_16x16x32_bf16(A, vb[vt][cs], st[i][vt], 0, 0, 0); } } \
            __syncthreads(); \
            _Pragma("unroll") for (int ksl = 0; ksl < 2; ++ksl) _Pragma("unroll") for (int vt = 0; vt < 2; ++vt) { u32x4 t_; P4_PACK(t_, ksl, vt); *(u32x4*)(xs_own + (ksl * 2 + vt) * 1024) = t_; } \
            P4_WRITE_RAW(Y, (CUR) ^ 1); \
            __syncthreads(); \
            { bf16_t* op = R0 + ((size_t)bh * SEQ + (size_t)(n_) * 64) * HD + 32 * vg + 4 * gq; \
              _Pragma("unroll") for (int ml = 0; ml < 2; ++ml) { const int c = 32 * kh + 16 * ml + r; const f32x4 p0 = *(const f32x4*)(part + c * 4); \
                const float rs = __builtin_amdgcn_rsqf(((p0.x + p0.y) + (p0.z + p0.w)) * (1.f / HD) + EPS); \
                const f32x4 ov0 = oo[ml][0] * og0 * rs, ov1 = oo[ml][1] * og1 * rs; u32x2 pk0, pk1; pk0.x = cvt_pk_bf16(ov0[0], ov0[1]); pk0.y = cvt_pk_bf16(ov0[2], ov0[3]); pk1.x = cvt_pk_bf16(ov1[0], ov1[1]); pk1.y = cvt_pk_bf16(ov1[2], ov1[3]); \
                if (!dry) { *(u32x2*)(op + (size_t)c * HD) = pk0; *(u32x2*)(op + (size_t)c * HD + 16) = pk1; } else asm volatile("" :: "v"(pk0), "v"(pk1)); } } \
            P4_PREP(Y, (CUR) ^ 1); } while (0)
        P4_LOAD(A, 0); P4_LOAD(B, 1); P4_WRITE_RAW(A, 0);
        __syncthreads();
        P4_PREP(A, 0);
        for (int n = 0; n < 64; n += 2) { P4_STEP(n, 0, A, B); P4_STEP(n + 1, 1, B, A); }
        __syncthreads();
#undef P4_LOAD
#undef P4_WRITE_RAW
#undef P4_WRITE_V
#undef P4_PREP
#undef P4_PACK
#undef P4_STEP
    }
}

#define XB_TMO      128
#define XB_XCNT(j)  (256  + 64 * (j))
#define XB_XSUB(j)  (1280 + 64 * (j))
#define XB_XGEN(j)  (2304 + 64 * (j))
#define XB_TOP      3328
#define XB_TOPGEN   3392
#define XCD_BAR_WORDS 3456
#define XB_SPIN_CAP (1u << 22)
__device__ __forceinline__ unsigned xb_ld(unsigned* p)              { return __hip_atomic_load(p, __ATOMIC_RELAXED, __HIP_MEMORY_SCOPE_AGENT); }
__device__ __forceinline__ unsigned xb_add(unsigned* p, unsigned v) { return __hip_atomic_fetch_add(p, v, __ATOMIC_RELAXED, __HIP_MEMORY_SCOPE_AGENT); }
__device__ __forceinline__ unsigned xb_xcc_id() { return (unsigned)__builtin_amdgcn_s_getreg((3 << 11) | 20) & 0xFu; }
#define XB_SPIN(cond, bar) do { unsigned _sp = 0; while (cond) { __builtin_amdgcn_s_sleep(1); \
    if ((++_sp & 255u) == 0u) { if (xb_ld(&(bar)[XB_TMO])) break; if (_sp > XB_SPIN_CAP) { atomicAdd(&(bar)[XB_TMO], 1u); break; } } } } while (0)
struct XcdBarrier { unsigned* bar; unsigned x; volatile LAS unsigned* st; };
__device__ __forceinline__ XcdBarrier xcd_barrier_post(unsigned* bar, volatile LAS unsigned* st) {
    XcdBarrier b; b.bar = bar; b.x = xb_xcc_id(); b.st = st;
    if (threadIdx.x == 0) (void)xb_add(&bar[XB_XCNT(b.x)], 1u);
    return b;
}
__device__ __forceinline__ void xcd_barrier_complete(unsigned* bar, unsigned x, unsigned& nloc, unsigned& nx) {
    const unsigned G = gridDim.x * gridDim.y * gridDim.z;
    unsigned sum, cnt, mine, sp = 0u;
    for (;;) {
        sum = 0u; cnt = 0u; mine = 0u;
#pragma unroll
        for (unsigned j = 0; j < 16; ++j) { const unsigned c = xb_ld(&bar[XB_XCNT(j)]); sum += c; cnt += (c > 0u) ? 1u : 0u; mine = (j == x) ? c : mine; }
        if (sum == G) break;
        __builtin_amdgcn_s_sleep(1);
        if ((++sp & 255u) == 0u) { if (xb_ld(&bar[XB_TMO])) break; if (sp > XB_SPIN_CAP) { atomicAdd(&bar[XB_TMO], 1u); break; } }
    }
    nloc = mine > 0u ? mine : 1u; nx = cnt > 0u ? cnt : 1u;
}
__device__ __forceinline__ void xcd_barrier(unsigned* bar_, volatile LAS unsigned* st_, int wv) {
    const int tid0 = otid(wv);
    asm volatile("" : "+s"(bar_));
    XcdBarrier b; b.bar = bar_; b.st = st_; b.x = 0;
    asm volatile("s_waitcnt vmcnt(0)" ::: "memory");
    __syncthreads();
    if (tid0 == 0) {
        unsigned* bar = b.bar; b.x = xb_xcc_id();
        __builtin_amdgcn_s_waitcnt(0);
        unsigned nloc = b.st[0], nx = b.st[1];
        if (nloc == 0u) { xcd_barrier_complete(bar, b.x, nloc, nx); b.st[0] = nloc; b.st[1] = nx; }
        const unsigned old = xb_add(&bar[XB_XSUB(b.x)], 1u);
        const unsigned gen = old / nloc;
        if (old + 1u == (gen + 1u) * nloc) {
            __builtin_amdgcn_fence(__ATOMIC_RELEASE, "agent");
            asm volatile("s_waitcnt vmcnt(0)" ::: "memory");
            const unsigned og = xb_add(&bar[XB_TOP], 1u);
            const unsigned tg = og / nx;
            if (og + 1u == (tg + 1u) * nx) xb_add(&bar[XB_TOPGEN], 1u);
            else XB_SPIN(xb_ld(&bar[XB_TOPGEN]) == tg, bar);
            __builtin_amdgcn_fence(__ATOMIC_ACQUIRE, "agent");
            xb_add(&bar[XB_XGEN(b.x)], 1u);
            asm volatile("s_waitcnt vmcnt(0)" ::: "memory");
        } else {
            XB_SPIN(xb_ld(&bar[XB_XGEN(b.x)]) == gen, bar);
            __builtin_amdgcn_fence(__ATOMIC_ACQUIRE, "agent");
            asm volatile("s_waitcnt vmcnt(0)" ::: "memory");
        }
    }
    __syncthreads();
}

__global__ void __launch_bounds__(512, 2) yoco_fwd(Args a) {
    extern __shared__ __attribute__((aligned(16))) unsigned char lds_raw[];
    char* lds = (char*)lds_raw; LAS unsigned char* ldsl = (LAS unsigned char*)lds_raw;
    cg::grid_group grid = cg::this_grid();
    const int wv = __builtin_amdgcn_readfirstlane((int)threadIdx.x >> 6);
    unsigned char* ws = a.ws;
    bf16_t* R0 = (bf16_t*)(ws + WS_R0); bf16_t* R1 = (bf16_t*)(ws + WS_R1); bf16_t* R2 = (bf16_t*)(ws + WS_R2);
    bf16_t* XA = (bf16_t*)(ws + WS_XA); bf16_t* H0 = (bf16_t*)a.out;
    const float* MOD0 = (const float*)(ws + WS_MOD0); const float* MOD1 = (const float*)(ws + WS_MOD1); const float* KVMOD = (const float*)(ws + WS_KVMOD);
    float* LSG = (float*)(ws + WS_LSG);
    const int G = gridDim.x, c = blockIdx.x;
    constexpr size_t TS = 64 * MiB;

    unsigned* barw = (unsigned*)(ws + WS_SM + 786432);
    volatile LAS unsigned* bst = (volatile LAS unsigned*)(ldsl + 143360);
    if (threadIdx.x == 0) { bst[0] = 0u; bst[1] = 0u; }
    if (a.one == 0) grid.sync();
    (void)xcd_barrier_post(barw, bst);
#define GSYNC() xcd_barrier((unsigned*)(a.ws + WS_SM + 786432), (volatile LAS unsigned*)(ldsl + 143360), wv)
    p0_prologue(a, lds, wv);
    GSYNC();
    norm_phase<false, false>(a.x, a.norm_g, MOD0, MOD0 + 1024, 3072, H0, nullptr, nullptr, nullptr, 0, nullptr, nullptr, nullptr, nullptr, lds, wv);
    GSYNC();
    { pg8::Gemm g{H0, (const bf16_t*)(ws + WS_W1), TOK, 6144, DM, 2048u, 256, (size_t)4096 * 2048}; pg8::StaticOrder S; S.init(TOK, 6144, G, c);
      pg8::EpiHead E{R0, TS}; pg8::gemm_phase(ldsl, g, S, E, wv);
    }
    GSYNC();
    p4_scan(a, lds, 0, wv);
    GSYNC();
    { pg8::Gemm g{H0, (const bf16_t*)(ws + WS_W1) + (size_t)6144 * DM, TOK, 2048, DM, 2048u, 256, (size_t)4096 * 2048}; pg8::StaticOrder S; S.init(TOK, 2048, G, c);
      pg8::EpiMulSilu E{R0}; pg8::gemm_phase(ldsl, g, S, E, wv); }
    GSYNC();
    { pg8::Gemm g{R0, (const bf16_t*)(ws + WS_W2), TOK, DM, WD, 256u, (size_t)SEQ * 256, (size_t)16 * SEQ * 256}; pg8::StaticOrder S; S.init(TOK, DM, G, c);
      pg8::EpiRes E{a.x, a.out, MOD0 + 2048}; pg8::gemm_phase(ldsl, g, S, E, wv);
    }
    GSYNC();
    norm_phase<true, true>(a.out, a.kv_norm_g, KVMOD, KVMOD + 1024, 2048, R0, a.norm_g + DM, MOD1, MOD1 + 1024, 3072, XA, (const float*)(ws + WS_WFL), a.kv_fb, LSG, lds, wv);
    GSYNC();
    cumsum_phase(LSG, (int*)(ws + WS_SM + 802816), a.k_norm_g, a.b_q_norm_g, lds, wv);
    { pg8::Gemm g{R0, (const bf16_t*)(ws + WS_W3KV), TOK, 4096, DM, 2048u, 256, (size_t)4096 * 2048}; pg8::StaticOrder S; S.init(TOK, 4096, G, c);
      pg8::EpiHeadNorm E{R1, TS, 1, a.k_norm_g, (LAS float*)(ldsl + 131072)}; pg8::gemm_phase(ldsl, g, S, E, wv);
    }
    GSYNC();
    { pg8::Gemm g{XA, (const bf16_t*)(ws + WS_W3Q), TOK, 2048, DM, 2048u, 256, (size_t)4096 * 2048}; pg8::StaticOrder S; S.init(TOK, 2048, G, c);
      pg8::EpiHeadNorm E{R0, TS, 1, a.b_q_norm_g, (LAS float*)(ldsl + 131072)}; pg8::gemm_phase(ldsl, g, S, E, wv); }
    GSYNC();
    att::phase(lds, R0, R1, R2, LSG, (const int*)(ws + WS_SM + 802816), R0, (bf16_t*)(ws + WS_SM + 716800), 2048, wv);
    GSYNC();
    { pg8::Gemm g{XA, (const bf16_t*)(ws + WS_W3G), TOK, 2048, DM, 2048u, 256, (size_t)4096 * 2048}; pg8::StaticOrder S; S.init(TOK, 2048, G, c);
      pg8::EpiMulSilu E{R0}; pg8::gemm_phase(ldsl, g, S, E, wv); }
    GSYNC();
    { pg8::Gemm g{R0, (const bf16_t*)(ws + WS_W4), TOK, DM, WD, 256u, (size_t)SEQ * 256, (size_t)16 * SEQ * 256}; pg8::StaticOrder S; S.init(TOK, DM, G, c);
      pg8::EpiRes E{a.out, a.out, MOD1 + 2048}; pg8::gemm_phase(ldsl, g, S, E, wv); }
}

extern "C" void kernel_launch(void* const* d_in, const int* in_sizes, int n_in, void* d_out, int out_size, void* d_ws, size_t ws_size, hipStream_t stream) {
    static int grid = 0;
    if (grid == 0) {
        int dev = 0, cus = 0, per_cu = 0;
        hipGetDevice(&dev); hipDeviceGetAttribute(&cus, hipDeviceAttributeMultiprocessorCount, dev);
        hipFuncSetAttribute((const void*)yoco_fwd, hipFuncAttributeMaxDynamicSharedMemorySize, LDS_BYTES);
        hipOccupancyMaxActiveBlocksPerMultiprocessor(&per_cu, (const void*)yoco_fwd, 512, LDS_BYTES);
        (void)hipGetLastError();
        if (cus <= 0) cus = 256;
        grid = cus;
        if (per_cu < 1) fprintf(stderr, "kernel_launch: occupancy query reports %d blocks/CU\n", per_cu);
        if (ws_size < 512 * MiB) fprintf(stderr, "kernel_launch: workspace too small (%zu)\n", ws_size);
    }
    if (hipMemsetAsync((char*)d_ws + WS_SM + 786432, 0, 16384, stream) != hipSuccess) fprintf(stderr, "kernel_launch: memset of barrier words failed\n");
    Args a{};
    const float** pp = (const float**)&a;
    for (int i = 0; i < 18; ++i) pp[i] = (const float*)d_in[i];
    a.out = (float*)d_out; a.ws = (unsigned char*)d_ws; a.one = 1;
    void* args[] = {&a};
    hipError_t e = hipLaunchCooperativeKernel((const void*)yoco_fwd, dim3(grid), dim3(512), args, LDS_BYTES, stream);
    if (e != hipSuccess) fprintf(stderr, "cooperative launch failed: %s (grid %d)\n", hipGetErrorString(e), grid);
}
```

```cpp
#include <hip/hip_runtime.h>
#include <hip/hip_cooperative_groups.h>
#include <cstdio>
#include <cstdint>
namespace cg = cooperative_groups;

#define LAS __attribute__((address_space(3)))
typedef unsigned short bf16_t;
typedef short bf16x8 __attribute__((ext_vector_type(8)));
typedef short s16x4 __attribute__((ext_vector_type(4)));
typedef float f32x4 __attribute__((ext_vector_type(4)));
typedef float f32x16 __attribute__((ext_vector_type(16)));
typedef unsigned u32x4 __attribute__((ext_vector_type(4)));
typedef unsigned u32x2 __attribute__((ext_vector_type(2)));

constexpr int NB = 8, SEQ = 4096, DM = 1024, WD = 2048, NH = 16, HD = 128, BH = NB * NH, TOK = NB * SEQ;
constexpr float EPS = 1e-6f;
constexpr size_t MiB = 1u << 20;
constexpr size_t WS_R0 = 0, WS_R1 = 128 * MiB, WS_R2 = 256 * MiB, WS_XA = 384 * MiB;
constexpr size_t WS_W1 = 448 * MiB, WS_W2 = 464 * MiB, WS_W3KV = 468 * MiB, WS_W3Q = 476 * MiB, WS_W3G = 480 * MiB, WS_W4 = 484 * MiB;
constexpr size_t WS_SM = 488 * MiB;
constexpr size_t WS_MOD0 = WS_SM, WS_MOD1 = WS_SM + 98304, WS_KVMOD = WS_SM + 196608, WS_LB = WS_SM + 262144, WS_WFL = WS_SM + 270336;
constexpr size_t WS_LSG = WS_SM + 1 * MiB, WS_DL = WS_SM + 4 * MiB;
constexpr int LDS_BYTES = 147456;

__device__ __forceinline__ float bf2f(unsigned short h) { return __uint_as_float(((unsigned)h) << 16); }
typedef float f32x2_t __attribute__((ext_vector_type(2))); typedef __bf16 bf16x2_t __attribute__((ext_vector_type(2)));
__device__ __forceinline__ unsigned cvt_pk_bf16(float lo, float hi) { f32x2_t v = {lo, hi}; bf16x2_t b = __builtin_convertvector(v, bf16x2_t); return __builtin_bit_cast(unsigned, b); }
__device__ __forceinline__ unsigned short f2bf(float f) { return (unsigned short)(cvt_pk_bf16(f, 0.f) & 0xffffu); }
__device__ __forceinline__ float wave_sum(float v) {
#pragma unroll
    for (int o = 1; o < 64; o <<= 1) v += __shfl_xor(v, o);
    return v;
}
__device__ __forceinline__ int otid(int wv) { int t = wv * 64 + (int)__builtin_amdgcn_mbcnt_hi(~0u, __builtin_amdgcn_mbcnt_lo(~0u, 0u)); asm volatile("" : "+v"(t)); return t; }
__device__ __forceinline__ float silu_f(float x) { return x * __builtin_amdgcn_rcpf(1.f + __builtin_amdgcn_exp2f(-1.4426950408889634f * x)); }

namespace pg8 {
constexpr int BM = 256, BK = 64, HALF = 128, HTB = HALF * BK * 2, STAGE_BYTES = 8 * HTB, NXCD = 8, WGM = 8;
__host__ __device__ __forceinline__ int lds_byte(int r, int c) { const int st = (r >> 4) * 2 + (c >> 5), rr = r & 15, cc = c & 31, ob = rr * 64 + cc * 2; return st * 1024 + (ob ^ (((ob >> 9) & 1) << 5)); }
__host__ __device__ __forceinline__ void stage_rc(int b, int& R, int& C) { const int st = b / 1024, sb = b % 1024, swz = sb ^ (((sb >> 9) & 1) << 5); R = (st >> 1) * 16 + swz / 64; C = (st & 1) * 32 + (swz % 64) / 2; }
__host__ __device__ __forceinline__ int perm32(int rho) { const int n = rho >> 4, i = rho & 15; return 8 * (i >> 2) + 4 * n + (i & 3); }

struct Unit { int pm, pn; };
struct Gemm { const bf16_t* A; const bf16_t* Bt; int M, N, K; unsigned lda; size_t hsA, bsA; };

struct StaticOrder {
    int nM, nN, nwg, G, c;
    __device__ void init(int M, int N, int G_, int c_) { nM = M / BM; nN = N / BM; nwg = nM * nN; G = G_; c = c_; }
    __device__ bool next(int i, Unit& u) const {
        const long L = (long)i * G + c; if (L >= nwg) return false;
        int wgid = (int)L; { const int q = nwg / NXCD, r = nwg % NXCD, xcd = wgid % NXCD, off = wgid / NXCD; wgid = (xcd < r ? xcd * (q + 1) : r * (q + 1) + (xcd - r) * q) + off; }
        const int nig = WGM * nN, gid = wgid / nig, fm = gid * WGM, gsz = (nM - fm) < WGM ? (nM - fm) : WGM;
        u.pm = fm + ((wgid % nig) % gsz); u.pn = (wgid % nig) / gsz; return true;
    }
};

struct EpiHead {
    bf16_t* base0; size_t tstride;
    __device__ __forceinline__ void operator()(const f32x4 (&acc)[2][2][4][2], const Unit& u, int wr, int wc, int fr, int fq) const {
        const int b = u.pm >> 4, s0 = (u.pm & 15) * 256 + wr * 64 + fr, t = u.pn >> 3, hd0 = (u.pn & 7) * 2;
        bf16_t* base = base0 + (size_t)t * tstride + wc * 32 + 8 * fq;
#pragma unroll
        for (int ai = 0; ai < 2; ++ai)
#pragma unroll
            for (int m = 0; m < 4; ++m)
#pragma unroll
                for (int bj = 0; bj < 2; ++bj) {
                    const f32x4 v0 = acc[ai][bj][m][0], v1 = acc[ai][bj][m][1];
                    u32x4 w; w.x = cvt_pk_bf16(v0[0], v0[1]); w.y = cvt_pk_bf16(v0[2], v0[3]); w.z = cvt_pk_bf16(v1[0], v1[1]); w.w = cvt_pk_bf16(v1[2], v1[3]);
                    *(u32x4*)(base + ((size_t)(b * 16 + hd0 + bj) * SEQ + s0 + ai * HALF + m * 16) * HD) = w;
                }
    }
};
struct EpiHeadNorm {
    bf16_t* base0; size_t tstride; int nnorm; const float* g; LAS float* xch;
    __device__ __forceinline__ void operator()(const f32x4 (&acc)[2][2][4][2], const Unit& u, int wr, int wc, int fr, int fq) const {
        const int b = u.pm >> 4, s0 = (u.pm & 15) * 256 + wr * 64 + fr, t = u.pn >> 3, hd0 = (u.pn & 7) * 2;
        bf16_t* base = base0 + (size_t)t * tstride + wc * 32 + 8 * fq;
        if (t < nnorm) {
#pragma unroll
            for (int ai = 0; ai < 2; ++ai)
#pragma unroll
                for (int m = 0; m < 4; ++m)
#pragma unroll
                    for (int bj = 0; bj < 2; ++bj) { const f32x4 v0 = acc[ai][bj][m][0], v1 = acc[ai][bj][m][1];
                        float sq = ((v0[0] * v0[0] + v0[1] * v0[1]) + (v0[2] * v0[2] + v0[3] * v0[3])) + ((v1[0] * v1[0] + v1[1] * v1[1]) + (v1[2] * v1[2] + v1[3] * v1[3]));
                        sq += __shfl_xor(sq, 16); sq += __shfl_xor(sq, 32);
                        if (fq == 0) xch[((ai * HALF + wr * 64 + m * 16 + fr) * 2 + bj) * 4 + wc] = sq; }
            asm volatile("s_waitcnt lgkmcnt(0)" ::: "memory"); __builtin_amdgcn_s_barrier(); asm volatile("" ::: "memory");
            const f32x4 g0 = *(const f32x4*)(g + wc * 32 + 8 * fq), g1 = *(const f32x4*)(g + wc * 32 + 8 * fq + 4);
#pragma unroll
            for (int ai = 0; ai < 2; ++ai)
#pragma unroll
                for (int m = 0; m < 4; ++m)
#pragma unroll
                    for (int bj = 0; bj < 2; ++bj) {
                        const f32x4 p = *(const LAS f32x4*)(xch + ((ai * HALF + wr * 64 + m * 16 + fr) * 2 + bj) * 4);
                        const float rs = __builtin_amdgcn_rsqf(((p[0] + p[1]) + (p[2] + p[3])) * (1.f / 128.f) + EPS);
                        const f32x4 v0 = acc[ai][bj][m][0] * g0 * rs, v1 = acc[ai][bj][m][1] * g1 * rs;
                        u32x4 w; w.x = cvt_pk_bf16(v0[0], v0[1]); w.y = cvt_pk_bf16(v0[2], v0[3]); w.z = cvt_pk_bf16(v1[0], v1[1]); w.w = cvt_pk_bf16(v1[2], v1[3]);
                        *(u32x4*)(base + ((size_t)(b * 16 + hd0 + bj) * SEQ + s0 + ai * HALF + m * 16) * HD) = w;
                    }
        } else {
#pragma unroll
            for (int ai = 0; ai < 2; ++ai)
#pragma unroll
                for (int m = 0; m < 4; ++m)
#pragma unroll
                    for (int bj = 0; bj < 2; ++bj) {
                        const f32x4 v0 = acc[ai][bj][m][0], v1 = acc[ai][bj][m][1];
                        u32x4 w; w.x = cvt_pk_bf16(v0[0], v0[1]); w.y = cvt_pk_bf16(v0[2], v0[3]); w.z = cvt_pk_bf16(v1[0], v1[1]); w.w = cvt_pk_bf16(v1[2], v1[3]);
                        *(u32x4*)(base + ((size_t)(b * 16 + hd0 + bj) * SEQ + s0 + ai * HALF + m * 16) * HD) = w;
                    }
        }
    }
};
struct EpiMulSilu {
    bf16_t* X;
    __device__ __forceinline__ void operator()(const f32x4 (&acc)[2][2][4][2], const Unit& u, int wr, int wc, int fr, int fq) const {
        const int b = u.pm >> 4, s0 = (u.pm & 15) * 256 + wr * 64 + fr, hd0 = (u.pn & 7) * 2;
        bf16_t* base = X + wc * 32 + 8 * fq;
        u32x4 pre[2][2];
#define EM_PTR(bt, bj) ((u32x4*)(base + ((size_t)(b * 16 + hd0 + (bj)) * SEQ + s0 + ((bt) >> 2) * HALF + ((bt) & 3) * 16) * HD))
        pre[0][0] = *EM_PTR(0, 0); pre[0][1] = *EM_PTR(0, 1);
#pragma unroll
        for (int bt = 0; bt < 8; ++bt) {
            if (bt + 1 < 8) { pre[(bt + 1) & 1][0] = *EM_PTR(bt + 1, 0); pre[(bt + 1) & 1][1] = *EM_PTR(bt + 1, 1); }
            asm volatile("" ::: "memory");
#pragma unroll
            for (int bj = 0; bj < 2; ++bj) {
                const u32x4 x = pre[bt & 1][bj]; const f32x4 v0 = acc[bt >> 2][bj][bt & 3][0], v1 = acc[bt >> 2][bj][bt & 3][1];
                u32x4 w;
                w.x = cvt_pk_bf16(__uint_as_float(x.x << 16) * silu_f(v0[0]), __uint_as_float(x.x & 0xffff0000u) * silu_f(v0[1]));
                w.y = cvt_pk_bf16(__uint_as_float(x.y << 16) * silu_f(v0[2]), __uint_as_float(x.y & 0xffff0000u) * silu_f(v0[3]));
                w.z = cvt_pk_bf16(__uint_as_float(x.z << 16) * silu_f(v1[0]), __uint_as_float(x.z & 0xffff0000u) * silu_f(v1[1]));
                w.w = cvt_pk_bf16(__uint_as_float(x.w << 16) * silu_f(v1[2]), __uint_as_float(x.w & 0xffff0000u) * silu_f(v1[3]));
                *EM_PTR(bt, bj) = w;
            }
            asm volatile("" ::: "memory");
        }
#undef EM_PTR
    }
};
struct EpiRes {
    const float* base; float* out; const float* gate;
    __device__ __forceinline__ void operator()(const f32x4 (&acc)[2][2][4][2], const Unit& u, int wr, int wc, int fr, int fq) const {
        const int b = u.pm >> 4, row0 = u.pm * BM + wr * 64 + fr, col0 = u.pn * BM + wc * 32 + 8 * fq;
        f32x4 gv[2][2];
#pragma unroll
        for (int bj = 0; bj < 2; ++bj)
#pragma unroll
            for (int n = 0; n < 2; ++n) gv[bj][n] = *(const f32x4*)(gate + (size_t)b * 3072 + col0 + bj * HALF + 4 * n);
        f32x4 pre[2][2][2][2];
#define ER_OFF(bt, mm) ((size_t)(row0 + ((bt) >> 1) * HALF + (2 * ((bt) & 1) + (mm)) * 16) * DM + col0)
#define ER_LOAD(bt, sl) do { _Pragma("unroll") for (int mm = 0; mm < 2; ++mm) _Pragma("unroll") for (int bj = 0; bj < 2; ++bj) _Pragma("unroll") for (int n = 0; n < 2; ++n) \
            pre[sl][mm][bj][n] = *(const f32x4*)(base + ER_OFF(bt, mm) + bj * HALF + 4 * n); } while (0)
        ER_LOAD(0, 0);
#pragma unroll
        for (int bt = 0; bt < 4; ++bt) {
            if (bt + 1 < 4) { if (bt & 1) ER_LOAD(bt + 1, 0); else ER_LOAD(bt + 1, 1); }
            asm volatile("" ::: "memory");
#pragma unroll
            for (int mm = 0; mm < 2; ++mm)
#pragma unroll
                for (int bj = 0; bj < 2; ++bj)
#pragma unroll
                    for (int n = 0; n < 2; ++n)
                        *(f32x4*)(out + ER_OFF(bt, mm) + bj * HALF + 4 * n) = pre[bt & 1][mm][bj][n] + gv[bj][n] * acc[bt >> 1][bj][2 * (bt & 1) + mm][n];
            asm volatile("" ::: "memory");
        }
#undef ER_OFF
#undef ER_LOAD
    }
};

template <class Epi, class Sched>
__device__ __forceinline__ void gemm_phase(LAS unsigned char* lds, const Gemm g, const Sched& S, const Epi& E, int wv) {
    const int tid = otid(wv), wid = __builtin_amdgcn_readfirstlane(tid >> 6), lane = tid & 63, wr = wid >> 2, wc = wid & 3, fr = lane & 15, fq = lane >> 4;
    const int K = g.K, nt = K / BK;
    unsigned voffA[2], voffB[2];
#pragma unroll
    for (int i = 0; i < 2; ++i) { int R, C; stage_rc(tid * 16 + i * 8192, R, C); const int Rb = (R & ~31) + perm32(R & 31);
        voffA[i] = (unsigned)R * g.lda + (unsigned)C * 2u; voffB[i] = (unsigned)(Rb * K + C) * 2u; }
    const size_t kstep = (size_t)(BK * 2);
    const size_t hstepA = (size_t)HALF * g.lda, hstepB = (size_t)HALF * K * 2, tstepB = 2 * hstepB, hsA = g.hsA;
    const unsigned ldsw = (unsigned)wid * 1024u;
    const int aoff = lds_byte(wr * 64 + fr, fq * 8), boff = lds_byte(wc * 32 + fr, fq * 8);
#define PG8_SA(b, h) (((b) * 2 + (h)) * HTB)
#define PG8_SB(b, h) ((4 + (b) * 2 + (h)) * HTB)
#define PG8_STAGE(bufoff, gbase, voff) do { _Pragma("unroll") for (int _i = 0; _i < 2; ++_i) \
        __builtin_amdgcn_global_load_lds((const unsigned*)((const char*)(gbase) + (voff)[_i]), (LAS unsigned*)(lds + (bufoff) + ldsw + _i * 8192), 16, 0, 0); } while (0)
#define PG8_LDA(dst, b, h) do { _Pragma("unroll") for (int m = 0; m < 4; ++m) _Pragma("unroll") for (int k = 0; k < 2; ++k) dst[m][k] = *(const LAS bf16x8*)(lds + PG8_SA(b, h) + aoff + m * 2048 + k * 1024); } while (0)
#define PG8_LDB(dst, b, h) do { _Pragma("unroll") for (int n = 0; n < 2; ++n) _Pragma("unroll") for (int k = 0; k < 2; ++k) dst[n][k] = *(const LAS bf16x8*)(lds + PG8_SB(b, h) + boff + n * 2048 + k * 1024); } while (0)
#define PG8_MMA(ai, bj, At, Bt) do { __builtin_amdgcn_s_setprio(1); _Pragma("unroll") for (int m = 0; m < 4; ++m) _Pragma("unroll") for (int n = 0; n < 2; ++n) _Pragma("unroll") for (int k = 0; k < 2; ++k) \
        acc[ai][bj][m][n] = __builtin_amdgcn_mfma_f32_16x16x32_bf16(Bt[n][k], At[m][k], acc[ai][bj][m][n], 0, 0, 0); __builtin_amdgcn_s_setprio(0); } while (0)
#define PG8_WAIT_V(n) asm volatile("s_waitcnt vmcnt(" #n ")" ::: "memory")
#define PG8_WAIT_L(n) asm volatile("s_waitcnt lgkmcnt(" #n ")" ::: "memory")
#define PG8_BAR __builtin_amdgcn_s_barrier()
#define PG8_SCHED __builtin_amdgcn_sched_barrier(0)
#define PG8_ATILE(u) ((const char*)g.A + (size_t)((u).pm >> 4) * g.bsA + (size_t)((u).pm & 15) * 256 * g.lda)
    Unit cur, nxt; int ui = 0;
    if (!S.next(0, cur)) return;
    f32x4 acc[2][2][4][2];
#pragma unroll
    for (int a = 0; a < 2; ++a)
#pragma unroll
        for (int b = 0; b < 2; ++b)
#pragma unroll
            for (int m = 0; m < 4; ++m)
#pragma unroll
                for (int n = 0; n < 2; ++n) acc[a][b][m][n] = (f32x4){0.f, 0.f, 0.f, 0.f};
    bf16x8 At[4][2], B0[2][2], B1[2][2];
    const char* cA = PG8_ATILE(cur); const char* cB = (const char*)g.Bt + (size_t)cur.pn * tstepB;
    PG8_STAGE(PG8_SB(0, 0), cB, voffB); PG8_STAGE(PG8_SB(0, 1), cB + hstepB, voffB); PG8_STAGE(PG8_SA(0, 0), cA, voffA); PG8_STAGE(PG8_SA(0, 1), cA + hstepA, voffA);
    if (wr == 1) PG8_BAR;
    PG8_WAIT_V(2); PG8_BAR;
    PG8_STAGE(PG8_SB(1, 0), cB + kstep, voffB); PG8_STAGE(PG8_SA(1, 0), cA + kstep, voffA); PG8_STAGE(PG8_SB(1, 1), cB + hstepB + kstep, voffB);
    PG8_WAIT_V(6); PG8_BAR;
    for (;;) {
        const bool has_next = S.next(ui + 1, nxt);
        const char* nA = has_next ? PG8_ATILE(nxt) : cA; const char* nB = has_next ? (const char*)g.Bt + (size_t)nxt.pn * tstepB : cB;
        for (int t = 0; t < nt; t += 2) {
            const bool last = (t == nt - 2);
            const char* a1 = cA + (size_t)(t >> 1) * hsA + kstep;
            const char* a2 = last ? nA : cA + (size_t)((t >> 1) + 1) * hsA; const char* b2 = last ? nB : cB + (size_t)(t + 2) * kstep;
            const char* a3 = a2 + kstep; const char* b3 = b2 + kstep;
            PG8_LDB(B0, 0, 0); PG8_LDB(B1, 0, 1); PG8_SCHED; PG8_LDA(At, 0, 0); PG8_STAGE(PG8_SA(1, 1), a1 + hstepA, voffA);
            PG8_WAIT_V(8); PG8_WAIT_L(0); PG8_BAR; PG8_MMA(0, 0, At, B0); PG8_MMA(0, 1, At, B1); PG8_BAR; PG8_SCHED;
            PG8_LDA(At, 0, 1); PG8_STAGE(PG8_SB(0, 0), b2, voffB); PG8_STAGE(PG8_SB(0, 1), b2 + hstepB, voffB); PG8_STAGE(PG8_SA(0, 0), a2, voffA);
            PG8_WAIT_V(8); PG8_WAIT_L(0); PG8_BAR; PG8_MMA(1, 0, At, B0); PG8_MMA(1, 1, At, B1); PG8_BAR; PG8_SCHED;
            PG8_LDB(B0, 1, 0); PG8_LDB(B1, 1, 1); PG8_SCHED; PG8_LDA(At, 1, 0); PG8_STAGE(PG8_SA(0, 1), a2 + hstepA, voffA);
            PG8_WAIT_V(8); PG8_WAIT_L(0); PG8_BAR; PG8_MMA(0, 0, At, B0); PG8_MMA(0, 1, At, B1); PG8_BAR; PG8_SCHED;
            PG8_LDA(At, 1, 1); PG8_STAGE(PG8_SB(1, 0), b3, voffB); PG8_STAGE(PG8_SB(1, 1), b3 + hstepB, voffB); PG8_STAGE(PG8_SA(1, 0), a3, voffA);
            PG8_WAIT_V(8); PG8_WAIT_L(0); PG8_BAR; PG8_MMA(1, 0, At, B0); PG8_MMA(1, 1, At, B1); PG8_BAR; PG8_SCHED;
        }
        if (wr == 0) PG8_BAR;
        E(acc, cur, wr, wc, fr, fq);
        if (!has_next) break;
#pragma unroll
        for (int a = 0; a < 2; ++a)
#pragma unroll
            for (int b = 0; b < 2; ++b)
#pragma unroll
                for (int m = 0; m < 4; ++m)
#pragma unroll
                    for (int n = 0; n < 2; ++n) acc[a][b][m][n] = (f32x4){0.f, 0.f, 0.f, 0.f};
        cur = nxt; cA = nA; cB = nB; ++ui;
        if (wr == 1) PG8_BAR;
    }
    PG8_WAIT_V(0);
    PG8_BAR;
#undef PG8_SA
#undef PG8_SB
#undef PG8_STAGE
#undef PG8_LDA
#undef PG8_LDB
#undef PG8_MMA
#undef PG8_WAIT_V
#undef PG8_WAIT_L
#undef PG8_BAR
#undef PG8_SCHED
#undef PG8_ATILE
}
}

namespace att {
constexpr int D = 128, NW = 8, QBLK = 32, KVBLK = 64, QB = NW * QBLK;
constexpr int SHM_V = KVBLK * D * 2, SHM_K = KVBLK * D * 2;
constexpr int OFF_WS = 2 * SHM_V + 2 * SHM_K, OFF_G = OFF_WS + NW * 64 * 4, ATT_LDS = OFF_G + 512;
constexpr float SCALE = 0.08838834764831845f, C2 = 1.4426950408889634f * SCALE, THR2 = 24.f;
#define KSWZ(row, colB) ((row) * 256 + ((colB) ^ (((row) & 7) << 4)))
#define SBAR() __builtin_amdgcn_sched_barrier(0)
__device__ __forceinline__ int v_st(int k, int c) { const int kk = (k & ~0xC) | ((k & 4) << 1) | ((k & 8) >> 1); return ((kk >> 3) * 4 + (c >> 5)) * 512 + ((kk & 7) * 32 + (c & 31)) * 2; }
__device__ __forceinline__ int v_rd_base(int lane) { return ((lane & 3) << 3) | (((lane >> 2) & 3) << 6) | (((lane >> 4) & 1) << 5) | (((lane >> 5) & 1) << 8); }
constexpr int v_rd_off(int d0, int ks, int half) { return d0 * 512 + ks * 4096 + half * 2048; }
__device__ __forceinline__ int crow(int r, int hi) { return (r & 3) + 8 * (r >> 2) + 4 * hi; }
__device__ __forceinline__ bf16x8 load8(const bf16_t* p) { return *reinterpret_cast<const bf16x8*>(p); }
__device__ __forceinline__ void mask_tile(f32x16& p0, f32x16& p1, int dq, unsigned W) {
    const float NEG = -__builtin_inff();
#pragma unroll
    for (int r = 0; r < 16; ++r) {
        const int c = (r & 3) + 8 * (r >> 2);
        if ((unsigned)(dq - c) >= W) p0[r] = NEG;
        if ((unsigned)(dq - c - 32) >= W) p1[r] = NEG;
    }
}
__device__ __forceinline__ void partialSM(f32x16& p0, f32x16& p1, float& m_reg, float& mn, float& alpha) {
    float pmax = p0[0];
#pragma unroll
    for (int r = 1; r < 16; ++r) pmax = fmaxf(pmax, p0[r]);
#pragma unroll
    for (int r = 0; r < 16; ++r) pmax = fmaxf(pmax, p1[r]);
    { auto rr = __builtin_amdgcn_permlane32_swap(__float_as_uint(pmax), __float_as_uint(pmax), false, false);
      pmax = fmaxf(__uint_as_float(rr[0]), __uint_as_float(rr[1])); }
    if (__builtin_expect(__all((pmax - m_reg) * C2 <= THR2), 1)) { mn = m_reg; alpha = 1.f; }
    else { mn = fmaxf(m_reg, pmax); alpha = __builtin_amdgcn_exp2f((m_reg - mn) * C2); m_reg = mn; }
    const float mnL = -mn * C2;
#pragma unroll
    for (int r = 0; r < 16; ++r) { p0[r] = fmaf(p0[r], C2, mnL); p1[r] = fmaf(p1[r], C2, mnL); }
#pragma unroll
    for (int r = 0; r < 16; ++r) p0[r] = __builtin_amdgcn_exp2f(p0[r]);
}
__device__ __forceinline__ void finishSM(f32x16& p0, f32x16& p1, float alpha, float& l_reg, bf16x8& pa0, bf16x8& pa1, bf16x8& pa2, bf16x8& pa3) {
#pragma unroll
    for (int r = 0; r < 16; ++r) p1[r] = __builtin_amdgcn_exp2f(p1[r]);
    float ps = 0;
#pragma unroll
    for (int r = 0; r < 16; ++r) ps += p0[r];
#pragma unroll
    for (int r = 0; r < 16; ++r) ps += p1[r];
    { auto rr = __builtin_amdgcn_permlane32_swap(__float_as_uint(ps), __float_as_uint(ps), false, false);
      ps = __uint_as_float(rr[0]) + __uint_as_float(rr[1]); }
    l_reg = l_reg * alpha + ps;
#define PK4(P, B_, OUT) do { unsigned a0 = cvt_pk_bf16(P[B_+0], P[B_+1]), a1 = cvt_pk_bf16(P[B_+2], P[B_+3]);                          \
        unsigned b0 = cvt_pk_bf16(P[B_+4], P[B_+5]), b1 = cvt_pk_bf16(P[B_+6], P[B_+7]);                                             \
        auto r0 = __builtin_amdgcn_permlane32_swap(a0, b0, false, false); auto r1 = __builtin_amdgcn_permlane32_swap(a1, b1, false, false); \
        u32x4 w = {r0[0], r1[0], r0[1], r1[1]}; OUT = *reinterpret_cast<bf16x8*>(&w); } while (0)
    PK4(p0, 0, pa0); PK4(p0, 8, pa1); PK4(p1, 0, pa2); PK4(p1, 8, pa3);
#undef PK4
}
template <int KB>
__device__ __forceinline__ void qkt(f32x16& p0, f32x16& p1, const char* K_lds, int r32, int hi, const bf16x8* qr, const float* gl) {
#pragma unroll
    for (int i = 0; i < 4; ++i) { const f32x4 g0 = *(const f32x4*)(gl + 8 * i + 4 * hi), g1 = *(const f32x4*)(gl + 32 + 8 * i + 4 * hi);
#pragma unroll
        for (int j = 0; j < 4; ++j) { p0[4 * i + j] = g0[j]; p1[4 * i + j] = g1[j]; } }
    const char* kb[4];
#pragma unroll
    for (int dd = 0; dd < 4; ++dd) kb[dd] = K_lds + KB * SHM_K + KSWZ(r32, (dd * 16 + hi * 8) * 2);
#pragma unroll
    for (int d0 = 0; d0 < 8; ++d0) { const char* a = kb[d0 & 3] + (d0 >> 2) * 128;
        bf16x8 b0 = *reinterpret_cast<const bf16x8*>(a);
        bf16x8 b1 = *reinterpret_cast<const bf16x8*>(a + 32 * 256);
        p0 = __builtin_amdgcn_mfma_f32_32x32x16_bf16(b0, qr[d0], p0, 0, 0, 0);
        p1 = __builtin_amdgcn_mfma_f32_32x32x16_bf16(b1, qr[d0], p1, 0, 0, 0); }
}
template <int VB>
__device__ __forceinline__ void pv_tile(f32x16* o, int vb0, bf16x8 pa0, bf16x8 pa1, bf16x8 pa2, bf16x8 pa3) {
#define TRRD(dst, off) asm volatile("ds_read_b64_tr_b16 %0, %1 offset:%2" : "=&v"(dst) : "v"(vb0), "i"(off) : "memory")
#define PV_D0(d0) do { s16x4 l0, l1, l2, l3, h0, h1, h2, h3; constexpr int b_ = VB * SHM_V + v_rd_off(d0, 0, 0); \
        TRRD(l0, b_); TRRD(h0, b_ + 2048); TRRD(l1, b_ + 4096); TRRD(h1, b_ + 6144); TRRD(l2, b_ + 8192); TRRD(h2, b_ + 10240); TRRD(l3, b_ + 12288); TRRD(h3, b_ + 14336); \
        asm volatile("s_waitcnt lgkmcnt(0)" ::: "memory"); SBAR();   \
        o[d0] = __builtin_amdgcn_mfma_f32_32x32x16_bf16(pa0, (bf16x8){l0[0], l0[1], l0[2], l0[3], h0[0], h0[1], h0[2], h0[3]}, o[d0], 0, 0, 0);   \
        o[d0] = __builtin_amdgcn_mfma_f32_32x32x16_bf16(pa1, (bf16x8){l1[0], l1[1], l1[2], l1[3], h1[0], h1[1], h1[2], h1[3]}, o[d0], 0, 0, 0);   \
        o[d0] = __builtin_amdgcn_mfma_f32_32x32x16_bf16(pa2, (bf16x8){l2[0], l2[1], l2[2], l2[3], h2[0], h2[1], h2[2], h2[3]}, o[d0], 0, 0, 0);   \
        o[d0] = __builtin_amdgcn_mfma_f32_32x32x16_bf16(pa3, (bf16x8){l3[0], l3[1], l3[2], l3[3], h3[0], h3[1], h3[2], h3[3]}, o[d0], 0, 0, 0); } while (0)
    PV_D0(0); PV_D0(1); PV_D0(2); PV_D0(3);
#undef PV_D0
#undef TRRD
}
struct BlockRef { const bf16_t* Q; const bf16_t* K; const bf16_t* V; const float* G; bf16_t* O; int P0, jlo; };
struct Seam { bf16x8 qr[8]; bf16x8 st_v0, st_v1, st_k0, st_k1; float sg; };
#define ROW(p, k0, rr) ((p) + (size_t)((k0) + (rr)) * D + sc)
#define VMW() asm volatile("s_waitcnt vmcnt(0)" ::: "memory")
#define VMWN(n) asm volatile("s_waitcnt vmcnt(%0)" :: "i"(n) : "memory")
#define SLOAD_H(Kp, Vp, Gp, k0) do { S.st_v0 = load8(ROW(Vp, k0, sr)); S.st_v1 = load8(ROW(Vp, k0, 32 + sr));              \
                         S.st_k0 = load8(ROW(Kp, k0, sr)); S.st_k1 = load8(ROW(Kp, k0, 32 + sr)); S.sg = (Gp)[(k0) + (tid & 63)]; } while (0)
#define SWRITE_HK(bf) do { *(bf16x8*)(K_lds + (bf) * SHM_K + kws) = S.st_k0; *(bf16x8*)(K_lds + (bf) * SHM_K + kws + 32 * 256) = S.st_k1; \
                           if (tid < 64) G_lds[(bf) * 64 + tid] = S.sg; } while (0)
#define SWRITE_HV(bf) do { *(bf16x8*)(V_lds + (bf) * SHM_V + vst0) = S.st_v0; *(bf16x8*)(V_lds + (bf) * SHM_V + vst1) = S.st_v1; } while (0)
#define SWRITE_H(bf) do { SWRITE_HV(bf); SWRITE_HK(bf); } while (0)
__device__ __forceinline__ void prime(const BlockRef& cur, char* lds, Seam& S, int wv) {
    const int tid = otid(wv), wid = __builtin_amdgcn_readfirstlane(tid >> 6), lane = tid & 63, r32 = lane & 31, hi = lane >> 5;
    const int sr = tid >> 4, sc = (tid & 15) * 8, kws = KSWZ(sr, sc * 2); char* K_lds = lds + 2 * SHM_V; float* G_lds = (float*)(lds + OFF_G);
#pragma unroll
    for (int d0 = 0; d0 < 8; ++d0) S.qr[d0] = load8(cur.Q + (size_t)(wid * QBLK + r32) * D + d0 * 16 + hi * 8);
    SLOAD_H(cur.K, cur.V, cur.G, cur.jlo * KVBLK); VMW(); SWRITE_HK(0);
    __syncthreads();
}
__device__ __forceinline__ void block(const BlockRef& cur, const BlockRef& nxt, char* lds, Seam& S, int wv) {
    const int tid = otid(wv), wid = __builtin_amdgcn_readfirstlane(tid >> 6), lane = tid & 63, r32 = lane & 31, hi = lane >> 5;
    const int W = SEQ;
    const int j_hi = (cur.P0 + QB - 1) / KVBLK + 1;
    const int j_lo = cur.jlo, NT = j_hi - j_lo, kbn = nxt.jlo * KVBLK;
    const int qlo = cur.P0 + wid * QBLK, qm = qlo + r32 - 4 * hi;
    char* V_lds = lds; char* K_lds = lds + 2 * SHM_V; float* G_lds = (float*)(lds + OFF_G);
    float* ws = (float*)(lds + OFF_WS) + wid * 64; float* li_l = ws, * al_l = ws + 32;
    float m_reg = -1e30f, l_reg = 0; f32x16 o[4] = {};
    const int sr = tid >> 4, sc = (tid & 15) * 8, vst0 = v_st(sr, sc), vst1 = v_st(32 + sr, sc), kws = KSWZ(sr, sc * 2);
    const int vb0 = (int)(uintptr_t)V_lds + v_rd_base(lane);
    const bf16_t* Kh = cur.K; const bf16_t* Vh = cur.V; const float* Gh = cur.G;
#define RESC(a) do { if (__any((a) < 1.f)) { if (hi == 0) al_l[r32] = (a); asm volatile("s_waitcnt lgkmcnt(0)" ::: "memory");              \
                     _Pragma("unroll") for (int d_ = 0; d_ < 4; ++d_) _Pragma("unroll") for (int r = 0; r < 16; ++r) o[d_][r] *= al_l[crow(r, hi)]; } } while (0)
#define KBASE(t) ((j_lo + (t)) * KVBLK)
#define MASKT(P0_, P1_, t) do { const int kb_ = KBASE(t); if (kb_ + KVBLK - 1 > qlo) mask_tile(P0_, P1_, qm - kb_, (unsigned)W); } while (0)
    constexpr int NQL = 8;
#define SEAM_K0() do { VMWN(NQL); SWRITE_HK(0); SBAR(); } while (0)
    f32x16 pA0, pA1, pB0, pB1; float mnA, mnB, alA, alB; bf16x8 pa0, pa1, pa2, pa3;
    SWRITE_HV(0); SBAR();
    if (NT > 1) SLOAD_H(Kh, Vh, Gh, KBASE(1));
    SBAR(); qkt<0>(pA0, pA1, K_lds, r32, hi, S.qr, G_lds);
    MASKT(pA0, pA1, 0); partialSM(pA0, pA1, m_reg, mnA, alA);
    if (NT > 1) { VMW(); SWRITE_H(1); }
    __syncthreads();
#define HALF_STEP(PX0, PX1, mnX, alX, PY0, PY1, alY, t, KB, VB, SB) do {                                                      \
        SBAR(); qkt<KB>(PX0, PX1, K_lds, r32, hi, S.qr, G_lds + (KB) * 64);                                             \
        finishSM(PY0, PY1, alY, l_reg, pa0, pa1, pa2, pa3); SBAR();                                                           \
        if ((t) + 1 < NT) { SLOAD_H(Kh, Vh, Gh, KBASE((t) + 1)); SBAR(); }                                               \
        pv_tile<VB>(o, vb0, pa0, pa1, pa2, pa3); MASKT(PX0, PX1, (t)); partialSM(PX0, PX1, m_reg, mnX, alX);                                        \
        __syncthreads();                                                                                                      \
        if ((t) + 1 < NT) { VMW(); SWRITE_H(SB); }                                                                          \
        RESC(alX); __syncthreads(); } while (0)
    for (int t = 1; t + 1 < NT; t += 2) {
        HALF_STEP(pB0, pB1, mnB, alB, pA0, pA1, alA, t, 1, 0, 0);
        HALF_STEP(pA0, pA1, mnA, alA, pB0, pB1, alB, t + 1, 0, 1, 1);
    }
    const bool even = (NT & 1) == 0;
    if (even) { SBAR(); qkt<1>(pB0, pB1, K_lds, r32, hi, S.qr, G_lds + 64); SBAR(); }
    SLOAD_H(nxt.K, nxt.V, nxt.G, kbn); SBAR();
#pragma unroll
    for (int d0 = 0; d0 < 8; ++d0) S.qr[d0] = load8(nxt.Q + (size_t)(wid * QBLK + r32) * D + d0 * 16 + hi * 8);
    SBAR();
    finishSM(pA0, pA1, alA, l_reg, pa0, pa1, pa2, pa3); SBAR();
    pv_tile<0>(o, vb0, pa0, pa1, pa2, pa3);
    if (even) { MASKT(pB0, pB1, NT - 1); partialSM(pB0, pB1, m_reg, mnB, alB); __syncthreads(); RESC(alB);
        finishSM(pB0, pB1, alB, l_reg, pa0, pa1, pa2, pa3); SBAR(); pv_tile<1>(o, vb0, pa0, pa1, pa2, pa3); }
    SBAR(); SEAM_K0();
    if (hi == 0) li_l[r32] = l_reg; asm volatile("s_waitcnt lgkmcnt(0)" ::: "memory");
    float rli[16];
#pragma unroll
    for (int r = 0; r < 16; ++r) rli[r] = __builtin_amdgcn_rcpf(li_l[crow(r, hi)]);
    bf16_t* Ow = cur.O + (size_t)(wid * QBLK) * D;
#pragma unroll
    for (int r = 0; r < 16; ++r) { const int orow = crow(r, hi);
#pragma unroll
        for (int d0 = 0; d0 < 4; ++d0) { const float v = o[d0][r] * rli[r];
            const float vn = __shfl_xor(v, 1);
            if ((r32 & 1) == 0) *(unsigned*)(Ow + (size_t)orow * D + d0 * 32 + r32) = cvt_pk_bf16(v, vn); } }
    __syncthreads();
#undef RESC
#undef KBASE
#undef MASKT
#undef SEAM_K0
#undef HALF_STEP
}
#undef ROW
#undef VMW
#undef VMWN
#undef SLOAD_H
#undef SWRITE_HK
#undef SWRITE_HV
#undef SWRITE_H
struct Item { int bh, qb0, qb1; };
__device__ __forceinline__ Item decode(int L) {
    const int c = L & 255, i = L >> 8, xcd = c & 7, cc = c >> 3, gi = (cc & 1) + 2 * i, qb = ((cc >> 1) + 2 * i + (i >> 2)) & 15;
    Item it; it.bh = ((xcd - gi) & 7) * 16 + gi; it.qb0 = qb; it.qb1 = qb; return it;
}
__device__ __forceinline__ BlockRef mkref(const Item& it, int pass, const bf16_t* Q, const bf16_t* K, const bf16_t* V, const float* G, const int* JLO, bf16_t* O, bf16_t* Odummy, bool dummy) {
    const int qb = pass ? it.qb1 : it.qb0; BlockRef r;
    r.Q = Q + ((size_t)it.bh * SEQ + (size_t)qb * QB) * D; r.O = dummy ? Odummy : O + ((size_t)it.bh * SEQ + (size_t)qb * QB) * D;
    r.K = K + (size_t)it.bh * SEQ * D; r.V = V + (size_t)it.bh * SEQ * D; r.G = G + (size_t)it.bh * SEQ; r.P0 = qb * QB; r.jlo = JLO[it.bh * 16 + qb]; return r;
}
__device__ __forceinline__ void phase(char* lds, const bf16_t* Q, const bf16_t* K, const bf16_t* V, const float* G, const int* JLO, bf16_t* O, bf16_t* Odummy, int total, int wv) {
    const int stride = gridDim.x;
    int L = blockIdx.x; if (L >= total) return;
    Item it = decode(L); int pass = 0;
    BlockRef cur = mkref(it, 0, Q, K, V, G, JLO, O, Odummy, false);
    Seam S;
    prime(cur, lds, S, wv);
    for (;;) {
        const bool more_pass = pass == 0 && it.qb1 != it.qb0, more_item = L + stride < total, last = !more_pass && !more_item;
        Item itn = it; int passn = pass + 1, Ln = L;
        if (!more_pass) { passn = 0; Ln = more_item ? L + stride : L; itn = decode(Ln); }
        const BlockRef nxt = last ? cur : mkref(itn, passn, Q, K, V, G, JLO, O, Odummy, false);
        block(cur, nxt, lds, S, wv);
        if (last) break;
        cur = nxt; it = itn; pass = passn; L = Ln;
    }
}
#undef SBAR
}

struct Args {
    const float *x, *c, *mod_w, *mod_b, *norm_g, *a_w_in, *a_lb, *a_onorm_g, *a_w_out, *kv_mod_w, *kv_mod_b, *kv_norm_g, *kv_w, *kv_fb, *k_norm_g, *b_w_in, *b_q_norm_g, *b_w_out;
    float* out; unsigned char* ws; int one, pad;
};

__device__ __forceinline__ void transpose_item(const float* W, int K, int ldw, int N, bf16_t* WT, float* scr, int item, int lane) {
    const int nblk = N / 32, kb = item / nblk, nb = item % nblk, k0 = 64 * kb, n0 = 32 * nb;
#pragma unroll 8
    for (int i = 0; i < 32; ++i) { const int kk = 2 * i + (lane >> 5); scr[kk * 33 + (lane & 31)] = W[(size_t)(k0 + kk) * ldw + n0 + (lane & 31)]; }
    asm volatile("s_waitcnt lgkmcnt(0)" ::: "memory");
    const int c = lane & 7;
#pragma unroll
    for (int j = 0; j < 4; ++j) { const int n = (lane >> 3) + 8 * j; const float* s = scr + (8 * c) * 33 + n;
        u32x4 o; o.x = cvt_pk_bf16(s[0 * 33], s[1 * 33]); o.y = cvt_pk_bf16(s[2 * 33], s[3 * 33]); o.z = cvt_pk_bf16(s[4 * 33], s[5 * 33]); o.w = cvt_pk_bf16(s[6 * 33], s[7 * 33]);
        *(u32x4*)(WT + (size_t)(n0 + n) * K + k0 + 8 * c) = o; }
    asm volatile("s_waitcnt lgkmcnt(0)" ::: "memory");
}

__device__ __forceinline__ void p0_prologue(const Args& a, char* lds, int wv) {
    const int tid = otid(wv), lane = tid & 63, wave = tid >> 6, G = gridDim.x;
    unsigned char* ws = a.ws;
    float* sc = (float*)lds;
    float* red = (float*)(lds + 32768);
    for (int i = tid; i < NB * DM; i += 512) sc[i] = silu_f(a.c[i]);
    __syncthreads();
    for (int cgp = blockIdx.x; cgp < 256; cgp += G) {
        const int n0 = cgp * 32; const float* Wm; const float* bias; float* outp; int ldn, nloc;
        if (n0 < 3072) { Wm = a.mod_w; bias = a.mod_b; outp = (float*)(ws + WS_MOD0); ldn = 3072; nloc = n0; }
        else if (n0 < 6144) { Wm = a.mod_w + (size_t)DM * 3072; bias = a.mod_b + 3072; outp = (float*)(ws + WS_MOD1); ldn = 3072; nloc = n0 - 3072; }
        else { Wm = a.kv_mod_w; bias = a.kv_mod_b; outp = (float*)(ws + WS_KVMOD); ldn = 2048; nloc = n0 - 6144; }
        const int col = lane & 31, ksub = wave * 2 + (lane >> 5);
        float accb[8];
#pragma unroll
        for (int b = 0; b < 8; ++b) accb[b] = 0.f;
#pragma unroll 8
        for (int kk = 0; kk < 64; ++kk) { const int k = ksub * 64 + kk; const float w = Wm[(size_t)k * ldn + nloc + col];
#pragma unroll
            for (int b = 0; b < 8; ++b) accb[b] = fmaf(sc[b * DM + k], w, accb[b]); }
#pragma unroll
        for (int b = 0; b < 8; ++b) red[(ksub * 8 + b) * 32 + col] = accb[b];
        __syncthreads();
        if (tid < 256) { const int b = tid >> 5, cc = tid & 31; float s = bias[nloc + cc];
#pragma unroll
            for (int j = 0; j < 16; ++j) s += red[(j * 8 + b) * 32 + cc];
            outp[(size_t)b * ldn + nloc + cc] = s; }
        __syncthreads();
    }
    const int gtid = blockIdx.x * 512 + tid, NT = G * 512;
    for (int j = gtid; j < WD; j += NT) ((float*)(ws + WS_LB))[j] = 1.f / (1.f + __expf(a.a_lb[WD + j] - a.a_lb[j]));
    for (int i = gtid; i < NH * DM; i += NT) { const int h = i >> 10, k = i & 1023; ((float*)(ws + WS_WFL))[i] = a.kv_w[(size_t)k * 4112 + 4096 + h]; }
    __syncthreads();
    float* scr = (float*)(lds + wave * 16384);
    const int gw = blockIdx.x * 8 + wave, NGW = G * 8;
    constexpr int I1 = 16 * 256, I2 = 32 * 32, I3 = 16 * 128, I4 = 16 * 128, I5 = 32 * 32, NIT = I1 + I2 + I3 + I4 + I5;
    for (int it = gw; it < NIT; it += NGW) {
        int r = it;
        if (r < I1) { transpose_item(a.a_w_in, 1024, 8192, 8192, (bf16_t*)(ws + WS_W1), scr, r, lane); continue; } r -= I1;
        if (r < I2) { transpose_item(a.a_w_out, 2048, 1024, 1024, (bf16_t*)(ws + WS_W2), scr, r, lane); continue; } r -= I2;
        if (r < I3) { transpose_item(a.kv_w, 1024, 4112, 4096, (bf16_t*)(ws + WS_W3KV), scr, r, lane); continue; } r -= I3;
        if (r < I4) { transpose_item(a.b_w_in, 1024, 4096, 4096, (bf16_t*)(ws + WS_W3Q), scr, r, lane); continue; } r -= I4;
        transpose_item(a.b_w_out, 2048, 1024, 1024, (bf16_t*)(ws + WS_W4), scr, r, lane);
    }
}

template <bool FL, bool DUAL>
__device__ __forceinline__ void norm_phase(const float* x, const float* g, const float* shiftp, const float* scalep, int mstride, bf16_t* outp,
                                           const float* g2, const float* shiftp2, const float* scalep2, int mstride2, bf16_t* outp2,
                                           const float* wfl_g, const float* fb, float* LS, char* lds, int wv) {
    const int tid = otid(wv), lane = tid & 63, wave = tid >> 6;
    float* wfl = (float*)lds;
    if (FL) { for (int i = tid; i < NH * DM / 4; i += 512) ((f32x4*)wfl)[i] = ((const f32x4*)wfl_g)[i]; __syncthreads(); }
    const int gw = blockIdx.x * 8 + wave, NGW = gridDim.x * 8, rpw = (((TOK + NGW - 1) / NGW) + 3) & ~3;
    int curb = -1; f32x4 al[4], be[4], al2[4], be2[4];
    for (int i0 = 0; i0 < rpw; i0 += 4) {
        const int m0 = gw * rpw + i0; if (m0 >= TOK) break;
        const int b = m0 >> 12;
        if (b != curb) { curb = b;
#pragma unroll
            for (int j = 0; j < 4; ++j) { const int col = 4 * lane + 256 * j; const f32x4 gg = *(const f32x4*)(g + col), sc = *(const f32x4*)(scalep + (size_t)b * mstride + col);
                al[j] = gg * (sc + 1.f); be[j] = *(const f32x4*)(shiftp + (size_t)b * mstride + col);
                if (DUAL) { const f32x4 gg2 = *(const f32x4*)(g2 + col), sc2 = *(const f32x4*)(scalep2 + (size_t)b * mstride2 + col);
                    al2[j] = gg2 * (sc2 + 1.f); be2[j] = *(const f32x4*)(shiftp2 + (size_t)b * mstride2 + col); } } }
        f32x4 v[4][4];
#pragma unroll
        for (int q = 0; q < 4; ++q) { const f32x4* xr = (const f32x4*)(x + (size_t)(m0 + q) * DM) + lane;
#pragma unroll
            for (int j = 0; j < 4; ++j) v[q][j] = xr[64 * j]; }
#pragma unroll
        for (int q = 0; q < 4; ++q) { float s2 = 0.f;
#pragma unroll
            for (int j = 0; j < 4; ++j) s2 += (v[q][j].x * v[q][j].x + v[q][j].y * v[q][j].y) + (v[q][j].z * v[q][j].z + v[q][j].w * v[q][j].w);
            const float rstd = __builtin_amdgcn_rsqf(wave_sum(s2) * (1.f / DM) + EPS);
            unsigned long long* o8 = (unsigned long long*)(outp + (size_t)(m0 + q) * DM) + lane;
            unsigned long long* o82 = (unsigned long long*)(outp2 + (size_t)(m0 + q) * DM) + lane;
#pragma unroll
            for (int j = 0; j < 4; ++j) { const f32x4 xh = v[q][j] * rstd;
                if (DUAL) { const f32x4 w2 = xh * al2[j] + be2[j];
                    o82[64 * j] = (unsigned long long)cvt_pk_bf16(w2.x, w2.y) | ((unsigned long long)cvt_pk_bf16(w2.z, w2.w) << 32); }
                v[q][j] = xh * al[j] + be[j];
                o8[64 * j] = (unsigned long long)cvt_pk_bf16(v[q][j].x, v[q][j].y) | ((unsigned long long)cvt_pk_bf16(v[q][j].z, v[q][j].w) << 32); } }
        if (FL) {
            float mine[4] = {0.f, 0.f, 0.f, 0.f};
#pragma unroll 2
            for (int h = 0; h < NH; ++h) { f32x4 w[4];
#pragma unroll
                for (int j = 0; j < 4; ++j) w[j] = *(const f32x4*)(wfl + h * DM + 4 * lane + 256 * j);
#pragma unroll
                for (int q = 0; q < 4; ++q) { float p = 0.f;
#pragma unroll
                    for (int j = 0; j < 4; ++j) p += (v[q][j].x * w[j].x + v[q][j].y * w[j].y) + (v[q][j].z * w[j].z + v[q][j].w * w[j].w);
                    p = wave_sum(p); if (lane == h) mine[q] = p; } }
            if (lane < NH) { const float fbv = fb[lane];
#pragma unroll
                for (int q = 0; q < 4; ++q) { const float z = mine[q] + fbv; const float ls = z < 0.f ? z - log1pf(__expf(z)) : -log1pf(__expf(-z));
                    LS[(size_t)(b * NH + lane) * SEQ + ((m0 + q) & (SEQ - 1))] = ls; } }
        }
    }
}

__device__ __forceinline__ void cumsum_phase(float* LS, int* JLO, const float* kg, const float* qg, char* lds, int wv) {
    const int tid = otid(wv), lane = tid & 63, wave = tid >> 6; float* wtot = (float*)lds; float* gl = (float*)(lds + 1024);
    float mk = fmaxf(fabsf(kg[lane]), fabsf(kg[lane + 64])), mq = fmaxf(fabsf(qg[lane]), fabsf(qg[lane + 64]));
#pragma unroll
    for (int o = 1; o < 64; o <<= 1) { mk = fmaxf(mk, __shfl_xor(mk, o)); mq = fmaxf(mq, __shfl_xor(mq, o)); }
    const float TH = (40.f + 2.f * (1.05f * 128.f * 1.4426950408889634f * 0.08838834764831845f * mk * mq)) / (1.4426950408889634f * 0.08838834764831845f);
    for (int bh = blockIdx.x; bh < BH; bh += gridDim.x) {
        float* p = LS + (size_t)bh * SEQ + tid * 8; f32x4 a = *(f32x4*)p, b = *(f32x4*)(p + 4);
        float v[8] = {a.x, a.y, a.z, a.w, b.x, b.y, b.z, b.w};
#pragma unroll
        for (int i = 1; i < 8; ++i) v[i] += v[i - 1];
        float run = v[7];
#pragma unroll
        for (int o = 1; o < 64; o <<= 1) { const float t = __shfl_up(run, o); if (lane >= o) run += t; }
        if (lane == 63) wtot[wave] = run;
        __syncthreads();
        float off = run - v[7];
        for (int w = 0; w < wave; ++w) off += wtot[w];
        const float k = -11.313708498984761f;
        a = (f32x4){(v[0] + off) * k, (v[1] + off) * k, (v[2] + off) * k, (v[3] + off) * k}; b = (f32x4){(v[4] + off) * k, (v[5] + off) * k, (v[6] + off) * k, (v[7] + off) * k};
        *(f32x4*)p = a; *(f32x4*)(p + 4) = b;
        *(f32x4*)(gl + tid * 8) = a; *(f32x4*)(gl + tid * 8 + 4) = b;
        __syncthreads();
#pragma unroll
        for (int rep = 0; rep < 2; ++rep) { const int qb = wave + 8 * rep, P0 = qb * 256;
            const bool skip = (64 * lane + 63 < P0) && (gl[P0] - gl[64 * lane + 63] > TH);
            const unsigned long long mask = __ballot(skip);
            if (lane == 0) JLO[bh * 16 + qb] = __popcll(mask); }
        __syncthreads();
    }
}

__device__ __forceinline__ void p4_scan(const Args& a, char* lds, int dry, int wv) {
    const int tid = otid(wv), lane = tid & 63, w = tid >> 6, r = lane & 15, gq = lane >> 4, vg = w & 3, kh = w >> 2;
    unsigned char* ws = a.ws;
    bf16_t* R0 = (bf16_t*)(ws + WS_R0); const bf16_t* R1 = (const bf16_t*)(ws + WS_R1); const bf16_t* R2 = (const bf16_t*)(ws + WS_R2);
    const float* LB = (const float*)(ws + WS_LB);
    constexpr int BUF = 45568, O_QD = 0, O_KT = 17408, O_AT = 35840, O_DL = 45056, O_XS = 2 * BUF, O_PART = O_XS + 32768, O_V = O_PART + 2048;
    typedef short v4i16_t __attribute__((ext_vector_type(4)));
    const LAS char* const vtr0 = (const LAS char*)(LAS unsigned char*)(lds) + O_V + (8 * gq + (r >> 2)) * 272 + (32 * vg + 4 * (r & 3)) * 2;
    const int pk0 = 4 * (tid & 31), prg = tid >> 5, pc0 = 4 * prg;
    bf16_t* const tf = (bf16_t*)(lds + O_V);
    for (int bh = blockIdx.x; bh < BH; bh += gridDim.x) {
        const int h = bh & 15;
        const f32x4 og0 = *(const f32x4*)(a.a_onorm_g + h * HD + 32 * vg + 4 * gq), og1 = *(const f32x4*)(a.a_onorm_g + h * HD + 32 * vg + 16 + 4 * gq);
        const f32x4 lbv4 = *(const f32x4*)(LB + h * HD + pk0), om4 = 1.f - lbv4;
        f32x4 st[4][2];
#pragma unroll
        for (int i = 0; i < 4; ++i) { st[i][0] = (f32x4){0.f, 0.f, 0.f, 0.f}; st[i][1] = (f32x4){0.f, 0.f, 0.f, 0.f}; }
        u32x4 sqA[2], sfA[2], svA[2], sqB[2], sfB[2], svB[2]; bf16x8 vb[2][2];
        char* const xs_own = lds + O_XS + w * 4096 + lane * 16; const char* const xs_par = lds + O_XS + (w ^ 4) * 4096 + lane * 16;
        { const u32x4 z = {0u, 0u, 0u, 0u};
#pragma unroll
          for (int f = 0; f < 4; ++f) *(u32x4*)(xs_own + f * 1024) = z; }
#define P4_LOAD(X, n_) do { const size_t blk_ = ((size_t)bh * SEQ + (size_t)(n_) * 64) * HD; \
            _Pragma("unroll") for (int rep = 0; rep < 2; ++rep) { const int i = tid + rep * 512; sq##X[rep] = *(const u32x4*)(R0 + blk_ + (size_t)i * 8); sf##X[rep] = *(const u32x4*)(R1 + blk_ + (size_t)i * 8); sv##X[rep] = *(const u32x4*)(R2 + blk_ + (size_t)i * 8); } } while (0)
#define P4_WRITE_RAW(X, bf_) do { char* B_ = lds + (bf_) * BUF; \
            _Pragma("unroll") for (int rep = 0; rep < 2; ++rep) { const int i = tid + rep * 512; *(u32x4*)(B_ + O_QD + (i >> 4) * 272 + (i & 15) * 16) = sq##X[rep]; *(u32x4*)(lds + O_V + (i >> 4) * 272 + (i & 15) * 16) = sf##X[rep]; } } while (0)
#define P4_WRITE_V(X) do { _Pragma("unroll") for (int rep = 0; rep < 2; ++rep) { const int i = tid + rep * 512; *(u32x4*)(lds + O_V + (i >> 4) * 272 + (i & 15) * 16) = sv##X[rep]; } } while (0)
#define P4_PREP(X, bf_) do { char* B_ = lds + (bf_) * BUF; bf16_t* tq = (bf16_t*)(B_ + O_QD); float* part2 = (float*)(B_ + O_AT); \
              \
            float ee[4][4]; f32x4 run = {1.f, 1.f, 1.f, 1.f}; \
            _Pragma("unroll") for (int i = 0; i < 4; ++i) { u32x2* pf = (u32x2*)(tf + (pc0 + i) * 136 + pk0); const u32x2 wz = *pf; \
                const f32x4 fz = {__uint_as_float(wz.x << 16), __uint_as_float(wz.x & 0xffff0000u), __uint_as_float(wz.y << 16), __uint_as_float(wz.y & 0xffff0000u)}; f32x4 kq; \
                _Pragma("unroll") for (int j = 0; j < 4; ++j) { const float sg = __builtin_amdgcn_rcpf(1.f + __expf(-fz[j])); const float f = lbv4[j] + om4[j] * sg; run[j] *= f; ee[i][j] = run[j]; kq[j] = 1.f - f; } \
                u32x2 wk; wk.x = cvt_pk_bf16(kq[0], kq[1]); wk.y = cvt_pk_bf16(kq[2], kq[3]); *pf = wk; } \
            *(f32x4*)(part2 + prg * 128 + pk0) = run; \
            __syncthreads(); \
            if (tid < 32) { f32x4 pa_ = {1.f, 1.f, 1.f, 1.f};     \
                _Pragma("unroll") for (int g = 0; g < 16; ++g) { f32x4* pp_ = (f32x4*)(part2 + g * 128 + 4 * tid); const f32x4 pg = *pp_; *pp_ = pa_; pa_ = pa_ * pg; } \
                *(f32x4*)(part2 + 16 * 128 + 4 * tid) = pa_; } \
            __syncthreads(); \
            const f32x4 offp = *(const f32x4*)(part2 + prg * 128 + pk0), totp = *(const f32x4*)(part2 + 16 * 128 + pk0); \
            float ks_[4][4]; \
            _Pragma("unroll") for (int i = 0; i < 4; ++i) { u32x2* pq = (u32x2*)(tq + (pc0 + i) * 136 + pk0); u32x2* pf = (u32x2*)(tf + (pc0 + i) * 136 + pk0); const u32x2 wq = *pq, wk = *pf; \
                const f32x4 qv = {__uint_as_float(wq.x << 16), __uint_as_float(wq.x & 0xffff0000u), __uint_as_float(wq.y << 16), __uint_as_float(wq.y & 0xffff0000u)}; \
                const f32x4 kv = {__uint_as_float(wk.x << 16), __uint_as_float(wk.x & 0xffff0000u), __uint_as_float(wk.y << 16), __uint_as_float(wk.y & 0xffff0000u)}; f32x4 qd, ki; \
                _Pragma("unroll") for (int j = 0; j < 4; ++j) { const float ea = offp[j] * ee[i][j]; const float ie = __builtin_amdgcn_rcpf(ea); qd[j] = qv[j] * ea; ki[j] = kv[j] * ie; ks_[j][i] = ki[j] * totp[j]; } \
                u32x2 o1, o2; o1.x = cvt_pk_bf16(qd[0], qd[1]); o1.y = cvt_pk_bf16(qd[2], qd[3]); o2.x = cvt_pk_bf16(ki[0], ki[1]); o2.y = cvt_pk_bf16(ki[2], ki[3]); *pq = o1; *pf = o2; } \
            _Pragma("unroll") for (int j = 0; j < 4; ++j) { u32x2 wk; wk.x = cvt_pk_bf16(ks_[j][0], ks_[j][1]); wk.y = cvt_pk_bf16(ks_[j][2], ks_[j][3]); *(u32x2*)(B_ + O_KT + (pk0 + j) * 144 + pc0 * 2) = wk; } \
            if (prg == 0) *(f32x4*)(B_ + O_DL + pk0 * 4) = totp; \
            __syncthreads(); \
            { const int mt = w >> 1, nt0 = (w & 1) * 2; f32x4 acc2[2] = {{0.f, 0.f, 0.f, 0.f}, {0.f, 0.f, 0.f, 0.f}}; \
              _Pragma("unroll") for (int ks = 0; ks < 4; ++ks) { const bf16x8 Aq = *(const bf16x8*)(tq + (16 * mt + r) * 136 + ks * 32 + gq * 8); \
                  _Pragma("unroll") for (int j = 0; j < 2; ++j) { const bf16x8 Bk = *(const bf16x8*)(tf + (16 * (nt0 + j) + r) * 136 + ks * 32 + gq * 8); \
                      acc2[j] = __builtin_amdgcn_mfma_f32_16x16x32_bf16(Bk, Aq, acc2[j], 0, 0, 0); } }     \
              char* ap = B_ + O_AT; \
              __syncthreads();     \
              _Pragma("unroll") for (int j = 0; j < 2; ++j) { const int c = 16 * mt + r, s0_ = 16 * (nt0 + j) + 4 * gq; \
                  u32x2 wa; wa.x = cvt_pk_bf16(s0_ <= c ? acc2[j][0] : 0.f, s0_ + 1 <= c ? acc2[j][1] : 0.f); wa.y = cvt_pk_bf16(s0_ + 2 <= c ? acc2[j][2] : 0.f, s0_ + 3 <= c ? acc2[j][3] : 0.f); \
                  *(u32x2*)(ap + c * 144 + s0_ * 2) = wa; } } \
            P4_WRITE_V(X); \
            __syncthreads(); } while (0)
#define P4_PACK(DST, ksl, vt) do { u32x4 bw_; bw_.x = cvt_pk_bf16(st[2 * (ksl)][vt][0], st[2 * (ksl)][vt][1]); bw_.y = cvt_pk_bf16(st[2 * (ksl)][vt][2], st[2 * (ksl)][vt][3]); \
            bw_.z = cvt_pk_bf16(st[2 * (ksl) + 1][vt][0], st[2 * (ksl) + 1][vt][1]); bw_.w = cvt_pk_bf16(st[2 * (ksl) + 1][vt][2], st[2 * (ksl) + 1][vt][3]); DST = bw_; } while (0)
#define P4_STEP(n_, CUR, X, Y) do { const char* B = lds + (CUR) * BUF; \
            _Pragma("unroll") for (int vt = 0; vt < 2; ++vt) _Pragma("unroll") for (int cs = 0; cs < 2; ++cs) { \
                const v4i16_t lo_ = __builtin_amdgcn_ds_read_tr16_b64_v4i16((LAS v4i16_t*)(vtr0 + cs * 32 * 272 + vt * 32)); \
                const v4i16_t hi_ = __builtin_amdgcn_ds_read_tr16_b64_v4i16((LAS v4i16_t*)(vtr0 + cs * 32 * 272 + vt * 32 + 4 * 272)); \
                vb[vt][cs] = (bf16x8){lo_[0], lo_[1], lo_[2], lo_[3], hi_[0], hi_[1], hi_[2], hi_[3]}; } \
            P4_LOAD(X, ((n_) + 2 < 64) ? (n_) + 2 : 63); \
            f32x4 oo[2][2]; \
            _Pragma("unroll") for (int ml = 0; ml < 2; ++ml) { oo[ml][0] = (f32x4){0.f, 0.f, 0.f, 0.f}; oo[ml][1] = (f32x4){0.f, 0.f, 0.f, 0.f}; \
                _Pragma("unroll") for (int ks = 0; ks < 2; ++ks) { const bf16x8 Bq = *(const bf16x8*)(B + O_AT + (32 * kh + 16 * ml + r) * 144 + ks * 64 + gq * 16); \
                    _Pragma("unroll") for (int vt = 0; vt < 2; ++vt) oo[ml][vt] = __builtin_amdgcn_mfma_f32_16x16x32_bf16(vb[vt][ks], Bq, oo[ml][vt], 0, 0, 0); } } \
            _Pragma("unroll") for (int hf = 0; hf < 2; ++hf) _Pragma("unroll") for (int ksl = 0; ksl < 2; ++ksl) { const int ksg = 2 * (hf == 0 ? kh : 1 - kh) + ksl; u32x4 sf_[2]; \
                _Pragma("unroll") for (int vt = 0; vt < 2; ++vt) sf_[vt] = *(const u32x4*)((hf == 0 ? (const char*)xs_own : xs_par) + (ksl * 2 + vt) * 1024); \
                _Pragma("unroll") for (int ml = 0; ml < 2; ++ml) { const char* qa = B + O_QD + (32 * kh + 16 * ml + r) * 272 + ksg * 64 + gq * 8; \
                    const u32x2 a0 = *(const u32x2*)qa, a1 = *(const u32x2*)(qa + 32); const u32x4 aw = {a0.x, a0.y, a1.x, a1.y}; \
                    _Pragma("unroll") for (int vt = 0; vt < 2; ++vt) oo[ml][vt] = __builtin_amdgcn_mfma_f32_16x16x32_bf16(__builtin_bit_cast(bf16x8, sf_[vt]), __builtin_bit_cast(bf16x8, aw), oo[ml][vt], 0, 0, 0); } } \
            float* part = (float*)(lds + O_PART) + (CUR) * 256; \
            _Pragma("unroll") for (int ml = 0; ml < 2; ++ml) { float s_ = 0.f; \
                _Pragma("unroll") for (int vt = 0; vt < 2; ++vt) s_ += (oo[ml][vt][0] * oo[ml][vt][0] + oo[ml][vt][1] * oo[ml][vt][1]) + (oo[ml][vt][2] * oo[ml][vt][2] + oo[ml][vt][3] * oo[ml][vt][3]); \
                s_ += __shfl_xor(s_, 16); s_ += __shfl_xor(s_, 32); if (gq == 0) part[(32 * kh + 16 * ml + r) * 4 + vg] = s_; } \
            _Pragma("unroll") for (int i = 0; i < 4; ++i) { const f32x4 dlv = *(const f32x4*)(B + O_DL + (64 * kh + 16 * i + 4 * gq) * 4); st[i][0] = st[i][0] * dlv; st[i][1] = st[i][1] * dlv; \
                _Pragma("unroll") for (int cs = 0; cs < 2; ++cs) { const bf16x8 A = *(const bf16x8*)(B + O_KT + (64 * kh + 16 * i + r) * 144 + cs * 64 + gq * 16); \
                    _Pragma("unroll") for (int vt = 0; vt < 2; ++vt) st[i][vt] = __builtin_amdgcn_mfma_f32_16x16x32_bf16(A, vb[vt][cs], st[i][vt], 0, 0, 0); } } \
            __syncthreads(); \
            _Pragma("unroll") for (int ksl = 0; ksl < 2; ++ksl) _Pragma("unroll") for (int vt = 0; vt < 2; ++vt) { u32x4 t_; P4_PACK(t_, ksl, vt); *(u32x4*)(xs_own + (ksl * 2 + vt) * 1024) = t_; } \
            P4_WRITE_RAW(Y, (CUR) ^ 1); \
            __syncthreads(); \
            { bf16_t* op = R0 + ((size_t)bh * SEQ + (size_t)(n_) * 64) * HD + 32 * vg + 4 * gq; \
              _Pragma("unroll") for (int ml = 0; ml < 2; ++ml) { const int c = 32 * kh + 16 * ml + r; const f32x4 p0 = *(const f32x4*)(part + c * 4); \
                const float rs = __builtin_amdgcn_rsqf(((p0.x + p0.y) + (p0.z + p0.w)) * (1.f / HD) + EPS); \
                const f32x4 ov0 = oo[ml][0] * og0 * rs, ov1 = oo[ml][1] * og1 * rs; u32x2 pk0, pk1; pk0.x = cvt_pk_bf16(ov0[0], ov0[1]); pk0.y = cvt_pk_bf16(ov0[2], ov0[3]); pk1.x = cvt_pk_bf16(ov1[0], ov1[1]); pk1.y = cvt_pk_bf16(ov1[2], ov1[3]); \
                if (!dry) { *(u32x2*)(op + (size_t)c * HD) = pk0; *(u32x2*)(op + (size_t)c * HD + 16) = pk1; } else asm volatile("" :: "v"(pk0), "v"(pk1)); } } \
            P4_PREP(Y, (CUR) ^ 1); } while (0)
        P4_LOAD(A, 0); P4_LOAD(B, 1); P4_WRITE_RAW(A, 0);
        __syncthreads();
        P4_PREP(A, 0);
        for (int n = 0; n < 64; n += 2) { P4_STEP(n, 0, A, B); P4_STEP(n + 1, 1, B, A); }
        __syncthreads();
#undef P4_LOAD
#undef P4_WRITE_RAW
#undef P4_WRITE_V
#undef P4_PREP
#undef P4_PACK
#undef P4_STEP
    }
}

#define XB_TMO      128
#define XB_XCNT(j)  (256  + 64 * (j))
#define XB_XSUB(j)  (1280 + 64 * (j))
#define XB_XGEN(j)  (2304 + 64 * (j))
#define XB_TOP      3328
#define XB_TOPGEN   3392
#define XCD_BAR_WORDS 3456
#define XB_SPIN_CAP (1u << 22)
__device__ __forceinline__ unsigned xb_ld(unsigned* p)              { return __hip_atomic_load(p, __ATOMIC_RELAXED, __HIP_MEMORY_SCOPE_AGENT); }
__device__ __forceinline__ unsigned xb_add(unsigned* p, unsigned v) { return __hip_atomic_fetch_add(p, v, __ATOMIC_RELAXED, __HIP_MEMORY_SCOPE_AGENT); }
__device__ __forceinline__ unsigned xb_xcc_id() { return (unsigned)__builtin_amdgcn_s_getreg((3 << 11) | 20) & 0xFu; }
#define XB_SPIN(cond, bar) do { unsigned _sp = 0; while (cond) { __builtin_amdgcn_s_sleep(1); \
    if ((++_sp & 255u) == 0u) { if (xb_ld(&(bar)[XB_TMO])) break; if (_sp > XB_SPIN_CAP) { atomicAdd(&(bar)[XB_TMO], 1u); break; } } } } while (0)
struct XcdBarrier { unsigned* bar; unsigned x; volatile LAS unsigned* st; };
__device__ __forceinline__ XcdBarrier xcd_barrier_post(unsigned* bar, volatile LAS unsigned* st) {
    XcdBarrier b; b.bar = bar; b.x = xb_xcc_id(); b.st = st;
    if (threadIdx.x == 0) (void)xb_add(&bar[XB_XCNT(b.x)], 1u);
    return b;
}
__device__ __forceinline__ void xcd_barrier_complete(unsigned* bar, unsigned x, unsigned& nloc, unsigned& nx) {
    const unsigned G = gridDim.x * gridDim.y * gridDim.z;
    unsigned sum, cnt, mine, sp = 0u;
    for (;;) {
        sum = 0u; cnt = 0u; mine = 0u;
#pragma unroll
        for (unsigned j = 0; j < 16; ++j) { const unsigned c = xb_ld(&bar[XB_XCNT(j)]); sum += c; cnt += (c > 0u) ? 1u : 0u; mine = (j == x) ? c : mine; }
        if (sum == G) break;
        __builtin_amdgcn_s_sleep(1);
        if ((++sp & 255u) == 0u) { if (xb_ld(&bar[XB_TMO])) break; if (sp > XB_SPIN_CAP) { atomicAdd(&bar[XB_TMO], 1u); break; } }
    }
    nloc = mine > 0u ? mine : 1u; nx = cnt > 0u ? cnt : 1u;
}
__device__ __forceinline__ void xcd_barrier(unsigned* bar_, volatile LAS unsigned* st_, int wv) {
    const int tid0 = otid(wv);
    asm volatile("" : "+s"(bar_));
    XcdBarrier b; b.bar = bar_; b.st = st_; b.x = 0;
    asm volatile("s_waitcnt vmcnt(0)" ::: "memory");
    __syncthreads();
    if (tid0 == 0) {
        unsigned* bar = b.bar; b.x = xb_xcc_id();
        __builtin_amdgcn_s_waitcnt(0);
        unsigned nloc = b.st[0], nx = b.st[1];
        if (nloc == 0u) { xcd_barrier_complete(bar, b.x, nloc, nx); b.st[0] = nloc; b.st[1] = nx; }
        const unsigned old = xb_add(&bar[XB_XSUB(b.x)], 1u);
        const unsigned gen = old / nloc;
        if (old + 1u == (gen + 1u) * nloc) {
            __builtin_amdgcn_fence(__ATOMIC_RELEASE, "agent");
            asm volatile("s_waitcnt vmcnt(0)" ::: "memory");
            const unsigned og = xb_add(&bar[XB_TOP], 1u);
            const unsigned tg = og / nx;
            if (og + 1u == (tg + 1u) * nx) xb_add(&bar[XB_TOPGEN], 1u);
            else XB_SPIN(xb_ld(&bar[XB_TOPGEN]) == tg, bar);
            __builtin_amdgcn_fence(__ATOMIC_ACQUIRE, "agent");
            xb_add(&bar[XB_XGEN(b.x)], 1u);
            asm volatile("s_waitcnt vmcnt(0)" ::: "memory");
        } else {
            XB_SPIN(xb_ld(&bar[XB_XGEN(b.x)]) == gen, bar);
            __builtin_amdgcn_fence(__ATOMIC_ACQUIRE, "agent");
            asm volatile("s_waitcnt vmcnt(0)" ::: "memory");
        }
    }
    __syncthreads();
}

__global__ void __launch_bounds__(512, 2) yoco_fwd(Args a) {
    extern __shared__ __attribute__((aligned(16))) unsigned char lds_raw[];
    char* lds = (char*)lds_raw; LAS unsigned char* ldsl = (LAS unsigned char*)lds_raw;
    cg::grid_group grid = cg::this_grid();
    const int wv = __builtin_amdgcn_readfirstlane((int)threadIdx.x >> 6);
    unsigned char* ws = a.ws;
    bf16_t* R0 = (bf16_t*)(ws + WS_R0); bf16_t* R1 = (bf16_t*)(ws + WS_R1); bf16_t* R2 = (bf16_t*)(ws + WS_R2);
    bf16_t* XA = (bf16_t*)(ws + WS_XA); bf16_t* H0 = (bf16_t*)a.out;
    const float* MOD0 = (const float*)(ws + WS_MOD0); const float* MOD1 = (const float*)(ws + WS_MOD1); const float* KVMOD = (const float*)(ws + WS_KVMOD);
    float* LSG = (float*)(ws + WS_LSG);
    const int G = gridDim.x, c = blockIdx.x;
    constexpr size_t TS = 64 * MiB;

    unsigned* barw = (unsigned*)(ws + WS_SM + 786432);
    volatile LAS unsigned* bst = (volatile LAS unsigned*)(ldsl + 143360);
    if (threadIdx.x == 0) { bst[0] = 0u; bst[1] = 0u; }
    if (a.one == 0) grid.sync();
    (void)xcd_barrier_post(barw, bst);
#define GSYNC() xcd_barrier((unsigned*)(a.ws + WS_SM + 786432), (volatile LAS unsigned*)(ldsl + 143360), wv)
    p0_prologue(a, lds, wv);
    GSYNC();
    norm_phase<false, false>(a.x, a.norm_g, MOD0, MOD0 + 1024, 3072, H0, nullptr, nullptr, nullptr, 0, nullptr, nullptr, nullptr, nullptr, lds, wv);
    GSYNC();
    { pg8::Gemm g{H0, (const bf16_t*)(ws + WS_W1), TOK, 6144, DM, 2048u, 256, (size_t)4096 * 2048}; pg8::StaticOrder S; S.init(TOK, 6144, G, c);
      pg8::EpiHead E{R0, TS}; pg8::gemm_phase(ldsl, g, S, E, wv);
    }
    GSYNC();
    p4_scan(a, lds, 0, wv);
    GSYNC();
    { pg8::Gemm g{H0, (const bf16_t*)(ws + WS_W1) + (size_t)6144 * DM, TOK, 2048, DM, 2048u, 256, (size_t)4096 * 2048}; pg8::StaticOrder S; S.init(TOK, 2048, G, c);
      pg8::EpiMulSilu E{R0}; pg8::gemm_phase(ldsl, g, S, E, wv); }
    GSYNC();
    { pg8::Gemm g{R0, (const bf16_t*)(ws + WS_W2), TOK, DM, WD, 256u, (size_t)SEQ * 256, (size_t)16 * SEQ * 256}; pg8::StaticOrder S; S.init(TOK, DM, G, c);
      pg8::EpiRes E{a.x, a.out, MOD0 + 2048}; pg8::gemm_phase(ldsl, g, S, E, wv);
    }
    GSYNC();
    norm_phase<true, true>(a.out, a.kv_norm_g, KVMOD, KVMOD + 1024, 2048, R0, a.norm_g + DM, MOD1, MOD1 + 1024, 3072, XA, (const float*)(ws + WS_WFL), a.kv_fb, LSG, lds, wv);
    GSYNC();
    cumsum_phase(LSG, (int*)(ws + WS_SM + 802816), a.k_norm_g, a.b_q_norm_g, lds, wv);
    { pg8::Gemm g{R0, (const bf16_t*)(ws + WS_W3KV), TOK, 4096, DM, 2048u, 256, (size_t)4096 * 2048}; pg8::StaticOrder S; S.init(TOK, 4096, G, c);
      pg8::EpiHeadNorm E{R1, TS, 1, a.k_norm_g, (LAS float*)(ldsl + 131072)}; pg8::gemm_phase(ldsl, g, S, E, wv);
    }
    GSYNC();
    { pg8::Gemm g{XA, (const bf16_t*)(ws + WS_W3Q), TOK, 2048, DM, 2048u, 256, (size_t)4096 * 2048}; pg8::StaticOrder S; S.init(TOK, 2048, G, c);
      pg8::EpiHeadNorm E{R0, TS, 1, a.b_q_norm_g, (LAS float*)(ldsl + 131072)}; pg8::gemm_phase(ldsl, g, S, E, wv); }
    GSYNC();
    att::phase(lds, R0, R1, R2, LSG, (const int*)(ws + WS_SM + 802816), R0, (bf16_t*)(ws + WS_SM + 716800), 2048, wv);
    GSYNC();
    { pg8::Gemm g{XA, (const bf16_t*)(ws + WS_W3G), TOK, 2048, DM, 2048u, 256, (size_t)4096 * 2048}; pg8::StaticOrder S; S.init(TOK, 2048, G, c);
      pg8::EpiMulSilu E{R0}; pg8::gemm_phase(ldsl, g, S, E, wv); }
    GSYNC();
    { pg8::Gemm g{R0, (const bf16_t*)(ws + WS_W4), TOK, DM, WD, 256u, (size_t)SEQ * 256, (size_t)16 * SEQ * 256}; pg8::StaticOrder S; S.init(TOK, DM, G, c);
      pg8::EpiRes E{a.out, a.out, MOD1 + 2048}; pg8::gemm_phase(ldsl, g, S, E, wv); }
}

extern "C" void kernel_launch(void* const* d_in, const int* in_sizes, int n_in, void* d_out, int out_size, void* d_ws, size_t ws_size, hipStream_t stream) {
    static int grid = 0;
    if (grid == 0) {
        int dev = 0, cus = 0, per_cu = 0;
        hipGetDevice(&dev); hipDeviceGetAttribute(&cus, hipDeviceAttributeMultiprocessorCount, dev);
        hipFuncSetAttribute((const void*)yoco_fwd, hipFuncAttributeMaxDynamicSharedMemorySize, LDS_BYTES);
        hipOccupancyMaxActiveBlocksPerMultiprocessor(&per_cu, (const void*)yoco_fwd, 512, LDS_BYTES);
        (void)hipGetLastError();
        if (cus <= 0) cus = 256;
        grid = cus;
        if (per_cu < 1) fprintf(stderr, "kernel_launch: occupancy query reports %d blocks/CU\n", per_cu);
        if (ws_size < 512 * MiB) fprintf(stderr, "kernel_launch: workspace too small (%zu)\n", ws_size);
    }
    if (hipMemsetAsync((char*)d_ws + WS_SM + 786432, 0, 16384, stream) != hipSuccess) fprintf(stderr, "kernel_launch: memset of barrier words failed\n");
    Args a{};
    const float** pp = (const float**)&a;
    for (int i = 0; i < 18; ++i) pp[i] = (const float*)d_in[i];
    a.out = (float*)d_out; a.ws = (unsigned char*)d_ws; a.one = 1;
    void* args[] = {&a};
    hipError_t e = hipLaunchCooperativeKernel((const void*)yoco_fwd, dim3(grid), dim3(512), args, LDS_BYTES, stream);
    if (e != hipSuccess) fprintf(stderr, "cooperative launch failed: %s (grid %d)\n", hipGetErrorString(e), grid);
}
```

```cpp
#include <hip/hip_runtime.h>
#include <hip/hip_cooperative_groups.h>
#include <cstdio>
#include <cstdint>
namespace cg = cooperative_groups;

#define LAS __attribute__((address_space(3)))
typedef unsigned short bf16_t;
typedef short bf16x8 __attribute__((ext_vector_type(8)));
typedef short s16x4 __attribute__((ext_vector_type(4)));
typedef float f32x4 __attribute__((ext_vector_type(4)));
typedef float f32x16 __attribute__((ext_vector_type(16)));
typedef unsigned u32x4 __attribute__((ext_vector_type(4)));
typedef unsigned u32x2 __attribute__((ext_vector_type(2)));

constexpr int NB = 8, SEQ = 4096, DM = 1024, WD = 2048, NH = 16, HD = 128, BH = NB * NH, TOK = NB * SEQ;
constexpr float EPS = 1e-6f;
constexpr size_t MiB = 1u << 20;
constexpr size_t WS_R0 = 0, WS_R1 = 128 * MiB, WS_R2 = 256 * MiB, WS_XA = 384 * MiB;
constexpr size_t WS_W1 = 448 * MiB, WS_W2 = 464 * MiB, WS_W3KV = 468 * MiB, WS_W3Q = 476 * MiB, WS_W3G = 480 * MiB, WS_W4 = 484 * MiB;
constexpr size_t WS_SM = 488 * MiB;
constexpr size_t WS_MOD0 = WS_SM, WS_MOD1 = WS_SM + 98304, WS_KVMOD = WS_SM + 196608, WS_LB = WS_SM + 262144, WS_WFL = WS_SM + 270336;
constexpr size_t WS_LSG = WS_SM + 1 * MiB, WS_DL = WS_SM + 4 * MiB;
constexpr int LDS_BYTES = 147456;

__device__ __forceinline__ float bf2f(unsigned short h) { return __uint_as_float(((unsigned)h) << 16); }
typedef float f32x2_t __attribute__((ext_vector_type(2))); typedef __bf16 bf16x2_t __attribute__((ext_vector_type(2)));
__device__ __forceinline__ unsigned cvt_pk_bf16(float lo, float hi) { f32x2_t v = {lo, hi}; bf16x2_t b = __builtin_convertvector(v, bf16x2_t); return __builtin_bit_cast(unsigned, b); }
__device__ __forceinline__ unsigned short f2bf(float f) { return (unsigned short)(cvt_pk_bf16(f, 0.f) & 0xffffu); }
__device__ __forceinline__ float wave_sum(float v) {
#pragma unroll
    for (int o = 1; o < 64; o <<= 1) v += __shfl_xor(v, o);
    return v;
}
__device__ __forceinline__ int otid(int wv) { int t = wv * 64 + (int)__builtin_amdgcn_mbcnt_hi(~0u, __builtin_amdgcn_mbcnt_lo(~0u, 0u)); asm volatile("" : "+v"(t)); return t; }
__device__ __forceinline__ float silu_f(float x) { return x * __builtin_amdgcn_rcpf(1.f + __builtin_amdgcn_exp2f(-1.4426950408889634f * x)); }

namespace pg8 {
constexpr int BM = 256, BK = 64, HALF = 128, HTB = HALF * BK * 2, STAGE_BYTES = 8 * HTB, NXCD = 8, WGM = 8;
__host__ __device__ __forceinline__ int lds_byte(int r, int c) { const int st = (r >> 4) * 2 + (c >> 5), rr = r & 15, cc = c & 31, ob = rr * 64 + cc * 2; return st * 1024 + (ob ^ (((ob >> 9) & 1) << 5)); }
__host__ __device__ __forceinline__ void stage_rc(int b, int& R, int& C) { const int st = b / 1024, sb = b % 1024, swz = sb ^ (((sb >> 9) & 1) << 5); R = (st >> 1) * 16 + swz / 64; C = (st & 1) * 32 + (swz % 64) / 2; }
__host__ __device__ __forceinline__ int perm32(int rho) { const int n = rho >> 4, i = rho & 15; return 8 * (i >> 2) + 4 * n + (i & 3); }

struct Unit { int pm, pn; };
struct Gemm { const bf16_t* A; const bf16_t* Bt; int M, N, K; unsigned lda; size_t hsA, bsA; };

struct StaticOrder {
    int nM, nN, nwg, G, c;
    __device__ void init(int M, int N, int G_, int c_) { nM = M / BM; nN = N / BM; nwg = nM * nN; G = G_; c = c_; }
    __device__ bool next(int i, Unit& u) const {
        const long L = (long)i * G + c; if (L >= nwg) return false;
        int wgid = (int)L; { const int q = nwg / NXCD, r = nwg % NXCD, xcd = wgid % NXCD, off = wgid / NXCD; wgid = (xcd < r ? xcd * (q + 1) : r * (q + 1) + (xcd - r) * q) + off; }
        const int nig = WGM * nN, gid = wgid / nig, fm = gid * WGM, gsz = (nM - fm) < WGM ? (nM - fm) : WGM;
        u.pm = fm + ((wgid % nig) % gsz); u.pn = (wgid % nig) / gsz; return true;
    }
};

struct EpiHead {
    bf16_t* base0; size_t tstride;
    __device__ __forceinline__ void operator()(const f32x4 (&acc)[2][2][4][2], const Unit& u, int wr, int wc, int fr, int fq) const {
        const int b = u.pm >> 4, s0 = (u.pm & 15) * 256 + wr * 64 + fr, t = u.pn >> 3, hd0 = (u.pn & 7) * 2;
        bf16_t* base = base0 + (size_t)t * tstride + wc * 32 + 8 * fq;
#pragma unroll
        for (int ai = 0; ai < 2; ++ai)
#pragma unroll
            for (int m = 0; m < 4; ++m)
#pragma unroll
                for (int bj = 0; bj < 2; ++bj) {
                    const f32x4 v0 = acc[ai][bj][m][0], v1 = acc[ai][bj][m][1];
                    u32x4 w; w.x = cvt_pk_bf16(v0[0], v0[1]); w.y = cvt_pk_bf16(v0[2], v0[3]); w.z = cvt_pk_bf16(v1[0], v1[1]); w.w = cvt_pk_bf16(v1[2], v1[3]);
                    *(u32x4*)(base + ((size_t)(b * 16 + hd0 + bj) * SEQ + s0 + ai * HALF + m * 16) * HD) = w;
                }
    }
};
struct EpiHeadNorm {
    bf16_t* base0; size_t tstride; int nnorm; const float* g; LAS float* xch;
    __device__ __forceinline__ void operator()(const f32x4 (&acc)[2][2][4][2], const Unit& u, int wr, int wc, int fr, int fq) const {
        const int b = u.pm >> 4, s0 = (u.pm & 15) * 256 + wr * 64 + fr, t = u.pn >> 3, hd0 = (u.pn & 7) * 2;
        bf16_t* base = base0 + (size_t)t * tstride + wc * 32 + 8 * fq;
        if (t < nnorm) {
#pragma unroll
            for (int ai = 0; ai < 2; ++ai)
#pragma unroll
                for (int m = 0; m < 4; ++m)
#pragma unroll
                    for (int bj = 0; bj < 2; ++bj) { const f32x4 v0 = acc[ai][bj][m][0], v1 = acc[ai][bj][m][1];
                        float sq = ((v0[0] * v0[0] + v0[1] * v0[1]) + (v0[2] * v0[2] + v0[3] * v0[3])) + ((v1[0] * v1[0] + v1[1] * v1[1]) + (v1[2] * v1[2] + v1[3] * v1[3]));
                        sq += __shfl_xor(sq, 16); sq += __shfl_xor(sq, 32);
                        if (fq == 0) xch[((ai * HALF + wr * 64 + m * 16 + fr) * 2 + bj) * 4 + wc] = sq; }
            asm volatile("s_waitcnt lgkmcnt(0)" ::: "memory"); __builtin_amdgcn_s_barrier(); asm volatile("" ::: "memory");
            const f32x4 g0 = *(const f32x4*)(g + wc * 32 + 8 * fq), g1 = *(const f32x4*)(g + wc * 32 + 8 * fq + 4);
#pragma unroll
            for (int ai = 0; ai < 2; ++ai)
#pragma unroll
                for (int m = 0; m < 4; ++m)
#pragma unroll
                    for (int bj = 0; bj < 2; ++bj) {
                        const f32x4 p = *(const LAS f32x4*)(xch + ((ai * HALF + wr * 64 + m * 16 + fr) * 2 + bj) * 4);
                        const float rs = __builtin_amdgcn_rsqf(((p[0] + p[1]) + (p[2] + p[3])) * (1.f / 128.f) + EPS);
                        const f32x4 v0 = acc[ai][bj][m][0] * g0 * rs, v1 = acc[ai][bj][m][1] * g1 * rs;
                        u32x4 w; w.x = cvt_pk_bf16(v0[0], v0[1]); w.y = cvt_pk_bf16(v0[2], v0[3]); w.z = cvt_pk_bf16(v1[0], v1[1]); w.w = cvt_pk_bf16(v1[2], v1[3]);
                        *(u32x4*)(base + ((size_t)(b * 16 + hd0 + bj) * SEQ + s0 + ai * HALF + m * 16) * HD) = w;
                    }
        } else {
#pragma unroll
            for (int ai = 0; ai < 2; ++ai)
#pragma unroll
                for (int m = 0; m < 4; ++m)
#pragma unroll
                    for (int bj = 0; bj < 2; ++bj) {
                        const f32x4 v0 = acc[ai][bj][m][0], v1 = acc[ai][bj][m][1];
                        u32x4 w; w.x = cvt_pk_bf16(v0[0], v0[1]); w.y = cvt_pk_bf16(v0[2], v0[3]); w.z = cvt_pk_bf16(v1[0], v1[1]); w.w = cvt_pk_bf16(v1[2], v1[3]);
                        *(u32x4*)(base + ((size_t)(b * 16 + hd0 + bj) * SEQ + s0 + ai * HALF + m * 16) * HD) = w;
                    }
        }
    }
};
struct EpiMulSilu {
    bf16_t* X;
    __device__ __forceinline__ void operator()(const f32x4 (&acc)[2][2][4][2], const Unit& u, int wr, int wc, int fr, int fq) const {
        const int b = u.pm >> 4, s0 = (u.pm & 15) * 256 + wr * 64 + fr, hd0 = (u.pn & 7) * 2;
        bf16_t* base = X + wc * 32 + 8 * fq;
        u32x4 pre[2][2];
#define EM_PTR(bt, bj) ((u32x4*)(base + ((size_t)(b * 16 + hd0 + (bj)) * SEQ + s0 + ((bt) >> 2) * HALF + ((bt) & 3) * 16) * HD))
        pre[0][0] = *EM_PTR(0, 0); pre[0][1] = *EM_PTR(0, 1);
#pragma unroll
        for (int bt = 0; bt < 8; ++bt) {
            if (bt + 1 < 8) { pre[(bt + 1) & 1][0] = *EM_PTR(bt + 1, 0); pre[(bt + 1) & 1][1] = *EM_PTR(bt + 1, 1); }
            asm volatile("" ::: "memory");
#pragma unroll
            for (int bj = 0; bj < 2; ++bj) {
                const u32x4 x = pre[bt & 1][bj]; const f32x4 v0 = acc[bt >> 2][bj][bt & 3][0], v1 = acc[bt >> 2][bj][bt & 3][1];
                u32x4 w;
                w.x = cvt_pk_bf16(__uint_as_float(x.x << 16) * silu_f(v0[0]), __uint_as_float(x.x & 0xffff0000u) * silu_f(v0[1]));
                w.y = cvt_pk_bf16(__uint_as_float(x.y << 16) * silu_f(v0[2]), __uint_as_float(x.y & 0xffff0000u) * silu_f(v0[3]));
                w.z = cvt_pk_bf16(__uint_as_float(x.z << 16) * silu_f(v1[0]), __uint_as_float(x.z & 0xffff0000u) * silu_f(v1[1]));
                w.w = cvt_pk_bf16(__uint_as_float(x.w << 16) * silu_f(v1[2]), __uint_as_float(x.w & 0xffff0000u) * silu_f(v1[3]));
                *EM_PTR(bt, bj) = w;
            }
            asm volatile("" ::: "memory");
        }
#undef EM_PTR
    }
};
struct EpiRes {
    const float* base; float* out; const float* gate;
    __device__ __forceinline__ void operator()(const f32x4 (&acc)[2][2][4][2], const Unit& u, int wr, int wc, int fr, int fq) const {
        const int b = u.pm >> 4, row0 = u.pm * BM + wr * 64 + fr, col0 = u.pn * BM + wc * 32 + 8 * fq;
        f32x4 gv[2][2];
#pragma unroll
        for (int bj = 0; bj < 2; ++bj)
#pragma unroll
            for (int n = 0; n < 2; ++n) gv[bj][n] = *(const f32x4*)(gate + (size_t)b * 3072 + col0 + bj * HALF + 4 * n);
        f32x4 pre[2][2][2][2];
#define ER_OFF(bt, mm) ((size_t)(row0 + ((bt) >> 1) * HALF + (2 * ((bt) & 1) + (mm)) * 16) * DM + col0)
#define ER_LOAD(bt, sl) do { _Pragma("unroll") for (int mm = 0; mm < 2; ++mm) _Pragma("unroll") for (int bj = 0; bj < 2; ++bj) _Pragma("unroll") for (int n = 0; n < 2; ++n) \
            pre[sl][mm][bj][n] = *(const f32x4*)(base + ER_OFF(bt, mm) + bj * HALF + 4 * n); } while (0)
        ER_LOAD(0, 0);
#pragma unroll
        for (int bt = 0; bt < 4; ++bt) {
            if (bt + 1 < 4) { if (bt & 1) ER_LOAD(bt + 1, 0); else ER_LOAD(bt + 1, 1); }
            asm volatile("" ::: "memory");
#pragma unroll
            for (int mm = 0; mm < 2; ++mm)
#pragma unroll
                for (int bj = 0; bj < 2; ++bj)
#pragma unroll
                    for (int n = 0; n < 2; ++n)
                        *(f32x4*)(out + ER_OFF(bt, mm) + bj * HALF + 4 * n) = pre[bt & 1][mm][bj][n] + gv[bj][n] * acc[bt >> 1][bj][2 * (bt & 1) + mm][n];
            asm volatile("" ::: "memory");
        }
#undef ER_OFF
#undef ER_LOAD
    }
};

template <class Epi, class Sched>
__device__ __forceinline__ void gemm_phase(LAS unsigned char* lds, const Gemm g, const Sched& S, const Epi& E, int wv) {
    const int tid = otid(wv), wid = __builtin_amdgcn_readfirstlane(tid >> 6), lane = tid & 63, wr = wid >> 2, wc = wid & 3, fr = lane & 15, fq = lane >> 4;
    const int K = g.K, nt = K / BK;
    unsigned voffA[2], voffB[2];
#pragma unroll
    for (int i = 0; i < 2; ++i) { int R, C; stage_rc(tid * 16 + i * 8192, R, C); const int Rb = (R & ~31) + perm32(R & 31);
        voffA[i] = (unsigned)R * g.lda + (unsigned)C * 2u; voffB[i] = (unsigned)(Rb * K + C) * 2u; }
    const size_t kstep = (size_t)(BK * 2);
    const size_t hstepA = (size_t)HALF * g.lda, hstepB = (size_t)HALF * K * 2, tstepB = 2 * hstepB, hsA = g.hsA;
    const unsigned ldsw = (unsigned)wid * 1024u;
    const int aoff = lds_byte(wr * 64 + fr, fq * 8), boff = lds_byte(wc * 32 + fr, fq * 8);
#define PG8_SA(b, h) (((b) * 2 + (h)) * HTB)
#define PG8_SB(b, h) ((4 + (b) * 2 + (h)) * HTB)
#define PG8_STAGE(bufoff, gbase, voff) do { _Pragma("unroll") for (int _i = 0; _i < 2; ++_i) \
        __builtin_amdgcn_global_load_lds((const unsigned*)((const char*)(gbase) + (voff)[_i]), (LAS unsigned*)(lds + (bufoff) + ldsw + _i * 8192), 16, 0, 0); } while (0)
#define PG8_LDA(dst, b, h) do { _Pragma("unroll") for (int m = 0; m < 4; ++m) _Pragma("unroll") for (int k = 0; k < 2; ++k) dst[m][k] = *(const LAS bf16x8*)(lds + PG8_SA(b, h) + aoff + m * 2048 + k * 1024); } while (0)
#define PG8_LDB(dst, b, h) do { _Pragma("unroll") for (int n = 0; n < 2; ++n) _Pragma("unroll") for (int k = 0; k < 2; ++k) dst[n][k] = *(const LAS bf16x8*)(lds + PG8_SB(b, h) + boff + n * 2048 + k * 1024); } while (0)
#define PG8_MMA(ai, bj, At, Bt) do { __builtin_amdgcn_s_setprio(1); _Pragma("unroll") for (int m = 0; m < 4; ++m) _Pragma("unroll") for (int n = 0; n < 2; ++n) _Pragma("unroll") for (int k = 0; k < 2; ++k) \
        acc[ai][bj][m][n] = __builtin_amdgcn_mfma_f32_16x16x32_bf16(Bt[n][k], At[m][k], acc[ai][bj][m][n], 0, 0, 0); __builtin_amdgcn_s_setprio(0); } while (0)
#define PG8_WAIT_V(n) asm volatile("s_waitcnt vmcnt(" #n ")" ::: "memory")
#define PG8_WAIT_L(n) asm volatile("s_waitcnt lgkmcnt(" #n ")" ::: "memory")
#define PG8_BAR __builtin_amdgcn_s_barrier()
#define PG8_SCHED __builtin_amdgcn_sched_barrier(0)
#define PG8_ATILE(u) ((const char*)g.A + (size_t)((u).pm >> 4) * g.bsA + (size_t)((u).pm & 15) * 256 * g.lda)
    Unit cur, nxt; int ui = 0;
    if (!S.next(0, cur)) return;
    f32x4 acc[2][2][4][2];
#pragma unroll
    for (int a = 0; a < 2; ++a)
#pragma unroll
        for (int b = 0; b < 2; ++b)
#pragma unroll
            for (int m = 0; m < 4; ++m)
#pragma unroll
                for (int n = 0; n < 2; ++n) acc[a][b][m][n] = (f32x4){0.f, 0.f, 0.f, 0.f};
    bf16x8 At[4][2], B0[2][2], B1[2][2];
    const char* cA = PG8_ATILE(cur); const char* cB = (const char*)g.Bt + (size_t)cur.pn * tstepB;
    PG8_STAGE(PG8_SB(0, 0), cB, voffB); PG8_STAGE(PG8_SB(0, 1), cB + hstepB, voffB); PG8_STAGE(PG8_SA(0, 0), cA, voffA); PG8_STAGE(PG8_SA(0, 1), cA + hstepA, voffA);
    if (wr == 1) PG8_BAR;
    PG8_WAIT_V(2); PG8_BAR;
    PG8_STAGE(PG8_SB(1, 0), cB + kstep, voffB); PG8_STAGE(PG8_SA(1, 0), cA + kstep, voffA); PG8_STAGE(PG8_SB(1, 1), cB + hstepB + kstep, voffB);
    PG8_WAIT_V(6); PG8_BAR;
    for (;;) {
        const bool has_next = S.next(ui + 1, nxt);
        const char* nA = has_next ? PG8_ATILE(nxt) : cA; const char* nB = has_next ? (const char*)g.Bt + (size_t)nxt.pn * tstepB : cB;
        for (int t = 0; t < nt; t += 2) {
            const bool last = (t == nt - 2);
            const char* a1 = cA + (size_t)(t >> 1) * hsA + kstep;
            const char* a2 = last ? nA : cA + (size_t)((t >> 1) + 1) * hsA; const char* b2 = last ? nB : cB + (size_t)(t + 2) * kstep;
            const char* a3 = a2 + kstep; const char* b3 = b2 + kstep;
            PG8_LDB(B0, 0, 0); PG8_LDB(B1, 0, 1); PG8_SCHED; PG8_LDA(At, 0, 0); PG8_STAGE(PG8_SA(1, 1), a1 + hstepA, voffA);
            PG8_WAIT_V(8); PG8_WAIT_L(0); PG8_BAR; PG8_MMA(0, 0, At, B0); PG8_MMA(0, 1, At, B1); PG8_BAR; PG8_SCHED;
            PG8_LDA(At, 0, 1); PG8_STAGE(PG8_SB(0, 0), b2, voffB); PG8_STAGE(PG8_SB(0, 1), b2 + hstepB, voffB); PG8_STAGE(PG8_SA(0, 0), a2, voffA);
            PG8_WAIT_V(8); PG8_WAIT_L(0); PG8_BAR; PG8_MMA(1, 0, At, B0); PG8_MMA(1, 1, At, B1); PG8_BAR; PG8_SCHED;
            PG8_LDB(B0, 1, 0); PG8_LDB(B1, 1, 1); PG8_SCHED; PG8_LDA(At, 1, 0); PG8_STAGE(PG8_SA(0, 1), a2 + hstepA, voffA);
            PG8_WAIT_V(8); PG8_WAIT_L(0); PG8_BAR; PG8_MMA(0, 0, At, B0); PG8_MMA(0, 1, At, B1); PG8_BAR; PG8_SCHED;
            PG8_LDA(At, 1, 1); PG8_STAGE(PG8_SB(1, 0), b3, voffB); PG8_STAGE(PG8_SB(1, 1), b3 + hstepB, voffB); PG8_STAGE(PG8_SA(1, 0), a3, voffA);
            PG8_WAIT_V(8); PG8_WAIT_L(0); PG8_BAR; PG8_MMA(1, 0, At, B0); PG8_MMA(1, 1, At, B1); PG8_BAR; PG8_SCHED;
        }
        if (wr == 0) PG8_BAR;
        E(acc, cur, wr, wc, fr, fq);
        if (!has_next) break;
#pragma unroll
        for (int a = 0; a < 2; ++a)
#pragma unroll
            for (int b = 0; b < 2; ++b)
#pragma unroll
                for (int m = 0; m < 4; ++m)
#pragma unroll
                    for (int n = 0; n < 2; ++n) acc[a][b][m][n] = (f32x4){0.f, 0.f, 0.f, 0.f};
        cur = nxt; cA = nA; cB = nB; ++ui;
        if (wr == 1) PG8_BAR;
    }
    PG8_WAIT_V(0);
    PG8_BAR;
#undef PG8_SA
#undef PG8_SB
#undef PG8_STAGE
#undef PG8_LDA
#undef PG8_LDB
#undef PG8_MMA
#undef PG8_WAIT_V
#undef PG8_WAIT_L
#undef PG8_BAR
#undef PG8_SCHED
#undef PG8_ATILE
}
}

namespace att {
constexpr int D = 128, NW = 8, QBLK = 32, KVBLK = 64, QB = NW * QBLK;
constexpr int SHM_V = KVBLK * D * 2, SHM_K = KVBLK * D * 2;
constexpr int OFF_WS = 2 * SHM_V + 2 * SHM_K, OFF_G = OFF_WS + NW * 64 * 4, ATT_LDS = OFF_G + 512;
constexpr float SCALE = 0.08838834764831845f, C2 = 1.4426950408889634f * SCALE, THR2 = 24.f;
#define KSWZ(row, colB) ((row) * 256 + ((colB) ^ (((row) & 7) << 4)))
#define SBAR() __builtin_amdgcn_sched_barrier(0)
__device__ __forceinline__ int v_st(int k, int c) { const int kk = (k & ~0xC) | ((k & 4) << 1) | ((k & 8) >> 1); return ((kk >> 3) * 4 + (c >> 5)) * 512 + ((kk & 7) * 32 + (c & 31)) * 2; }
__device__ __forceinline__ int v_rd_base(int lane) { return ((lane & 3) << 3) | (((lane >> 2) & 3) << 6) | (((lane >> 4) & 1) << 5) | (((lane >> 5) & 1) << 8); }
constexpr int v_rd_off(int d0, int ks, int half) { return d0 * 512 + ks * 4096 + half * 2048; }
__device__ __forceinline__ int crow(int r, int hi) { return (r & 3) + 8 * (r >> 2) + 4 * hi; }
__device__ __forceinline__ bf16x8 load8(const bf16_t* p) { return *reinterpret_cast<const bf16x8*>(p); }
__device__ __forceinline__ void mask_tile(f32x16& p0, f32x16& p1, int dq, unsigned W) {
    const float NEG = -__builtin_inff();
#pragma unroll
    for (int r = 0; r < 16; ++r) {
        const int c = (r & 3) + 8 * (r >> 2);
        if ((unsigned)(dq - c) >= W) p0[r] = NEG;
        if ((unsigned)(dq - c - 32) >= W) p1[r] = NEG;
    }
}
__device__ __forceinline__ void partialSM(f32x16& p0, f32x16& p1, float& m_reg, float& mn, float& alpha) {
    float pmax = p0[0];
#pragma unroll
    for (int r = 1; r < 16; ++r) pmax = fmaxf(pmax, p0[r]);
#pragma unroll
    for (int r = 0; r < 16; ++r) pmax = fmaxf(pmax, p1[r]);
    { auto rr = __builtin_amdgcn_permlane32_swap(__float_as_uint(pmax), __float_as_uint(pmax), false, false);
      pmax = fmaxf(__uint_as_float(rr[0]), __uint_as_float(rr[1])); }
    if (__builtin_expect(__all((pmax - m_reg) * C2 <= THR2), 1)) { mn = m_reg; alpha = 1.f; }
    else { mn = fmaxf(m_reg, pmax); alpha = __builtin_amdgcn_exp2f((m_reg - mn) * C2); m_reg = mn; }
    const float mnL = -mn * C2;
#pragma unroll
    for (int r = 0; r < 16; ++r) { p0[r] = fmaf(p0[r], C2, mnL); p1[r] = fmaf(p1[r], C2, mnL); }
#pragma unroll
    for (int r = 0; r < 16; ++r) p0[r] = __builtin_amdgcn_exp2f(p0[r]);
}
__device__ __forceinline__ void finishSM(f32x16& p0, f32x16& p1, float alpha, float& l_reg, bf16x8& pa0, bf16x8& pa1, bf16x8& pa2, bf16x8& pa3) {
#pragma unroll
    for (int r = 0; r < 16; ++r) p1[r] = __builtin_amdgcn_exp2f(p1[r]);
    float ps = 0;
#pragma unroll
    for (int r = 0; r < 16; ++r) ps += p0[r];
#pragma unroll
    for (int r = 0; r < 16; ++r) ps += p1[r];
    { auto rr = __builtin_amdgcn_permlane32_swap(__float_as_uint(ps), __float_as_uint(ps), false, false);
      ps = __uint_as_float(rr[0]) + __uint_as_float(rr[1]); }
    l_reg = l_reg * alpha + ps;
#define PK4(P, B_, OUT) do { unsigned a0 = cvt_pk_bf16(P[B_+0], P[B_+1]), a1 = cvt_pk_bf16(P[B_+2], P[B_+3]);                          \
        unsigned b0 = cvt_pk_bf16(P[B_+4], P[B_+5]), b1 = cvt_pk_bf16(P[B_+6], P[B_+7]);                                             \
        auto r0 = __builtin_amdgcn_permlane32_swap(a0, b0, false, false); auto r1 = __builtin_amdgcn_permlane32_swap(a1, b1, false, false); \
        u32x4 w = {r0[0], r1[0], r0[1], r1[1]}; OUT = *reinterpret_cast<bf16x8*>(&w); } while (0)
    PK4(p0, 0, pa0); PK4(p0, 8, pa1); PK4(p1, 0, pa2); PK4(p1, 8, pa3);
#undef PK4
}
template <int KB>
__device__ __forceinline__ void qkt(f32x16& p0, f32x16& p1, const char* K_lds, int r32, int hi, const bf16x8* qr, const float* gl) {
#pragma unroll
    for (int i = 0; i < 4; ++i) { const f32x4 g0 = *(const f32x4*)(gl + 8 * i + 4 * hi), g1 = *(const f32x4*)(gl + 32 + 8 * i + 4 * hi);
#pragma unroll
        for (int j = 0; j < 4; ++j) { p0[4 * i + j] = g0[j]; p1[4 * i + j] = g1[j]; } }
    const char* kb[4];
#pragma unroll
    for (int dd = 0; dd < 4; ++dd) kb[dd] = K_lds + KB * SHM_K + KSWZ(r32, (dd * 16 + hi * 8) * 2);
#pragma unroll
    for (int d0 = 0; d0 < 8; ++d0) { const char* a = kb[d0 & 3] + (d0 >> 2) * 128;
        bf16x8 b0 = *reinterpret_cast<const bf16x8*>(a);
        bf16x8 b1 = *reinterpret_cast<const bf16x8*>(a + 32 * 256);
        p0 = __builtin_amdgcn_mfma_f32_32x32x16_bf16(b0, qr[d0], p0, 0, 0, 0);
        p1 = __builtin_amdgcn_mfma_f32_32x32x16_bf16(b1, qr[d0], p1, 0, 0, 0); }
}
template <int VB>
__device__ __forceinline__ void pv_tile(f32x16* o, int vb0, bf16x8 pa0, bf16x8 pa1, bf16x8 pa2, bf16x8 pa3) {
#define TRRD(dst, off) asm volatile("ds_read_b64_tr_b16 %0, %1 offset:%2" : "=&v"(dst) : "v"(vb0), "i"(off) : "memory")
#define PV_D0(d0) do { s16x4 l0, l1, l2, l3, h0, h1, h2, h3; constexpr int b_ = VB * SHM_V + v_rd_off(d0, 0, 0); \
        TRRD(l0, b_); TRRD(h0, b_ + 2048); TRRD(l1, b_ + 4096); TRRD(h1, b_ + 6144); TRRD(l2, b_ + 8192); TRRD(h2, b_ + 10240); TRRD(l3, b_ + 12288); TRRD(h3, b_ + 14336); \
        asm volatile("s_waitcnt lgkmcnt(0)" ::: "memory"); SBAR();   \
        o[d0] = __builtin_amdgcn_mfma_f32_32x32x16_bf16(pa0, (bf16x8){l0[0], l0[1], l0[2], l0[3], h0[0], h0[1], h0[2], h0[3]}, o[d0], 0, 0, 0);   \
        o[d0] = __builtin_amdgcn_mfma_f32_32x32x16_bf16(pa1, (bf16x8){l1[0], l1[1], l1[2], l1[3], h1[0], h1[1], h1[2], h1[3]}, o[d0], 0, 0, 0);   \
        o[d0] = __builtin_amdgcn_mfma_f32_32x32x16_bf16(pa2, (bf16x8){l2[0], l2[1], l2[2], l2[3], h2[0], h2[1], h2[2], h2[3]}, o[d0], 0, 0, 0);   \
        o[d0] = __builtin_amdgcn_mfma_f32_32x32x16_bf16(pa3, (bf16x8){l3[0], l3[1], l3[2], l3[3], h3[0], h3[1], h3[2], h3[3]}, o[d0], 0, 0, 0); } while (0)
    PV_D0(0); PV_D0(1); PV_D0(2); PV_D0(3);
#undef PV_D0
#undef TRRD
}
struct BlockRef { const bf16_t* Q; const bf16_t* K; const bf16_t* V; const float* G; bf16_t* O; int P0, jlo; };
struct Seam { bf16x8 qr[8]; bf16x8 st_v0, st_v1, st_k0, st_k1; float sg; };
#define ROW(p, k0, rr) ((p) + (size_t)((k0) + (rr)) * D + sc)
#define VMW() asm volatile("s_waitcnt vmcnt(0)" ::: "memory")
#define VMWN(n) asm volatile("s_waitcnt vmcnt(%0)" :: "i"(n) : "memory")
#define SLOAD_H(Kp, Vp, Gp, k0) do { S.st_v0 = load8(ROW(Vp, k0, sr)); S.st_v1 = load8(ROW(Vp, k0, 32 + sr));              \
                         S.st_k0 = load8(ROW(Kp, k0, sr)); S.st_k1 = load8(ROW(Kp, k0, 32 + sr)); S.sg = (Gp)[(k0) + (tid & 63)]; } while (0)
#define SWRITE_HK(bf) do { *(bf16x8*)(K_lds + (bf) * SHM_K + kws) = S.st_k0; *(bf16x8*)(K_lds + (bf) * SHM_K + kws + 32 * 256) = S.st_k1; \
                           if (tid < 64) G_lds[(bf) * 64 + tid] = S.sg; } while (0)
#define SWRITE_HV(bf) do { *(bf16x8*)(V_lds + (bf) * SHM_V + vst0) = S.st_v0; *(bf16x8*)(V_lds + (bf) * SHM_V + vst1) = S.st_v1; } while (0)
#define SWRITE_H(bf) do { SWRITE_HV(bf); SWRITE_HK(bf); } while (0)
__device__ __forceinline__ void prime(const BlockRef& cur, char* lds, Seam& S, int wv) {
    const int tid = otid(wv), wid = __builtin_amdgcn_readfirstlane(tid >> 6), lane = tid & 63, r32 = lane & 31, hi = lane >> 5;
    const int sr = tid >> 4, sc = (tid & 15) * 8, kws = KSWZ(sr, sc * 2); char* K_lds = lds + 2 * SHM_V; float* G_lds = (float*)(lds + OFF_G);
#pragma unroll
    for (int d0 = 0; d0 < 8; ++d0) S.qr[d0] = load8(cur.Q + (size_t)(wid * QBLK + r32) * D + d0 * 16 + hi * 8);
    SLOAD_H(cur.K, cur.V, cur.G, cur.jlo * KVBLK); VMW(); SWRITE_HK(0);
    __syncthreads();
}
__device__ __forceinline__ void block(const BlockRef& cur, const BlockRef& nxt, char* lds, Seam& S, int wv) {
    const int tid = otid(wv), wid = __builtin_amdgcn_readfirstlane(tid >> 6), lane = tid & 63, r32 = lane & 31, hi = lane >> 5;
    const int W = SEQ;
    const int j_hi = (cur.P0 + QB - 1) / KVBLK + 1;
    const int j_lo = cur.jlo, NT = j_hi - j_lo, kbn = nxt.jlo * KVBLK;
    const int qlo = cur.P0 + wid * QBLK, qm = qlo + r32 - 4 * hi;
    char* V_lds = lds; char* K_lds = lds + 2 * SHM_V; float* G_lds = (float*)(lds + OFF_G);
    float* ws = (float*)(lds + OFF_WS) + wid * 64; float* li_l = ws, * al_l = ws + 32;
    float m_reg = -1e30f, l_reg = 0; f32x16 o[4] = {};
    const int sr = tid >> 4, sc = (tid & 15) * 8, vst0 = v_st(sr, sc), vst1 = v_st(32 + sr, sc), kws = KSWZ(sr, sc * 2);
    const int vb0 = (int)(uintptr_t)V_lds + v_rd_base(lane);
    const bf16_t* Kh = cur.K; const bf16_t* Vh = cur.V; const float* Gh = cur.G;
#define RESC(a) do { if (__any((a) < 1.f)) { if (hi == 0) al_l[r32] = (a); asm volatile("s_waitcnt lgkmcnt(0)" ::: "memory");              \
                     _Pragma("unroll") for (int d_ = 0; d_ < 4; ++d_) _Pragma("unroll") for (int r = 0; r < 16; ++r) o[d_][r] *= al_l[crow(r, hi)]; } } while (0)
#define KBASE(t) ((j_lo + (t)) * KVBLK)
#define MASKT(P0_, P1_, t) do { const int kb_ = KBASE(t); if (kb_ + KVBLK - 1 > qlo) mask_tile(P0_, P1_, qm - kb_, (unsigned)W); } while (0)
    constexpr int NQL = 8;
#define SEAM_K0() do { VMWN(NQL); SWRITE_HK(0); SBAR(); } while (0)
    f32x16 pA0, pA1, pB0, pB1; float mnA, mnB, alA, alB; bf16x8 pa0, pa1, pa2, pa3;
    SWRITE_HV(0); SBAR();
    if (NT > 1) SLOAD_H(Kh, Vh, Gh, KBASE(1));
    SBAR(); qkt<0>(pA0, pA1, K_lds, r32, hi, S.qr, G_lds);
    MASKT(pA0, pA1, 0); partialSM(pA0, pA1, m_reg, mnA, alA);
    if (NT > 1) { VMW(); SWRITE_H(1); }
    __syncthreads();
#define HALF_STEP(PX0, PX1, mnX, alX, PY0, PY1, alY, t, KB, VB, SB) do {                                                      \
        SBAR(); qkt<KB>(PX0, PX1, K_lds, r32, hi, S.qr, G_lds + (KB) * 64);                                             \
        finishSM(PY0, PY1, alY, l_reg, pa0, pa1, pa2, pa3); SBAR();                                                           \
        if ((t) + 1 < NT) { SLOAD_H(Kh, Vh, Gh, KBASE((t) + 1)); SBAR(); }                                               \
        pv_tile<VB>(o, vb0, pa0, pa1, pa2, pa3); MASKT(PX0, PX1, (t)); partialSM(PX0, PX1, m_reg, mnX, alX);                                        \
        __syncthreads();                                                                                                      \
        if ((t) + 1 < NT) { VMW(); SWRITE_H(SB); }                                                                          \
        RESC(alX); __syncthreads(); } while (0)
    for (int t = 1; t + 1 < NT; t += 2) {
        HALF_STEP(pB0, pB1, mnB, alB, pA0, pA1, alA, t, 1, 0, 0);
        HALF_STEP(pA0, pA1, mnA, alA, pB0, pB1, alB, t + 1, 0, 1, 1);
    }
    const bool even = (NT & 1) == 0;
    if (even) { SBAR(); qkt<1>(pB0, pB1, K_lds, r32, hi, S.qr, G_lds + 64); SBAR(); }
    SLOAD_H(nxt.K, nxt.V, nxt.G, kbn); SBAR();
#pragma unroll
    for (int d0 = 0; d0 < 8; ++d0) S.qr[d0] = load8(nxt.Q + (size_t)(wid * QBLK + r32) * D + d0 * 16 + hi * 8);
    SBAR();
    finishSM(pA0, pA1, alA, l_reg, pa0, pa1, pa2, pa3); SBAR();
    pv_tile<0>(o, vb0, pa0, pa1, pa2, pa3);
    if (even) { MASKT(pB0, pB1, NT - 1); partialSM(pB0, pB1, m_reg, mnB, alB); __syncthreads(); RESC(alB);
        finishSM(pB0, pB1, alB, l_reg, pa0, pa1, pa2, pa3); SBAR(); pv_tile<1>(o, vb0, pa0, pa1, pa2, pa3); }
    SBAR(); SEAM_K0();
    if (hi == 0) li_l[r32] = l_reg; asm volatile("s_waitcnt lgkmcnt(0)" ::: "memory");
    float rli[16];
#pragma unroll
    for (int r = 0; r < 16; ++r) rli[r] = __builtin_amdgcn_rcpf(li_l[crow(r, hi)]);
    bf16_t* Ow = cur.O + (size_t)(wid * QBLK) * D;
#pragma unroll
    for (int r = 0; r < 16; ++r) { const int orow = crow(r, hi);
#pragma unroll
        for (int d0 = 0; d0 < 4; ++d0) { const float v = o[d0][r] * rli[r];
            const float vn = __shfl_xor(v, 1);
            if ((r32 & 1) == 0) *(unsigned*)(Ow + (size_t)orow * D + d0 * 32 + r32) = cvt_pk_bf16(v, vn); } }
    __syncthreads();
#undef RESC
#undef KBASE
#undef MASKT
#undef SEAM_K0
#undef HALF_STEP
}
#undef ROW
#undef VMW
#undef VMWN
#undef SLOAD_H
#undef SWRITE_HK
#undef SWRITE_HV
#undef SWRITE_H
struct Item { int bh, qb0, qb1; };
__device__ __forceinline__ Item decode(int L) {
    const int c = L & 255, i = L >> 8, xcd = c & 7, cc = c >> 3, gi = (cc & 1) + 2 * i, qb = ((cc >> 1) + 2 * i + (i >> 2)) & 15;
    Item it; it.bh = ((xcd - gi) & 7) * 16 + gi; it.qb0 = qb; it.qb1 = qb; return it;
}
__device__ __forceinline__ BlockRef mkref(const Item& it, int pass, const bf16_t* Q, const bf16_t* K, const bf16_t* V, const float* G, const int* JLO, bf16_t* O, bf16_t* Odummy, bool dummy) {
    const int qb = pass ? it.qb1 : it.qb0; BlockRef r;
    r.Q = Q + ((size_t)it.bh * SEQ + (size_t)qb * QB) * D; r.O = dummy ? Odummy : O + ((size_t)it.bh * SEQ + (size_t)qb * QB) * D;
    r.K = K + (size_t)it.bh * SEQ * D; r.V = V + (size_t)it.bh * SEQ * D; r.G = G + (size_t)it.bh * SEQ; r.P0 = qb * QB; r.jlo = JLO[it.bh * 16 + qb]; return r;
}
__device__ __forceinline__ void phase(char* lds, const bf16_t* Q, const bf16_t* K, const bf16_t* V, const float* G, const int* JLO, bf16_t* O, bf16_t* Odummy, int total, int wv) {
    const int stride = gridDim.x;
    int L = blockIdx.x; if (L >= total) return;
    Item it = decode(L); int pass = 0;
    BlockRef cur = mkref(it, 0, Q, K, V, G, JLO, O, Odummy, false);
    Seam S;
    prime(cur, lds, S, wv);
    for (;;) {
        const bool more_pass = pass == 0 && it.qb1 != it.qb0, more_item = L + stride < total, last = !more_pass && !more_item;
        Item itn = it; int passn = pass + 1, Ln = L;
        if (!more_pass) { passn = 0; Ln = more_item ? L + stride : L; itn = decode(Ln); }
        const BlockRef nxt = last ? cur : mkref(itn, passn, Q, K, V, G, JLO, O, Odummy, false);
        block(cur, nxt, lds, S, wv);
        if (last) break;
        cur = nxt; it = itn; pass = passn; L = Ln;
    }
}
#undef SBAR
}

struct Args {
    const float *x, *c, *mod_w, *mod_b, *norm_g, *a_w_in, *a_lb, *a_onorm_g, *a_w_out, *kv_mod_w, *kv_mod_b, *kv_norm_g, *kv_w, *kv_fb, *k_norm_g, *b_w_in, *b_q_norm_g, *b_w_out;
    float* out; unsigned char* ws; int one, pad;
};

__device__ __forceinline__ void transpose_item(const float* W, int K, int ldw, int N, bf16_t* WT, float* scr, int item, int lane) {
    const int nblk = N / 32, kb = item / nblk, nb = item % nblk, k0 = 64 * kb, n0 = 32 * nb;
#pragma unroll 8
    for (int i = 0; i < 32; ++i) { const int kk = 2 * i + (lane >> 5); scr[kk * 33 + (lane & 31)] = W[(size_t)(k0 + kk) * ldw + n0 + (lane & 31)]; }
    asm volatile("s_waitcnt lgkmcnt(0)" ::: "memory");
    const int c = lane & 7;
#pragma unroll
    for (int j = 0; j < 4; ++j) { const int n = (lane >> 3) + 8 * j; const float* s = scr + (8 * c) * 33 + n;
        u32x4 o; o.x = cvt_pk_bf16(s[0 * 33], s[1 * 33]); o.y = cvt_pk_bf16(s[2 * 33], s[3 * 33]); o.z = cvt_pk_bf16(s[4 * 33], s[5 * 33]); o.w = cvt_pk_bf16(s[6 * 33], s[7 * 33]);
        *(u32x4*)(WT + (size_t)(n0 + n) * K + k0 + 8 * c) = o; }
    asm volatile("s_waitcnt lgkmcnt(0)" ::: "memory");
}

__device__ __forceinline__ void p0_prologue(const Args& a, char* lds, int wv) {
    const int tid = otid(wv), lane = tid & 63, wave = tid >> 6, G = gridDim.x;
    unsigned char* ws = a.ws;
    float* sc = (float*)lds;
    float* red = (float*)(lds + 32768);
    for (int i = tid; i < NB * DM; i += 512) sc[i] = silu_f(a.c[i]);
    __syncthreads();
    for (int cgp = blockIdx.x; cgp < 256; cgp += G) {
        const int n0 = cgp * 32; const float* Wm; const float* bias; float* outp; int ldn, nloc;
        if (n0 < 3072) { Wm = a.mod_w; bias = a.mod_b; outp = (float*)(ws + WS_MOD0); ldn = 3072; nloc = n0; }
        else if (n0 < 6144) { Wm = a.mod_w + (size_t)DM * 3072; bias = a.mod_b + 3072; outp = (float*)(ws + WS_MOD1); ldn = 3072; nloc = n0 - 3072; }
        else { Wm = a.kv_mod_w; bias = a.kv_mod_b; outp = (float*)(ws + WS_KVMOD); ldn = 2048; nloc = n0 - 6144; }
        const int col = lane & 31, ksub = wave * 2 + (lane >> 5);
        float accb[8];
#pragma unroll
        for (int b = 0; b < 8; ++b) accb[b] = 0.f;
#pragma unroll 8
        for (int kk = 0; kk < 64; ++kk) { const int k = ksub * 64 + kk; const float w = Wm[(size_t)k * ldn + nloc + col];
#pragma unroll
            for (int b = 0; b < 8; ++b) accb[b] = fmaf(sc[b * DM + k], w, accb[b]); }
#pragma unroll
        for (int b = 0; b < 8; ++b) red[(ksub * 8 + b) * 32 + col] = accb[b];
        __syncthreads();
        if (tid < 256) { const int b = tid >> 5, cc = tid & 31; float s = bias[nloc + cc];
#pragma unroll
            for (int j = 0; j < 16; ++j) s += red[(j * 8 + b) * 32 + cc];
            outp[(size_t)b * ldn + nloc + cc] = s; }
        __syncthreads();
    }
    const int gtid = blockIdx.x * 512 + tid, NT = G * 512;
    for (int j = gtid; j < WD; j += NT) ((float*)(ws + WS_LB))[j] = 1.f / (1.f + __expf(a.a_lb[WD + j] - a.a_lb[j]));
    for (int i = gtid; i < NH * DM; i += NT) { const int h = i >> 10, k = i & 1023; ((float*)(ws + WS_WFL))[i] = a.kv_w[(size_t)k * 4112 + 4096 + h]; }
    __syncthreads();
    float* scr = (float*)(lds + wave * 16384);
    const int gw = blockIdx.x * 8 + wave, NGW = G * 8;
    constexpr int I1 = 16 * 256, I2 = 32 * 32, I3 = 16 * 128, I4 = 16 * 128, I5 = 32 * 32, NIT = I1 + I2 + I3 + I4 + I5;
    for (int it = gw; it < NIT; it += NGW) {
        int r = it;
        if (r < I1) { transpose_item(a.a_w_in, 1024, 8192, 8192, (bf16_t*)(ws + WS_W1), scr, r, lane); continue; } r -= I1;
        if (r < I2) { transpose_item(a.a_w_out, 2048, 1024, 1024, (bf16_t*)(ws + WS_W2), scr, r, lane); continue; } r -= I2;
        if (r < I3) { transpose_item(a.kv_w, 1024, 4112, 4096, (bf16_t*)(ws + WS_W3KV), scr, r, lane); continue; } r -= I3;
        if (r < I4) { transpose_item(a.b_w_in, 1024, 4096, 4096, (bf16_t*)(ws + WS_W3Q), scr, r, lane); continue; } r -= I4;
        transpose_item(a.b_w_out, 2048, 1024, 1024, (bf16_t*)(ws + WS_W4), scr, r, lane);
    }
}

template <bool FL, bool DUAL>
__device__ __forceinline__ void norm_phase(const float* x, const float* g, const float* shiftp, const float* scalep, int mstride, bf16_t* outp,
                                           const float* g2, const float* shiftp2, const float* scalep2, int mstride2, bf16_t* outp2,
                                           const float* wfl_g, const float* fb, float* LS, char* lds, int wv) {
    const int tid = otid(wv), lane = tid & 63, wave = tid >> 6;
    float* wfl = (float*)lds;
    if (FL) { for (int i = tid; i < NH * DM / 4; i += 512) ((f32x4*)wfl)[i] = ((const f32x4*)wfl_g)[i]; __syncthreads(); }
    const int gw = blockIdx.x * 8 + wave, NGW = gridDim.x * 8, rpw = (((TOK + NGW - 1) / NGW) + 3) & ~3;
    int curb = -1; f32x4 al[4], be[4], al2[4], be2[4];
    for (int i0 = 0; i0 < rpw; i0 += 4) {
        const int m0 = gw * rpw + i0; if (m0 >= TOK) break;
        const int b = m0 >> 12;
        if (b != curb) { curb = b;
#pragma unroll
            for (int j = 0; j < 4; ++j) { const int col = 4 * lane + 256 * j; const f32x4 gg = *(const f32x4*)(g + col), sc = *(const f32x4*)(scalep + (size_t)b * mstride + col);
                al[j] = gg * (sc + 1.f); be[j] = *(const f32x4*)(shiftp + (size_t)b * mstride + col);
                if (DUAL) { const f32x4 gg2 = *(const f32x4*)(g2 + col), sc2 = *(const f32x4*)(scalep2 + (size_t)b * mstride2 + col);
                    al2[j] = gg2 * (sc2 + 1.f); be2[j] = *(const f32x4*)(shiftp2 + (size_t)b * mstride2 + col); } } }
        f32x4 v[4][4];
#pragma unroll
        for (int q = 0; q < 4; ++q) { const f32x4* xr = (const f32x4*)(x + (size_t)(m0 + q) * DM) + lane;
#pragma unroll
            for (int j = 0; j < 4; ++j) v[q][j] = xr[64 * j]; }
#pragma unroll
        for (int q = 0; q < 4; ++q) { float s2 = 0.f;
#pragma unroll
            for (int j = 0; j < 4; ++j) s2 += (v[q][j].x * v[q][j].x + v[q][j].y * v[q][j].y) + (v[q][j].z * v[q][j].z + v[q][j].w * v[q][j].w);
            const float rstd = __builtin_amdgcn_rsqf(wave_sum(s2) * (1.f / DM) + EPS);
            unsigned long long* o8 = (unsigned long long*)(outp + (size_t)(m0 + q) * DM) + lane;
            unsigned long long* o82 = (unsigned long long*)(outp2 + (size_t)(m0 + q) * DM) + lane;
#pragma unroll
            for (int j = 0; j < 4; ++j) { const f32x4 xh = v[q][j] * rstd;
                if (DUAL) { const f32x4 w2 = xh * al2[j] + be2[j];
                    o82[64 * j] = (unsigned long long)cvt_pk_bf16(w2.x, w2.y) | ((unsigned long long)cvt_pk_bf16(w2.z, w2.w) << 32); }
                v[q][j] = xh * al[j] + be[j];
                o8[64 * j] = (unsigned long long)cvt_pk_bf16(v[q][j].x, v[q][j].y) | ((unsigned long long)cvt_pk_bf16(v[q][j].z, v[q][j].w) << 32); } }
        if (FL) {
            float mine[4] = {0.f, 0.f, 0.f, 0.f};
#pragma unroll 2
            for (int h = 0; h < NH; ++h) { f32x4 w[4];
#pragma unroll
                for (int j = 0; j < 4; ++j) w[j] = *(const f32x4*)(wfl + h * DM + 4 * lane + 256 * j);
#pragma unroll
                for (int q = 0; q < 4; ++q) { float p = 0.f;
#pragma unroll
                    for (int j = 0; j < 4; ++j) p += (v[q][j].x * w[j].x + v[q][j].y * w[j].y) + (v[q][j].z * w[j].z + v[q][j].w * w[j].w);
                    p = wave_sum(p); if (lane == h) mine[q] = p; } }
            if (lane < NH) { const float fbv = fb[lane];
#pragma unroll
                for (int q = 0; q < 4; ++q) { const float z = mine[q] + fbv; const float ls = z < 0.f ? z - log1pf(__expf(z)) : -log1pf(__expf(-z));
                    LS[(size_t)(b * NH + lane) * SEQ + ((m0 + q) & (SEQ - 1))] = ls; } }
        }
    }
}

__device__ __forceinline__ void cumsum_phase(float* LS, int* JLO, const float* kg, const float* qg, char* lds, int wv) {
    const int tid = otid(wv), lane = tid & 63, wave = tid >> 6; float* wtot = (float*)lds; float* gl = (float*)(lds + 1024);
    float mk = fmaxf(fabsf(kg[lane]), fabsf(kg[lane + 64])), mq = fmaxf(fabsf(qg[lane]), fabsf(qg[lane + 64]));
#pragma unroll
    for (int o = 1; o < 64; o <<= 1) { mk = fmaxf(mk, __shfl_xor(mk, o)); mq = fmaxf(mq, __shfl_xor(mq, o)); }
    const float TH = (40.f + 2.f * (1.05f * 128.f * 1.4426950408889634f * 0.08838834764831845f * mk * mq)) / (1.4426950408889634f * 0.08838834764831845f);
    for (int bh = blockIdx.x; bh < BH; bh += gridDim.x) {
        float* p = LS + (size_t)bh * SEQ + tid * 8; f32x4 a = *(f32x4*)p, b = *(f32x4*)(p + 4);
        float v[8] = {a.x, a.y, a.z, a.w, b.x, b.y, b.z, b.w};
#pragma unroll
        for (int i = 1; i < 8; ++i) v[i] += v[i - 1];
        float run = v[7];
#pragma unroll
        for (int o = 1; o < 64; o <<= 1) { const float t = __shfl_up(run, o); if (lane >= o) run += t; }
        if (lane == 63) wtot[wave] = run;
        __syncthreads();
        float off = run - v[7];
        for (int w = 0; w < wave; ++w) off += wtot[w];
        const float k = -11.313708498984761f;
        a = (f32x4){(v[0] + off) * k, (v[1] + off) * k, (v[2] + off) * k, (v[3] + off) * k}; b = (f32x4){(v[4] + off) * k, (v[5] + off) * k, (v[6] + off) * k, (v[7] + off) * k};
        *(f32x4*)p = a; *(f32x4*)(p + 4) = b;
        *(f32x4*)(gl + tid * 8) = a; *(f32x4*)(gl + tid * 8 + 4) = b;
        __syncthreads();
#pragma unroll
        for (int rep = 0; rep < 2; ++rep) { const int qb = wave + 8 * rep, P0 = qb * 256;
            const bool skip = (64 * lane + 63 < P0) && (gl[P0] - gl[64 * lane + 63] > TH);
            const unsigned long long mask = __ballot(skip);
            if (lane == 0) JLO[bh * 16 + qb] = __popcll(mask); }
        __syncthreads();
    }
}

__device__ __forceinline__ void p4_scan(const Args& a, char* lds, int dry, int wv) {
    const int tid = otid(wv), lane = tid & 63, w = tid >> 6, r = lane & 15, gq = lane >> 4, vg = w & 3, kh = w >> 2;
    unsigned char* ws = a.ws;
    bf16_t* R0 = (bf16_t*)(ws + WS_R0); const bf16_t* R1 = (const bf16_t*)(ws + WS_R1); const bf16_t* R2 = (const bf16_t*)(ws + WS_R2);
    const float* LB = (const float*)(ws + WS_LB);
    constexpr int BUF = 45568, O_QD = 0, O_KT = 17408, O_AT = 35840, O_DL = 45056, O_XS = 2 * BUF, O_PART = O_XS + 32768, O_V = O_PART + 2048;
    typedef short v4i16_t __attribute__((ext_vector_type(4)));
    const LAS char* const vtr0 = (const LAS char*)(LAS unsigned char*)(lds) + O_V + (8 * gq + (r >> 2)) * 272 + (32 * vg + 4 * (r & 3)) * 2;
    const int pk0 = 4 * (tid & 31), prg = tid >> 5, pc0 = 4 * prg;
    bf16_t* const tf = (bf16_t*)(lds + O_V);
    for (int bh = blockIdx.x; bh < BH; bh += gridDim.x) {
        const int h = bh & 15;
        const f32x4 og0 = *(const f32x4*)(a.a_onorm_g + h * HD + 32 * vg + 4 * gq), og1 = *(const f32x4*)(a.a_onorm_g + h * HD + 32 * vg + 16 + 4 * gq);
        const f32x4 lbv4 = *(const f32x4*)(LB + h * HD + pk0), om4 = 1.f - lbv4;
        f32x4 st[4][2];
#pragma unroll
        for (int i = 0; i < 4; ++i) { st[i][0] = (f32x4){0.f, 0.f, 0.f, 0.f}; st[i][1] = (f32x4){0.f, 0.f, 0.f, 0.f}; }
        u32x2 sqA[4], sfA[4], sqB[4], sfB[4]; u32x4 svA[2], svB[2]; bf16x8 vb[2][2];
        char* const xs_own = lds + O_XS + w * 4096 + lane * 16; const char* const xs_par = lds + O_XS + (w ^ 4) * 4096 + lane * 16;
        { const u32x4 z = {0u, 0u, 0u, 0u};
#pragma unroll
          for (int f = 0; f < 4; ++f) *(u32x4*)(xs_own + f * 1024) = z; }
#define P4_LOAD(X, n_) do { const size_t blk_ = ((size_t)bh * SEQ + (size_t)(n_) * 64) * HD; \
            _Pragma("unroll") for (int i = 0; i < 4; ++i) { sq##X[i] = *(const u32x2*)(R0 + blk_ + (size_t)(pc0 + i) * HD + pk0); sf##X[i] = *(const u32x2*)(R1 + blk_ + (size_t)(pc0 + i) * HD + pk0); } \
            _Pragma("unroll") for (int rep = 0; rep < 2; ++rep) { const int i = tid + rep * 512; sv##X[rep] = *(const u32x4*)(R2 + blk_ + (size_t)i * 8); } } while (0)
#define P4_WRITE_V(X) do { _Pragma("unroll") for (int rep = 0; rep < 2; ++rep) { const int i = tid + rep * 512; *(u32x4*)(lds + O_V + (i >> 4) * 272 + (i & 15) * 16) = sv##X[rep]; } } while (0)
#define P4_PACK(DST, ksl, vt) do { u32x4 bw_; bw_.x = cvt_pk_bf16(st[2 * (ksl)][vt][0], st[2 * (ksl)][vt][1]); bw_.y = cvt_pk_bf16(st[2 * (ksl)][vt][2], st[2 * (ksl)][vt][3]); \
            bw_.z = cvt_pk_bf16(st[2 * (ksl) + 1][vt][0], st[2 * (ksl) + 1][vt][1]); bw_.w = cvt_pk_bf16(st[2 * (ksl) + 1][vt][2], st[2 * (ksl) + 1][vt][3]); DST = bw_; } while (0)
#define P4_PREP(X, bf_) do { char* B_ = lds + (bf_) * BUF; bf16_t* tq = (bf16_t*)(B_ + O_QD); float* part2 = (float*)(B_ + O_AT); \
              \
            float ee[4][4]; f32x4 kq_[4]; f32x4 run = {1.f, 1.f, 1.f, 1.f}; \
            _Pragma("unroll") for (int i = 0; i < 4; ++i) { const u32x2 wz = sf##X[i]; \
                const f32x4 fz = {__uint_as_float(wz.x << 16), __uint_as_float(wz.x & 0xffff0000u), __uint_as_float(wz.y << 16), __uint_as_float(wz.y & 0xffff0000u)}; \
                _Pragma("unroll") for (int j = 0; j < 4; ++j) { const float sg = __builtin_amdgcn_rcpf(1.f + __expf(-fz[j])); const float f = lbv4[j] + om4[j] * sg; run[j] *= f; ee[i][j] = run[j]; kq_[i][j] = 1.f - f; } } \
            *(f32x4*)(part2 + prg * 128 + pk0) = run; \
            __syncthreads(); \
            _Pragma("unroll") for (int ksl = 0; ksl < 2; ++ksl) _Pragma("unroll") for (int vt = 0; vt < 2; ++vt) { u32x4 t_; P4_PACK(t_, ksl, vt); *(u32x4*)(xs_own + (ksl * 2 + vt) * 1024) = t_; } \
            if (tid < 32) { f32x4 pa_ = {1.f, 1.f, 1.f, 1.f};     \
                _Pragma("unroll") for (int g = 0; g < 16; ++g) { f32x4* pp_ = (f32x4*)(part2 + g * 128 + 4 * tid); const f32x4 pg = *pp_; *pp_ = pa_; pa_ = pa_ * pg; } \
                *(f32x4*)(part2 + 16 * 128 + 4 * tid) = pa_; } \
            __syncthreads(); \
            const f32x4 offp = *(const f32x4*)(part2 + prg * 128 + pk0), totp = *(const f32x4*)(part2 + 16 * 128 + pk0); \
            float ks_[4][4]; \
            _Pragma("unroll") for (int i = 0; i < 4; ++i) { const u32x2 wq = sq##X[i]; \
                const f32x4 qv = {__uint_as_float(wq.x << 16), __uint_as_float(wq.x & 0xffff0000u), __uint_as_float(wq.y << 16), __uint_as_float(wq.y & 0xffff0000u)}; f32x4 qd, ki; \
                  \
                const u32x2 wk = {cvt_pk_bf16(kq_[i][0], kq_[i][1]), cvt_pk_bf16(kq_[i][2], kq_[i][3])}; \
                const f32x4 kv = {__uint_as_float(wk.x << 16), __uint_as_float(wk.x & 0xffff0000u), __uint_as_float(wk.y << 16), __uint_as_float(wk.y & 0xffff0000u)}; \
                _Pragma("unroll") for (int j = 0; j < 4; ++j) { const float ea = offp[j] * ee[i][j]; const float ie = __builtin_amdgcn_rcpf(ea); qd[j] = qv[j] * ea; ki[j] = kv[j] * ie; ks_[j][i] = ki[j] * totp[j]; } \
                u32x2 o1, o2; o1.x = cvt_pk_bf16(qd[0], qd[1]); o1.y = cvt_pk_bf16(qd[2], qd[3]); o2.x = cvt_pk_bf16(ki[0], ki[1]); o2.y = cvt_pk_bf16(ki[2], ki[3]); \
                *(u32x2*)(tq + (pc0 + i) * 136 + pk0) = o1; *(u32x2*)(tf + (pc0 + i) * 136 + pk0) = o2; } \
            _Pragma("unroll") for (int j = 0; j < 4; ++j) { u32x2 wk; wk.x = cvt_pk_bf16(ks_[j][0], ks_[j][1]); wk.y = cvt_pk_bf16(ks_[j][2], ks_[j][3]); *(u32x2*)(B_ + O_KT + (pk0 + j) * 144 + pc0 * 2) = wk; } \
            if (prg == 0) *(f32x4*)(B_ + O_DL + pk0 * 4) = totp; \
            __syncthreads(); \
            { const int mt = w >> 1, nt0 = (w & 1) * 2; f32x4 acc2[2] = {{0.f, 0.f, 0.f, 0.f}, {0.f, 0.f, 0.f, 0.f}}; \
              _Pragma("unroll") for (int ks = 0; ks < 4; ++ks) { const bf16x8 Aq = *(const bf16x8*)(tq + (16 * mt + r) * 136 + ks * 32 + gq * 8); \
                  _Pragma("unroll") for (int j = 0; j < 2; ++j) { const bf16x8 Bk = *(const bf16x8*)(tf + (16 * (nt0 + j) + r) * 136 + ks * 32 + gq * 8); \
                      acc2[j] = __builtin_amdgcn_mfma_f32_16x16x32_bf16(Bk, Aq, acc2[j], 0, 0, 0); } }     \
              char* ap = B_ + O_AT; \
              __syncthreads();     \
              _Pragma("unroll") for (int j = 0; j < 2; ++j) { const int c = 16 * mt + r, s0_ = 16 * (nt0 + j) + 4 * gq; \
                  u32x2 wa; wa.x = cvt_pk_bf16(s0_ <= c ? acc2[j][0] : 0.f, s0_ + 1 <= c ? acc2[j][1] : 0.f); wa.y = cvt_pk_bf16(s0_ + 2 <= c ? acc2[j][2] : 0.f, s0_ + 3 <= c ? acc2[j][3] : 0.f); \
                  *(u32x2*)(ap + c * 144 + s0_ * 2) = wa; } } \
            P4_WRITE_V(X); \
            __syncthreads(); } while (0)
#define P4_STEP(n_, CUR, X, Y) do { const char* B = lds + (CUR) * BUF; \
            _Pragma("unroll") for (int vt = 0; vt < 2; ++vt) _Pragma("unroll") for (int cs = 0; cs < 2; ++cs) { \
                const v4i16_t lo_ = __builtin_amdgcn_ds_read_tr16_b64_v4i16((LAS v4i16_t*)(vtr0 + cs * 32 * 272 + vt * 32)); \
                const v4i16_t hi_ = __builtin_amdgcn_ds_read_tr16_b64_v4i16((LAS v4i16_t*)(vtr0 + cs * 32 * 272 + vt * 32 + 4 * 272)); \
                vb[vt][cs] = (bf16x8){lo_[0], lo_[1], lo_[2], lo_[3], hi_[0], hi_[1], hi_[2], hi_[3]}; } \
            P4_LOAD(X, ((n_) + 2 < 64) ? (n_) + 2 : 63); \
            f32x4 oo[2][2]; \
            _Pragma("unroll") for (int ml = 0; ml < 2; ++ml) { oo[ml][0] = (f32x4){0.f, 0.f, 0.f, 0.f}; oo[ml][1] = (f32x4){0.f, 0.f, 0.f, 0.f}; \
                _Pragma("unroll") for (int ks = 0; ks < 2; ++ks) { const bf16x8 Bq = *(const bf16x8*)(B + O_AT + (32 * kh + 16 * ml + r) * 144 + ks * 64 + gq * 16); \
                    _Pragma("unroll") for (int vt = 0; vt < 2; ++vt) oo[ml][vt] = __builtin_amdgcn_mfma_f32_16x16x32_bf16(vb[vt][ks], Bq, oo[ml][vt], 0, 0, 0); } } \
            _Pragma("unroll") for (int hf = 0; hf < 2; ++hf) _Pragma("unroll") for (int ksl = 0; ksl < 2; ++ksl) { const int ksg = 2 * (hf == 0 ? kh : 1 - kh) + ksl; u32x4 sf_[2]; \
                _Pragma("unroll") for (int vt = 0; vt < 2; ++vt) sf_[vt] = *(const u32x4*)((hf == 0 ? (const char*)xs_own : xs_par) + (ksl * 2 + vt) * 1024); \
                _Pragma("unroll") for (int ml = 0; ml < 2; ++ml) { const char* qa = B + O_QD + (32 * kh + 16 * ml + r) * 272 + ksg * 64 + gq * 8; \
                    const u32x2 a0 = *(const u32x2*)qa, a1 = *(const u32x2*)(qa + 32); const u32x4 aw = {a0.x, a0.y, a1.x, a1.y}; \
                    _Pragma("unroll") for (int vt = 0; vt < 2; ++vt) oo[ml][vt] = __builtin_amdgcn_mfma_f32_16x16x32_bf16(__builtin_bit_cast(bf16x8, sf_[vt]), __builtin_bit_cast(bf16x8, aw), oo[ml][vt], 0, 0, 0); } } \
            float* part = (float*)(lds + O_PART) + (CUR) * 256; \
            _Pragma("unroll") for (int ml = 0; ml < 2; ++ml) { float s_ = 0.f; \
                _Pragma("unroll") for (int vt = 0; vt < 2; ++vt) s_ += (oo[ml][vt][0] * oo[ml][vt][0] + oo[ml][vt][1] * oo[ml][vt][1]) + (oo[ml][vt][2] * oo[ml][vt][2] + oo[ml][vt][3] * oo[ml][vt][3]); \
                s_ += __shfl_xor(s_, 16); s_ += __shfl_xor(s_, 32); if (gq == 0) part[(32 * kh + 16 * ml + r) * 4 + vg] = s_; } \
            _Pragma("unroll") for (int i = 0; i < 4; ++i) { const f32x4 dlv = *(const f32x4*)(B + O_DL + (64 * kh + 16 * i + 4 * gq) * 4); st[i][0] = st[i][0] * dlv; st[i][1] = st[i][1] * dlv; \
                _Pragma("unroll") for (int cs = 0; cs < 2; ++cs) { const bf16x8 A = *(const bf16x8*)(B + O_KT + (64 * kh + 16 * i + r) * 144 + cs * 64 + gq * 16); \
                    _Pragma("unroll") for (int vt = 0; vt < 2; ++vt) st[i][vt] = __builtin_amdgcn_mfma_f32_16x16x32_bf16(A, vb[vt][cs], st[i][vt], 0, 0, 0); } } \
            P4_PREP(Y, (CUR) ^ 1); \
            { bf16_t* op = R0 + ((size_t)bh * SEQ + (size_t)(n_) * 64) * HD + 32 * vg + 4 * gq; \
              _Pragma("unroll") for (int ml = 0; ml < 2; ++ml) { const int c = 32 * kh + 16 * ml + r; const f32x4 p0 = *(const f32x4*)(part + c * 4); \
                const float rs = __builtin_amdgcn_rsqf(((p0.x + p0.y) + (p0.z + p0.w)) * (1.f / HD) + EPS); \
                const f32x4 ov0 = oo[ml][0] * og0 * rs, ov1 = oo[ml][1] * og1 * rs; u32x2 pk0, pk1; pk0.x = cvt_pk_bf16(ov0[0], ov0[1]); pk0.y = cvt_pk_bf16(ov0[2], ov0[3]); pk1.x = cvt_pk_bf16(ov1[0], ov1[1]); pk1.y = cvt_pk_bf16(ov1[2], ov1[3]); \
                if (!dry) { *(u32x2*)(op + (size_t)c * HD) = pk0; *(u32x2*)(op + (size_t)c * HD + 16) = pk1; } else asm volatile("" :: "v"(pk0), "v"(pk1)); } } } while (0)
        P4_LOAD(A, 0); P4_LOAD(B, 1);
        __syncthreads();
        P4_PREP(A, 0);
        for (int n = 0; n < 64; n += 2) { P4_STEP(n, 0, A, B); P4_STEP(n + 1, 1, B, A); }
        __syncthreads();
#undef P4_LOAD
#undef P4_WRITE_V
#undef P4_PREP
#undef P4_PACK
#undef P4_STEP
    }
}

#define XB_TMO      128
#define XB_XCNT(j)  (256  + 64 * (j))
#define XB_XSUB(j)  (1280 + 64 * (j))
#define XB_XGEN(j)  (2304 + 64 * (j))
#define XB_TOP      3328
#define XB_TOPGEN   3392
#define XCD_BAR_WORDS 3456
#define XB_SPIN_CAP (1u << 22)
__device__ __forceinline__ unsigned xb_ld(unsigned* p)              { return __hip_atomic_load(p, __ATOMIC_RELAXED, __HIP_MEMORY_SCOPE_AGENT); }
__device__ __forceinline__ unsigned xb_add(unsigned* p, unsigned v) { return __hip_atomic_fetch_add(p, v, __ATOMIC_RELAXED, __HIP_MEMORY_SCOPE_AGENT); }
__device__ __forceinline__ unsigned xb_xcc_id() { return (unsigned)__builtin_amdgcn_s_getreg((3 << 11) | 20) & 0xFu; }
#define XB_SPIN(cond, bar) do { unsigned _sp = 0; while (cond) { __builtin_amdgcn_s_sleep(1); \
    if ((++_sp & 255u) == 0u) { if (xb_ld(&(bar)[XB_TMO])) break; if (_sp > XB_SPIN_CAP) { atomicAdd(&(bar)[XB_TMO], 1u); break; } } } } while (0)
struct XcdBarrier { unsigned* bar; unsigned x; volatile LAS unsigned* st; };
__device__ __forceinline__ XcdBarrier xcd_barrier_post(unsigned* bar, volatile LAS unsigned* st) {
    XcdBarrier b; b.bar = bar; b.x = xb_xcc_id(); b.st = st;
    if (threadIdx.x == 0) (void)xb_add(&bar[XB_XCNT(b.x)], 1u);
    return b;
}
__device__ __forceinline__ void xcd_barrier_complete(unsigned* bar, unsigned x, unsigned& nloc, unsigned& nx) {
    const unsigned G = gridDim.x * gridDim.y * gridDim.z;
    unsigned sum, cnt, mine, sp = 0u;
    for (;;) {
        sum = 0u; cnt = 0u; mine = 0u;
#pragma unroll
        for (unsigned j = 0; j < 16; ++j) { const unsigned c = xb_ld(&bar[XB_XCNT(j)]); sum += c; cnt += (c > 0u) ? 1u : 0u; mine = (j == x) ? c : mine; }
        if (sum == G) break;
        __builtin_amdgcn_s_sleep(1);
        if ((++sp & 255u) == 0u) { if (xb_ld(&bar[XB_TMO])) break; if (sp > XB_SPIN_CAP) { atomicAdd(&bar[XB_TMO], 1u); break; } }
    }
    nloc = mine > 0u ? mine : 1u; nx = cnt > 0u ? cnt : 1u;
}
__device__ __forceinline__ void xcd_barrier(unsigned* bar_, volatile LAS unsigned* st_, int wv) {
    const int tid0 = otid(wv);
    asm volatile("" : "+s"(bar_));
    XcdBarrier b; b.bar = bar_; b.st = st_; b.x = 0;
    asm volatile("s_waitcnt vmcnt(0)" ::: "memory");
    __syncthreads();
    if (tid0 == 0) {
        unsigned* bar = b.bar; b.x = xb_xcc_id();
        __builtin_amdgcn_s_waitcnt(0);
        unsigned nloc = b.st[0], nx = b.st[1];
        if (nloc == 0u) { xcd_barrier_complete(bar, b.x, nloc, nx); b.st[0] = nloc; b.st[1] = nx; }
        const unsigned old = xb_add(&bar[XB_XSUB(b.x)], 1u);
        const unsigned gen = old / nloc;
        if (old + 1u == (gen + 1u) * nloc) {
            __builtin_amdgcn_fence(__ATOMIC_RELEASE, "agent");
            asm volatile("s_waitcnt vmcnt(0)" ::: "memory");
            const unsigned og = xb_add(&bar[XB_TOP], 1u);
            const unsigned tg = og / nx;
            if (og + 1u == (tg + 1u) * nx) xb_add(&bar[XB_TOPGEN], 1u);
            else XB_SPIN(xb_ld(&bar[XB_TOPGEN]) == tg, bar);
            __builtin_amdgcn_fence(__ATOMIC_ACQUIRE, "agent");
            xb_add(&bar[XB_XGEN(b.x)], 1u);
            asm volatile("s_waitcnt vmcnt(0)" ::: "memory");
        } else {
            XB_SPIN(xb_ld(&bar[XB_XGEN(b.x)]) == gen, bar);
            __builtin_amdgcn_fence(__ATOMIC_ACQUIRE, "agent");
            asm volatile("s_waitcnt vmcnt(0)" ::: "memory");
        }
    }
    __syncthreads();
}

__global__ void __launch_bounds__(512, 2) yoco_fwd(Args a) {
    extern __shared__ __attribute__((aligned(16))) unsigned char lds_raw[];
    char* lds = (char*)lds_raw; LAS unsigned char* ldsl = (LAS unsigned char*)lds_raw;
    cg::grid_group grid = cg::this_grid();
    const int wv = __builtin_amdgcn_readfirstlane((int)threadIdx.x >> 6);
    unsigned char* ws = a.ws;
    bf16_t* R0 = (bf16_t*)(ws + WS_R0); bf16_t* R1 = (bf16_t*)(ws + WS_R1); bf16_t* R2 = (bf16_t*)(ws + WS_R2);
    bf16_t* XA = (bf16_t*)(ws + WS_XA); bf16_t* H0 = (bf16_t*)a.out;
    const float* MOD0 = (const float*)(ws + WS_MOD0); const float* MOD1 = (const float*)(ws + WS_MOD1); const float* KVMOD = (const float*)(ws + WS_KVMOD);
    float* LSG = (float*)(ws + WS_LSG);
    const int G = gridDim.x, c = blockIdx.x;
    constexpr size_t TS = 64 * MiB;

    unsigned* barw = (unsigned*)(ws + WS_SM + 786432);
    volatile LAS unsigned* bst = (volatile LAS unsigned*)(ldsl + 143360);
    if (threadIdx.x == 0) { bst[0] = 0u; bst[1] = 0u; }
    if (a.one == 0) grid.sync();
    (void)xcd_barrier_post(barw, bst);
#define GSYNC() xcd_barrier((unsigned*)(a.ws + WS_SM + 786432), (volatile LAS unsigned*)(ldsl + 143360), wv)
    p0_prologue(a, lds, wv);
    GSYNC();
    norm_phase<false, false>(a.x, a.norm_g, MOD0, MOD0 + 1024, 3072, H0, nullptr, nullptr, nullptr, 0, nullptr, nullptr, nullptr, nullptr, lds, wv);
    GSYNC();
    { pg8::Gemm g{H0, (const bf16_t*)(ws + WS_W1), TOK, 6144, DM, 2048u, 256, (size_t)4096 * 2048}; pg8::StaticOrder S; S.init(TOK, 6144, G, c);
      pg8::EpiHead E{R0, TS}; pg8::gemm_phase(ldsl, g, S, E, wv);
    }
    GSYNC();
    p4_scan(a, lds, 0, wv);
    GSYNC();
    { pg8::Gemm g{H0, (const bf16_t*)(ws + WS_W1) + (size_t)6144 * DM, TOK, 2048, DM, 2048u, 256, (size_t)4096 * 2048}; pg8::StaticOrder S; S.init(TOK, 2048, G, c);
      pg8::EpiMulSilu E{R0}; pg8::gemm_phase(ldsl, g, S, E, wv); }
    GSYNC();
    { pg8::Gemm g{R0, (const bf16_t*)(ws + WS_W2), TOK, DM, WD, 256u, (size_t)SEQ * 256, (size_t)16 * SEQ * 256}; pg8::StaticOrder S; S.init(TOK, DM, G, c);
      pg8::EpiRes E{a.x, a.out, MOD0 + 2048}; pg8::gemm_phase(ldsl, g, S, E, wv);
    }
    GSYNC();
    norm_phase<true, true>(a.out, a.kv_norm_g, KVMOD, KVMOD + 1024, 2048, R0, a.norm_g + DM, MOD1, MOD1 + 1024, 3072, XA, (const float*)(ws + WS_WFL), a.kv_fb, LSG, lds, wv);
    GSYNC();
    cumsum_phase(LSG, (int*)(ws + WS_SM + 802816), a.k_norm_g, a.b_q_norm_g, lds, wv);
    { pg8::Gemm g{R0, (const bf16_t*)(ws + WS_W3KV), TOK, 4096, DM, 2048u, 256, (size_t)4096 * 2048}; pg8::StaticOrder S; S.init(TOK, 4096, G, c);
      pg8::EpiHeadNorm E{R1, TS, 1, a.k_norm_g, (LAS float*)(ldsl + 131072)}; pg8::gemm_phase(ldsl, g, S, E, wv);
    }
    GSYNC();
    { pg8::Gemm g{XA, (const bf16_t*)(ws + WS_W3Q), TOK, 2048, DM, 2048u, 256, (size_t)4096 * 2048}; pg8::StaticOrder S; S.init(TOK, 2048, G, c);
      pg8::EpiHeadNorm E{R0, TS, 1, a.b_q_norm_g, (LAS float*)(ldsl + 131072)}; pg8::gemm_phase(ldsl, g, S, E, wv); }
    GSYNC();
    att::phase(lds, R0, R1, R2, LSG, (const int*)(ws + WS_SM + 802816), R0, (bf16_t*)(ws + WS_SM + 716800), 2048, wv);
    GSYNC();
    { pg8::Gemm g{XA, (const bf16_t*)(ws + WS_W3G), TOK, 2048, DM, 2048u, 256, (size_t)4096 * 2048}; pg8::StaticOrder S; S.init(TOK, 2048, G, c);
      pg8::EpiMulSilu E{R0}; pg8::gemm_phase(ldsl, g, S, E, wv); }
    GSYNC();
    { pg8::Gemm g{R0, (const bf16_t*)(ws + WS_W4), TOK, DM, WD, 256u, (size_t)SEQ * 256, (size_t)16 * SEQ * 256}; pg8::StaticOrder S; S.init(TOK, DM, G, c);
      pg8::EpiRes E{a.out, a.out, MOD1 + 2048}; pg8::gemm_phase(ldsl, g, S, E, wv); }
}

extern "C" void kernel_launch(void* const* d_in, const int* in_sizes, int n_in, void* d_out, int out_size, void* d_ws, size_t ws_size, hipStream_t stream) {
    static int grid = 0;
    if (grid == 0) {
        int dev = 0, cus = 0, per_cu = 0;
        hipGetDevice(&dev); hipDeviceGetAttribute(&cus, hipDeviceAttributeMultiprocessorCount, dev);
        hipFuncSetAttribute((const void*)yoco_fwd, hipFuncAttributeMaxDynamicSharedMemorySize, LDS_BYTES);
        hipOccupancyMaxActiveBlocksPerMultiprocessor(&per_cu, (const void*)yoco_fwd, 512, LDS_BYTES);
        (void)hipGetLastError();
        if (cus <= 0) cus = 256;
        grid = cus;
        if (per_cu < 1) fprintf(stderr, "kernel_launch: occupancy query reports %d blocks/CU\n", per_cu);
        if (ws_size < 512 * MiB) fprintf(stderr, "kernel_launch: workspace too small (%zu)\n", ws_size);
    }
    if (hipMemsetAsync((char*)d_ws + WS_SM + 786432, 0, 16384, stream) != hipSuccess) fprintf(stderr, "kernel_launch: memset of barrier words failed\n");
    Args a{};
    const float** pp = (const float**)&a;
    for (int i = 0; i < 18; ++i) pp[i] = (const float*)d_in[i];
    a.out = (float*)d_out; a.ws = (unsigned char*)d_ws; a.one = 1;
    void* args[] = {&a};
    hipError_t e = hipLaunchCooperativeKernel((const void*)yoco_fwd, dim3(grid), dim3(512), args, LDS_BYTES, stream);
    if (e != hipSuccess) fprintf(stderr, "cooperative launch failed: %s (grid %d)\n", hipGetErrorString(e), grid);
}
```

```cpp
#include <hip/hip_runtime.h>
#include <hip/hip_cooperative_groups.h>
#include <cstdio>
#include <cstdint>
namespace cg = cooperative_groups;

#define LAS __attribute__((address_space(3)))
typedef unsigned short bf16_t;
typedef short bf16x8 __attribute__((ext_vector_type(8)));
typedef short s16x4 __attribute__((ext_vector_type(4)));
typedef float f32x4 __attribute__((ext_vector_type(4)));
typedef float f32x16 __attribute__((ext_vector_type(16)));
typedef unsigned u32x4 __attribute__((ext_vector_type(4)));
typedef unsigned u32x2 __attribute__((ext_vector_type(2)));

constexpr int NB = 8, SEQ = 4096, DM = 1024, WD = 2048, NH = 16, HD = 128, BH = NB * NH, TOK = NB * SEQ;
constexpr float EPS = 1e-6f;
constexpr size_t MiB = 1u << 20;
constexpr size_t WS_R0 = 0, WS_R1 = 128 * MiB, WS_R2 = 256 * MiB, WS_XA = 384 * MiB;
constexpr size_t WS_W1 = 448 * MiB, WS_W2 = 464 * MiB, WS_W3KV = 468 * MiB, WS_W3Q = 476 * MiB, WS_W3G = 480 * MiB, WS_W4 = 484 * MiB;
constexpr size_t WS_SM = 488 * MiB;
constexpr size_t WS_MOD0 = WS_SM, WS_MOD1 = WS_SM + 98304, WS_KVMOD = WS_SM + 196608, WS_LB = WS_SM + 262144, WS_WFL = WS_SM + 270336;
constexpr size_t WS_LSG = WS_SM + 1 * MiB, WS_DL = WS_SM + 4 * MiB;
constexpr int LDS_BYTES = 147456;

__device__ __forceinline__ float bf2f(unsigned short h) { return __uint_as_float(((unsigned)h) << 16); }
typedef float f32x2_t __attribute__((ext_vector_type(2))); typedef __bf16 bf16x2_t __attribute__((ext_vector_type(2)));
__device__ __forceinline__ unsigned cvt_pk_bf16(float lo, float hi) { f32x2_t v = {lo, hi}; bf16x2_t b = __builtin_convertvector(v, bf16x2_t); return __builtin_bit_cast(unsigned, b); }
__device__ __forceinline__ unsigned short f2bf(float f) { return (unsigned short)(cvt_pk_bf16(f, 0.f) & 0xffffu); }
__device__ __forceinline__ float wave_sum(float v) {
#pragma unroll
    for (int o = 1; o < 64; o <<= 1) v += __shfl_xor(v, o);
    return v;
}
__device__ __forceinline__ int otid(int wv) { int t = wv * 64 + (int)__builtin_amdgcn_mbcnt_hi(~0u, __builtin_amdgcn_mbcnt_lo(~0u, 0u)); asm volatile("" : "+v"(t)); return t; }
__device__ __forceinline__ float silu_f(float x) { return x * __builtin_amdgcn_rcpf(1.f + __builtin_amdgcn_exp2f(-1.4426950408889634f * x)); }

namespace pg8 {
constexpr int BM = 256, BK = 64, HALF = 128, HTB = HALF * BK * 2, STAGE_BYTES = 8 * HTB, NXCD = 8, WGM = 8;
__host__ __device__ __forceinline__ int lds_byte(int r, int c) { const int st = (r >> 4) * 2 + (c >> 5), rr = r & 15, cc = c & 31, ob = rr * 64 + cc * 2; return st * 1024 + (ob ^ (((ob >> 9) & 1) << 5)); }
__host__ __device__ __forceinline__ void stage_rc(int b, int& R, int& C) { const int st = b / 1024, sb = b % 1024, swz = sb ^ (((sb >> 9) & 1) << 5); R = (st >> 1) * 16 + swz / 64; C = (st & 1) * 32 + (swz % 64) / 2; }
__host__ __device__ __forceinline__ int perm32(int rho) { const int n = rho >> 4, i = rho & 15; return 8 * (i >> 2) + 4 * n + (i & 3); }

struct Unit { int pm, pn; };
struct Gemm { const bf16_t* A; const bf16_t* Bt; int M, N, K; unsigned lda; size_t hsA, bsA; };

struct StaticOrder {
    int nM, nN, nwg, G, c;
    __device__ void init(int M, int N, int G_, int c_) { nM = M / BM; nN = N / BM; nwg = nM * nN; G = G_; c = c_; }
    __device__ bool next(int i, Unit& u) const {
        const long L = (long)i * G + c; if (L >= nwg) return false;
        int wgid = (int)L; { const int q = nwg / NXCD, r = nwg % NXCD, xcd = wgid % NXCD, off = wgid / NXCD; wgid = (xcd < r ? xcd * (q + 1) : r * (q + 1) + (xcd - r) * q) + off; }
        const int nig = WGM * nN, gid = wgid / nig, fm = gid * WGM, gsz = (nM - fm) < WGM ? (nM - fm) : WGM;
        u.pm = fm + ((wgid % nig) % gsz); u.pn = (wgid % nig) / gsz; return true;
    }
};

struct EarlyOrder {
    int e;
    __device__ bool next(int i, Unit& u) const { if (i >= 6) return false; const int uu = i * 128 + e, rp = uu >> 6, idx = uu & 63; u.pm = (idx >> 3) * 16 + rp; u.pn = idx & 7; return true; }
};
struct RestOrder {
    int c;
    __device__ bool next(int i, Unit& u) const { if (i >= 1) return false; const int rp = 12 + (c >> 6), idx = c & 63; u.pm = (idx >> 3) * 16 + rp; u.pn = idx & 7; return true; }
};

struct EpiHead {
    bf16_t* base0; size_t tstride;
    __device__ __forceinline__ void operator()(const f32x4 (&acc)[2][2][4][2], const Unit& u, int wr, int wc, int fr, int fq) const {
        const int b = u.pm >> 4, s0 = (u.pm & 15) * 256 + wr * 64 + fr, t = u.pn >> 3, hd0 = (u.pn & 7) * 2;
        bf16_t* base = base0 + (size_t)t * tstride + wc * 32 + 8 * fq;
#pragma unroll
        for (int ai = 0; ai < 2; ++ai)
#pragma unroll
            for (int m = 0; m < 4; ++m)
#pragma unroll
                for (int bj = 0; bj < 2; ++bj) {
                    const f32x4 v0 = acc[ai][bj][m][0], v1 = acc[ai][bj][m][1];
                    u32x4 w; w.x = cvt_pk_bf16(v0[0], v0[1]); w.y = cvt_pk_bf16(v0[2], v0[3]); w.z = cvt_pk_bf16(v1[0], v1[1]); w.w = cvt_pk_bf16(v1[2], v1[3]);
                    *(u32x4*)(base + ((size_t)(b * 16 + hd0 + bj) * SEQ + s0 + ai * HALF + m * 16) * HD) = w;
                }
    }
};
struct EpiHeadNorm {
    bf16_t* base0; size_t tstride; int nnorm; const float* g; LAS float* xch;
    __device__ __forceinline__ void operator()(const f32x4 (&acc)[2][2][4][2], const Unit& u, int wr, int wc, int fr, int fq) const {
        const int b = u.pm >> 4, s0 = (u.pm & 15) * 256 + wr * 64 + fr, t = u.pn >> 3, hd0 = (u.pn & 7) * 2;
        bf16_t* base = base0 + (size_t)t * tstride + wc * 32 + 8 * fq;
        if (t < nnorm) {
#pragma unroll
            for (int ai = 0; ai < 2; ++ai)
#pragma unroll
                for (int m = 0; m < 4; ++m)
#pragma unroll
                    for (int bj = 0; bj < 2; ++bj) { const f32x4 v0 = acc[ai][bj][m][0], v1 = acc[ai][bj][m][1];
                        float sq = ((v0[0] * v0[0] + v0[1] * v0[1]) + (v0[2] * v0[2] + v0[3] * v0[3])) + ((v1[0] * v1[0] + v1[1] * v1[1]) + (v1[2] * v1[2] + v1[3] * v1[3]));
                        sq += __shfl_xor(sq, 16); sq += __shfl_xor(sq, 32);
                        if (fq == 0) xch[((ai * HALF + wr * 64 + m * 16 + fr) * 2 + bj) * 4 + wc] = sq; }
            asm volatile("s_waitcnt lgkmcnt(0)" ::: "memory"); __builtin_amdgcn_s_barrier(); asm volatile("" ::: "memory");
            const f32x4 g0 = *(const f32x4*)(g + wc * 32 + 8 * fq), g1 = *(const f32x4*)(g + wc * 32 + 8 * fq + 4);
#pragma unroll
            for (int ai = 0; ai < 2; ++ai)
#pragma unroll
                for (int m = 0; m < 4; ++m)
#pragma unroll
                    for (int bj = 0; bj < 2; ++bj) {
                        const f32x4 p = *(const LAS f32x4*)(xch + ((ai * HALF + wr * 64 + m * 16 + fr) * 2 + bj) * 4);
                        const float rs = __builtin_amdgcn_rsqf(((p[0] + p[1]) + (p[2] + p[3])) * (1.f / 128.f) + EPS);
                        const f32x4 v0 = acc[ai][bj][m][0] * g0 * rs, v1 = acc[ai][bj][m][1] * g1 * rs;
                        u32x4 w; w.x = cvt_pk_bf16(v0[0], v0[1]); w.y = cvt_pk_bf16(v0[2], v0[3]); w.z = cvt_pk_bf16(v1[0], v1[1]); w.w = cvt_pk_bf16(v1[2], v1[3]);
                        *(u32x4*)(base + ((size_t)(b * 16 + hd0 + bj) * SEQ + s0 + ai * HALF + m * 16) * HD) = w;
                    }
        } else {
#pragma unroll
            for (int ai = 0; ai < 2; ++ai)
#pragma unroll
                for (int m = 0; m < 4; ++m)
#pragma unroll
                    for (int bj = 0; bj < 2; ++bj) {
                        const f32x4 v0 = acc[ai][bj][m][0], v1 = acc[ai][bj][m][1];
                        u32x4 w; w.x = cvt_pk_bf16(v0[0], v0[1]); w.y = cvt_pk_bf16(v0[2], v0[3]); w.z = cvt_pk_bf16(v1[0], v1[1]); w.w = cvt_pk_bf16(v1[2], v1[3]);
                        *(u32x4*)(base + ((size_t)(b * 16 + hd0 + bj) * SEQ + s0 + ai * HALF + m * 16) * HD) = w;
                    }
        }
    }
};
struct EpiMulSilu {
    bf16_t* X;
    __device__ __forceinline__ void operator()(const f32x4 (&acc)[2][2][4][2], const Unit& u, int wr, int wc, int fr, int fq) const {
        const int b = u.pm >> 4, s0 = (u.pm & 15) * 256 + wr * 64 + fr, hd0 = (u.pn & 7) * 2;
        bf16_t* base = X + wc * 32 + 8 * fq;
        u32x4 pre[2][2];
#define EM_PTR(bt, bj) ((u32x4*)(base + ((size_t)(b * 16 + hd0 + (bj)) * SEQ + s0 + ((bt) >> 2) * HALF + ((bt) & 3) * 16) * HD))
        pre[0][0] = *EM_PTR(0, 0); pre[0][1] = *EM_PTR(0, 1);
#pragma unroll
        for (int bt = 0; bt < 8; ++bt) {
            if (bt + 1 < 8) { pre[(bt + 1) & 1][0] = *EM_PTR(bt + 1, 0); pre[(bt + 1) & 1][1] = *EM_PTR(bt + 1, 1); }
            asm volatile("" ::: "memory");
#pragma unroll
            for (int bj = 0; bj < 2; ++bj) {
                const u32x4 x = pre[bt & 1][bj]; const f32x4 v0 = acc[bt >> 2][bj][bt & 3][0], v1 = acc[bt >> 2][bj][bt & 3][1];
                u32x4 w;
                w.x = cvt_pk_bf16(__uint_as_float(x.x << 16) * silu_f(v0[0]), __uint_as_float(x.x & 0xffff0000u) * silu_f(v0[1]));
                w.y = cvt_pk_bf16(__uint_as_float(x.y << 16) * silu_f(v0[2]), __uint_as_float(x.y & 0xffff0000u) * silu_f(v0[3]));
                w.z = cvt_pk_bf16(__uint_as_float(x.z << 16) * silu_f(v1[0]), __uint_as_float(x.z & 0xffff0000u) * silu_f(v1[1]));
                w.w = cvt_pk_bf16(__uint_as_float(x.w << 16) * silu_f(v1[2]), __uint_as_float(x.w & 0xffff0000u) * silu_f(v1[3]));
                *EM_PTR(bt, bj) = w;
            }
            asm volatile("" ::: "memory");
        }
#undef EM_PTR
    }
};
struct EpiMulSiluWait {
    bf16_t* X; unsigned* prog;
    __device__ __forceinline__ void operator()(const f32x4 (&acc)[2][2][4][2], const Unit& u, int wr, int wc, int fr, int fq) const {
        const int b = u.pm >> 4, s0 = (u.pm & 15) * 256 + wr * 64 + fr, hd0 = (u.pn & 7) * 2;
        { const unsigned need = 4u * (unsigned)(u.pm & 15) + 4u; unsigned* p0 = prog + (b * 16 + hd0) * 16; unsigned* p1 = p0 + 16; unsigned sp = 0;
          while ((__hip_atomic_load(p0, __ATOMIC_RELAXED, __HIP_MEMORY_SCOPE_AGENT) < need || __hip_atomic_load(p1, __ATOMIC_RELAXED, __HIP_MEMORY_SCOPE_AGENT) < need) && ++sp < (1u << 22)) __builtin_amdgcn_s_sleep(8);
          __builtin_amdgcn_fence(__ATOMIC_ACQUIRE, "agent"); asm volatile("s_waitcnt vmcnt(0)" ::: "memory"); }
        bf16_t* base = X + wc * 32 + 8 * fq;
        u32x4 pre[2][2];
#define EM_PTR(bt, bj) ((u32x4*)(base + ((size_t)(b * 16 + hd0 + (bj)) * SEQ + s0 + ((bt) >> 2) * HALF + ((bt) & 3) * 16) * HD))
        pre[0][0] = *EM_PTR(0, 0); pre[0][1] = *EM_PTR(0, 1);
#pragma unroll
        for (int bt = 0; bt < 8; ++bt) {
            if (bt + 1 < 8) { pre[(bt + 1) & 1][0] = *EM_PTR(bt + 1, 0); pre[(bt + 1) & 1][1] = *EM_PTR(bt + 1, 1); }
            asm volatile("" ::: "memory");
#pragma unroll
            for (int bj = 0; bj < 2; ++bj) {
                const u32x4 x = pre[bt & 1][bj]; const f32x4 v0 = acc[bt >> 2][bj][bt & 3][0], v1 = acc[bt >> 2][bj][bt & 3][1];
                u32x4 w;
                w.x = cvt_pk_bf16(__uint_as_float(x.x << 16) * silu_f(v0[0]), __uint_as_float(x.x & 0xffff0000u) * silu_f(v0[1]));
                w.y = cvt_pk_bf16(__uint_as_float(x.y << 16) * silu_f(v0[2]), __uint_as_float(x.y & 0xffff0000u) * silu_f(v0[3]));
                w.z = cvt_pk_bf16(__uint_as_float(x.z << 16) * silu_f(v1[0]), __uint_as_float(x.z & 0xffff0000u) * silu_f(v1[1]));
                w.w = cvt_pk_bf16(__uint_as_float(x.w << 16) * silu_f(v1[2]), __uint_as_float(x.w & 0xffff0000u) * silu_f(v1[3]));
                *EM_PTR(bt, bj) = w;
            }
            asm volatile("" ::: "memory");
        }
#undef EM_PTR
    }
};
struct EpiRes {
    const float* base; float* out; const float* gate;
    __device__ __forceinline__ void operator()(const f32x4 (&acc)[2][2][4][2], const Unit& u, int wr, int wc, int fr, int fq) const {
        const int b = u.pm >> 4, row0 = u.pm * BM + wr * 64 + fr, col0 = u.pn * BM + wc * 32 + 8 * fq;
        f32x4 gv[2][2];
#pragma unroll
        for (int bj = 0; bj < 2; ++bj)
#pragma unroll
            for (int n = 0; n < 2; ++n) gv[bj][n] = *(const f32x4*)(gate + (size_t)b * 3072 + col0 + bj * HALF + 4 * n);
        f32x4 pre[2][2][2][2];
#define ER_OFF(bt, mm) ((size_t)(row0 + ((bt) >> 1) * HALF + (2 * ((bt) & 1) + (mm)) * 16) * DM + col0)
#define ER_LOAD(bt, sl) do { _Pragma("unroll") for (int mm = 0; mm < 2; ++mm) _Pragma("unroll") for (int bj = 0; bj < 2; ++bj) _Pragma("unroll") for (int n = 0; n < 2; ++n) \
            pre[sl][mm][bj][n] = *(const f32x4*)(base + ER_OFF(bt, mm) + bj * HALF + 4 * n); } while (0)
        ER_LOAD(0, 0);
#pragma unroll
        for (int bt = 0; bt < 4; ++bt) {
            if (bt + 1 < 4) { if (bt & 1) ER_LOAD(bt + 1, 0); else ER_LOAD(bt + 1, 1); }
            asm volatile("" ::: "memory");
#pragma unroll
            for (int mm = 0; mm < 2; ++mm)
#pragma unroll
                for (int bj = 0; bj < 2; ++bj)
#pragma unroll
                    for (int n = 0; n < 2; ++n)
                        *(f32x4*)(out + ER_OFF(bt, mm) + bj * HALF + 4 * n) = pre[bt & 1][mm][bj][n] + gv[bj][n] * acc[bt >> 1][bj][2 * (bt & 1) + mm][n];
            asm volatile("" ::: "memory");
        }
#undef ER_OFF
#undef ER_LOAD
    }
};

template <class Epi, class Sched>
__device__ __forceinline__ void gemm_phase(LAS unsigned char* lds, const Gemm g, const Sched& S, const Epi& E, int wv) {
    const int tid = otid(wv), wid = __builtin_amdgcn_readfirstlane(tid >> 6), lane = tid & 63, wr = wid >> 2, wc = wid & 3, fr = lane & 15, fq = lane >> 4;
    const int K = g.K, nt = K / BK;
    unsigned voffA[2], voffB[2];
#pragma unroll
    for (int i = 0; i < 2; ++i) { int R, C; stage_rc(tid * 16 + i * 8192, R, C); const int Rb = (R & ~31) + perm32(R & 31);
        voffA[i] = (unsigned)R * g.lda + (unsigned)C * 2u; voffB[i] = (unsigned)(Rb * K + C) * 2u; }
    const size_t kstep = (size_t)(BK * 2);
    const size_t hstepA = (size_t)HALF * g.lda, hstepB = (size_t)HALF * K * 2, tstepB = 2 * hstepB, hsA = g.hsA;
    const unsigned ldsw = (unsigned)wid * 1024u;
    const int aoff = lds_byte(wr * 64 + fr, fq * 8), boff = lds_byte(wc * 32 + fr, fq * 8);
#define PG8_SA(b, h) (((b) * 2 + (h)) * HTB)
#define PG8_SB(b, h) ((4 + (b) * 2 + (h)) * HTB)
#define PG8_STAGE(bufoff, gbase, voff) do { _Pragma("unroll") for (int _i = 0; _i < 2; ++_i) \
        __builtin_amdgcn_global_load_lds((const unsigned*)((const char*)(gbase) + (voff)[_i]), (LAS unsigned*)(lds + (bufoff) + ldsw + _i * 8192), 16, 0, 0); } while (0)
#define PG8_LDA(dst, b, h) do { _Pragma("unroll") for (int m = 0; m < 4; ++m) _Pragma("unroll") for (int k = 0; k < 2; ++k) dst[m][k] = *(const LAS bf16x8*)(lds + PG8_SA(b, h) + aoff + m * 2048 + k * 1024); } while (0)
#define PG8_LDB(dst, b, h) do { _Pragma("unroll") for (int n = 0; n < 2; ++n) _Pragma("unroll") for (int k = 0; k < 2; ++k) dst[n][k] = *(const LAS bf16x8*)(lds + PG8_SB(b, h) + boff + n * 2048 + k * 1024); } while (0)
#define PG8_MMA(ai, bj, At, Bt) do { __builtin_amdgcn_s_setprio(1); _Pragma("unroll") for (int m = 0; m < 4; ++m) _Pragma("unroll") for (int n = 0; n < 2; ++n) _Pragma("unroll") for (int k = 0; k < 2; ++k) \
        acc[ai][bj][m][n] = __builtin_amdgcn_mfma_f32_16x16x32_bf16(Bt[n][k], At[m][k], acc[ai][bj][m][n], 0, 0, 0); __builtin_amdgcn_s_setprio(0); } while (0)
#define PG8_WAIT_V(n) asm volatile("s_waitcnt vmcnt(" #n ")" ::: "memory")
#define PG8_WAIT_L(n) asm volatile("s_waitcnt lgkmcnt(" #n ")" ::: "memory")
#define PG8_BAR __builtin_amdgcn_s_barrier()
#define PG8_SCHED __builtin_amdgcn_sched_barrier(0)
#define PG8_ATILE(u) ((const char*)g.A + (size_t)((u).pm >> 4) * g.bsA + (size_t)((u).pm & 15) * 256 * g.lda)
    Unit cur, nxt; int ui = 0;
    if (!S.next(0, cur)) return;
    f32x4 acc[2][2][4][2];
#pragma unroll
    for (int a = 0; a < 2; ++a)
#pragma unroll
        for (int b = 0; b < 2; ++b)
#pragma unroll
            for (int m = 0; m < 4; ++m)
#pragma unroll
                for (int n = 0; n < 2; ++n) acc[a][b][m][n] = (f32x4){0.f, 0.f, 0.f, 0.f};
    bf16x8 At[4][2], B0[2][2], B1[2][2];
    const char* cA = PG8_ATILE(cur); const char* cB = (const char*)g.Bt + (size_t)cur.pn * tstepB;
    PG8_STAGE(PG8_SB(0, 0), cB, voffB); PG8_STAGE(PG8_SB(0, 1), cB + hstepB, voffB); PG8_STAGE(PG8_SA(0, 0), cA, voffA); PG8_STAGE(PG8_SA(0, 1), cA + hstepA, voffA);
    if (wr == 1) PG8_BAR;
    PG8_WAIT_V(2); PG8_BAR;
    PG8_STAGE(PG8_SB(1, 0), cB + kstep, voffB); PG8_STAGE(PG8_SA(1, 0), cA + kstep, voffA); PG8_STAGE(PG8_SB(1, 1), cB + hstepB + kstep, voffB);
    PG8_WAIT_V(6); PG8_BAR;
    for (;;) {
        const bool has_next = S.next(ui + 1, nxt);
        const char* nA = has_next ? PG8_ATILE(nxt) : cA; const char* nB = has_next ? (const char*)g.Bt + (size_t)nxt.pn * tstepB : cB;
        for (int t = 0; t < nt; t += 2) {
            const bool last = (t == nt - 2);
            const char* a1 = cA + (size_t)(t >> 1) * hsA + kstep;
            const char* a2 = last ? nA : cA + (size_t)((t >> 1) + 1) * hsA; const char* b2 = last ? nB : cB + (size_t)(t + 2) * kstep;
            const char* a3 = a2 + kstep; const char* b3 = b2 + kstep;
            PG8_LDB(B0, 0, 0); PG8_LDB(B1, 0, 1); PG8_SCHED; PG8_LDA(At, 0, 0); PG8_STAGE(PG8_SA(1, 1), a1 + hstepA, voffA);
            PG8_WAIT_V(8); PG8_WAIT_L(0); PG8_BAR; PG8_MMA(0, 0, At, B0); PG8_MMA(0, 1, At, B1); PG8_BAR; PG8_SCHED;
            PG8_LDA(At, 0, 1); PG8_STAGE(PG8_SB(0, 0), b2, voffB); PG8_STAGE(PG8_SB(0, 1), b2 + hstepB, voffB); PG8_STAGE(PG8_SA(0, 0), a2, voffA);
            PG8_WAIT_V(8); PG8_WAIT_L(0); PG8_BAR; PG8_MMA(1, 0, At, B0); PG8_MMA(1, 1, At, B1); PG8_BAR; PG8_SCHED;
            PG8_LDB(B0, 1, 0); PG8_LDB(B1, 1, 1); PG8_SCHED; PG8_LDA(At, 1, 0); PG8_STAGE(PG8_SA(0, 1), a2 + hstepA, voffA);
            PG8_WAIT_V(8); PG8_WAIT_L(0); PG8_BAR; PG8_MMA(0, 0, At, B0); PG8_MMA(0, 1, At, B1); PG8_BAR; PG8_SCHED;
            PG8_LDA(At, 1, 1); PG8_STAGE(PG8_SB(1, 0), b3, voffB); PG8_STAGE(PG8_SB(1, 1), b3 + hstepB, voffB); PG8_STAGE(PG8_SA(1, 0), a3, voffA);
            PG8_WAIT_V(8); PG8_WAIT_L(0); PG8_BAR; PG8_MMA(1, 0, At, B0); PG8_MMA(1, 1, At, B1); PG8_BAR; PG8_SCHED;
        }
        if (wr == 0) PG8_BAR;
        E(acc, cur, wr, wc, fr, fq);
        if (!has_next) break;
#pragma unroll
        for (int a = 0; a < 2; ++a)
#pragma unroll
            for (int b = 0; b < 2; ++b)
#pragma unroll
                for (int m = 0; m < 4; ++m)
#pragma unroll
                    for (int n = 0; n < 2; ++n) acc[a][b][m][n] = (f32x4){0.f, 0.f, 0.f, 0.f};
        cur = nxt; cA = nA; cB = nB; ++ui;
        if (wr == 1) PG8_BAR;
    }
    PG8_WAIT_V(0);
    PG8_BAR;
#undef PG8_SA
#undef PG8_SB
#undef PG8_STAGE
#undef PG8_LDA
#undef PG8_LDB
#undef PG8_MMA
#undef PG8_WAIT_V
#undef PG8_WAIT_L
#undef PG8_BAR
#undef PG8_SCHED
#undef PG8_ATILE
}
}

namespace att {
constexpr int D = 128, NW = 8, QBLK = 32, KVBLK = 64, QB = NW * QBLK;
constexpr int SHM_V = KVBLK * D * 2, SHM_K = KVBLK * D * 2;
constexpr int OFF_WS = 2 * SHM_V + 2 * SHM_K, OFF_G = OFF_WS + NW * 64 * 4, ATT_LDS = OFF_G + 512;
constexpr float SCALE = 0.08838834764831845f, C2 = 1.4426950408889634f * SCALE, THR2 = 24.f;
#define KSWZ(row, colB) ((row) * 256 + ((colB) ^ (((row) & 7) << 4)))
#define SBAR() __builtin_amdgcn_sched_barrier(0)
__device__ __forceinline__ int v_st(int k, int c) { const int kk = (k & ~0xC) | ((k & 4) << 1) | ((k & 8) >> 1); return ((kk >> 3) * 4 + (c >> 5)) * 512 + ((kk & 7) * 32 + (c & 31)) * 2; }
__device__ __forceinline__ int v_rd_base(int lane) { return ((lane & 3) << 3) | (((lane >> 2) & 3) << 6) | (((lane >> 4) & 1) << 5) | (((lane >> 5) & 1) << 8); }
constexpr int v_rd_off(int d0, int ks, int half) { return d0 * 512 + ks * 4096 + half * 2048; }
__device__ __forceinline__ int crow(int r, int hi) { return (r & 3) + 8 * (r >> 2) + 4 * hi; }
__device__ __forceinline__ bf16x8 load8(const bf16_t* p) { return *reinterpret_cast<const bf16x8*>(p); }
__device__ __forceinline__ void mask_tile(f32x16& p0, f32x16& p1, int dq, unsigned W) {
    const float NEG = -__builtin_inff();
#pragma unroll
    for (int r = 0; r < 16; ++r) {
        const int c = (r & 3) + 8 * (r >> 2);
        if ((unsigned)(dq - c) >= W) p0[r] = NEG;
        if ((unsigned)(dq - c - 32) >= W) p1[r] = NEG;
    }
}
__device__ __forceinline__ void partialSM(f32x16& p0, f32x16& p1, float& m_reg, float& mn, float& alpha) {
    float pmax = p0[0];
#pragma unroll
    for (int r = 1; r < 16; ++r) pmax = fmaxf(pmax, p0[r]);
#pragma unroll
    for (int r = 0; r < 16; ++r) pmax = fmaxf(pmax, p1[r]);
    { auto rr = __builtin_amdgcn_permlane32_swap(__float_as_uint(pmax), __float_as_uint(pmax), false, false);
      pmax = fmaxf(__uint_as_float(rr[0]), __uint_as_float(rr[1])); }
    if (__builtin_expect(__all((pmax - m_reg) * C2 <= THR2), 1)) { mn = m_reg; alpha = 1.f; }
    else { mn = fmaxf(m_reg, pmax); alpha = __builtin_amdgcn_exp2f((m_reg - mn) * C2); m_reg = mn; }
    const float mnL = -mn * C2;
#pragma unroll
    for (int r = 0; r < 16; ++r) { p0[r] = fmaf(p0[r], C2, mnL); p1[r] = fmaf(p1[r], C2, mnL); }
#pragma unroll
    for (int r = 0; r < 16; ++r) p0[r] = __builtin_amdgcn_exp2f(p0[r]);
}
__device__ __forceinline__ void finishSM(f32x16& p0, f32x16& p1, float alpha, float& l_reg, bf16x8& pa0, bf16x8& pa1, bf16x8& pa2, bf16x8& pa3) {
#pragma unroll
    for (int r = 0; r < 16; ++r) p1[r] = __builtin_amdgcn_exp2f(p1[r]);
    float ps = 0;
#pragma unroll
    for (int r = 0; r < 16; ++r) ps += p0[r];
#pragma unroll
    for (int r = 0; r < 16; ++r) ps += p1[r];
    { auto rr = __builtin_amdgcn_permlane32_swap(__float_as_uint(ps), __float_as_uint(ps), false, false);
      ps = __uint_as_float(rr[0]) + __uint_as_float(rr[1]); }
    l_reg = l_reg * alpha + ps;
#define PK4(P, B_, OUT) do { unsigned a0 = cvt_pk_bf16(P[B_+0], P[B_+1]), a1 = cvt_pk_bf16(P[B_+2], P[B_+3]);                          \
        unsigned b0 = cvt_pk_bf16(P[B_+4], P[B_+5]), b1 = cvt_pk_bf16(P[B_+6], P[B_+7]);                                             \
        auto r0 = __builtin_amdgcn_permlane32_swap(a0, b0, false, false); auto r1 = __builtin_amdgcn_permlane32_swap(a1, b1, false, false); \
        u32x4 w = {r0[0], r1[0], r0[1], r1[1]}; OUT = *reinterpret_cast<bf16x8*>(&w); } while (0)
    PK4(p0, 0, pa0); PK4(p0, 8, pa1); PK4(p1, 0, pa2); PK4(p1, 8, pa3);
#undef PK4
}
template <int KB>
__device__ __forceinline__ void qkt(f32x16& p0, f32x16& p1, const char* K_lds, int r32, int hi, const bf16x8* qr, const float* gl) {
#pragma unroll
    for (int i = 0; i < 4; ++i) { const f32x4 g0 = *(const f32x4*)(gl + 8 * i + 4 * hi), g1 = *(const f32x4*)(gl + 32 + 8 * i + 4 * hi);
#pragma unroll
        for (int j = 0; j < 4; ++j) { p0[4 * i + j] = g0[j]; p1[4 * i + j] = g1[j]; } }
    const char* kb[4];
#pragma unroll
    for (int dd = 0; dd < 4; ++dd) kb[dd] = K_lds + KB * SHM_K + KSWZ(r32, (dd * 16 + hi * 8) * 2);
#pragma unroll
    for (int d0 = 0; d0 < 8; ++d0) { const char* a = kb[d0 & 3] + (d0 >> 2) * 128;
        bf16x8 b0 = *reinterpret_cast<const bf16x8*>(a);
        bf16x8 b1 = *reinterpret_cast<const bf16x8*>(a + 32 * 256);
        p0 = __builtin_amdgcn_mfma_f32_32x32x16_bf16(b0, qr[d0], p0, 0, 0, 0);
        p1 = __builtin_amdgcn_mfma_f32_32x32x16_bf16(b1, qr[d0], p1, 0, 0, 0); }
}
template <int VB>
__device__ __forceinline__ void pv_tile(f32x16* o, int vb0, bf16x8 pa0, bf16x8 pa1, bf16x8 pa2, bf16x8 pa3) {
#define TRRD(dst, off) asm volatile("ds_read_b64_tr_b16 %0, %1 offset:%2" : "=&v"(dst) : "v"(vb0), "i"(off) : "memory")
#define PV_D0(d0) do { s16x4 l0, l1, l2, l3, h0, h1, h2, h3; constexpr int b_ = VB * SHM_V + v_rd_off(d0, 0, 0); \
        TRRD(l0, b_); TRRD(h0, b_ + 2048); TRRD(l1, b_ + 4096); TRRD(h1, b_ + 6144); TRRD(l2, b_ + 8192); TRRD(h2, b_ + 10240); TRRD(l3, b_ + 12288); TRRD(h3, b_ + 14336); \
        asm volatile("s_waitcnt lgkmcnt(0)" ::: "memory"); SBAR();   \
        o[d0] = __builtin_amdgcn_mfma_f32_32x32x16_bf16(pa0, (bf16x8){l0[0], l0[1], l0[2], l0[3], h0[0], h0[1], h0[2], h0[3]}, o[d0], 0, 0, 0);   \
        o[d0] = __builtin_amdgcn_mfma_f32_32x32x16_bf16(pa1, (bf16x8){l1[0], l1[1], l1[2], l1[3], h1[0], h1[1], h1[2], h1[3]}, o[d0], 0, 0, 0);   \
        o[d0] = __builtin_amdgcn_mfma_f32_32x32x16_bf16(pa2, (bf16x8){l2[0], l2[1], l2[2], l2[3], h2[0], h2[1], h2[2], h2[3]}, o[d0], 0, 0, 0);   \
        o[d0] = __builtin_amdgcn_mfma_f32_32x32x16_bf16(pa3, (bf16x8){l3[0], l3[1], l3[2], l3[3], h3[0], h3[1], h3[2], h3[3]}, o[d0], 0, 0, 0); } while (0)
    PV_D0(0); PV_D0(1); PV_D0(2); PV_D0(3);
#undef PV_D0
#undef TRRD
}
struct BlockRef { const bf16_t* Q; const bf16_t* K; const bf16_t* V; const float* G; bf16_t* O; int P0, jlo; };
struct Seam { bf16x8 qr[8]; bf16x8 st_v0, st_v1, st_k0, st_k1; float sg; };
#define ROW(p, k0, rr) ((p) + (size_t)((k0) + (rr)) * D + sc)
#define VMW() asm volatile("s_waitcnt vmcnt(0)" ::: "memory")
#define VMWN(n) asm volatile("s_waitcnt vmcnt(%0)" :: "i"(n) : "memory")
#define SLOAD_H(Kp, Vp, Gp, k0) do { S.st_v0 = load8(ROW(Vp, k0, sr)); S.st_v1 = load8(ROW(Vp, k0, 32 + sr));              \
                         S.st_k0 = load8(ROW(Kp, k0, sr)); S.st_k1 = load8(ROW(Kp, k0, 32 + sr)); S.sg = (Gp)[(k0) + (tid & 63)]; } while (0)
#define SWRITE_HK(bf) do { *(bf16x8*)(K_lds + (bf) * SHM_K + kws) = S.st_k0; *(bf16x8*)(K_lds + (bf) * SHM_K + kws + 32 * 256) = S.st_k1; \
                           if (tid < 64) G_lds[(bf) * 64 + tid] = S.sg; } while (0)
#define SWRITE_HV(bf) do { *(bf16x8*)(V_lds + (bf) * SHM_V + vst0) = S.st_v0; *(bf16x8*)(V_lds + (bf) * SHM_V + vst1) = S.st_v1; } while (0)
#define SWRITE_H(bf) do { SWRITE_HV(bf); SWRITE_HK(bf); } while (0)
__device__ __forceinline__ void prime(const BlockRef& cur, char* lds, Seam& S, int wv) {
    const int tid = otid(wv), wid = __builtin_amdgcn_readfirstlane(tid >> 6), lane = tid & 63, r32 = lane & 31, hi = lane >> 5;
    const int sr = tid >> 4, sc = (tid & 15) * 8, kws = KSWZ(sr, sc * 2); char* K_lds = lds + 2 * SHM_V; float* G_lds = (float*)(lds + OFF_G);
#pragma unroll
    for (int d0 = 0; d0 < 8; ++d0) S.qr[d0] = load8(cur.Q + (size_t)(wid * QBLK + r32) * D + d0 * 16 + hi * 8);
    SLOAD_H(cur.K, cur.V, cur.G, cur.jlo * KVBLK); VMW(); SWRITE_HK(0);
    __syncthreads();
}
__device__ __forceinline__ void block(const BlockRef& cur, const BlockRef& nxt, char* lds, Seam& S, int wv) {
    const int tid = otid(wv), wid = __builtin_amdgcn_readfirstlane(tid >> 6), lane = tid & 63, r32 = lane & 31, hi = lane >> 5;
    const int W = SEQ;
    const int j_hi = (cur.P0 + QB - 1) / KVBLK + 1;
    const int j_lo = cur.jlo, NT = j_hi - j_lo, kbn = nxt.jlo * KVBLK;
    const int qlo = cur.P0 + wid * QBLK, qm = qlo + r32 - 4 * hi;
    char* V_lds = lds; char* K_lds = lds + 2 * SHM_V; float* G_lds = (float*)(lds + OFF_G);
    float* ws = (float*)(lds + OFF_WS) + wid * 64; float* li_l = ws, * al_l = ws + 32;
    float m_reg = -1e30f, l_reg = 0; f32x16 o[4] = {};
    const int sr = tid >> 4, sc = (tid & 15) * 8, vst0 = v_st(sr, sc), vst1 = v_st(32 + sr, sc), kws = KSWZ(sr, sc * 2);
    const int vb0 = (int)(uintptr_t)V_lds + v_rd_base(lane);
    const bf16_t* Kh = cur.K; const bf16_t* Vh = cur.V; const float* Gh = cur.G;
#define RESC(a) do { if (__any((a) < 1.f)) { if (hi == 0) al_l[r32] = (a); asm volatile("s_waitcnt lgkmcnt(0)" ::: "memory");              \
                     _Pragma("unroll") for (int d_ = 0; d_ < 4; ++d_) _Pragma("unroll") for (int r = 0; r < 16; ++r) o[d_][r] *= al_l[crow(r, hi)]; } } while (0)
#define KBASE(t) ((j_lo + (t)) * KVBLK)
#define MASKT(P0_, P1_, t) do { const int kb_ = KBASE(t); if (kb_ + KVBLK - 1 > qlo) mask_tile(P0_, P1_, qm - kb_, (unsigned)W); } while (0)
    constexpr int NQL = 8;
#define SEAM_K0() do { VMWN(NQL); SWRITE_HK(0); SBAR(); } while (0)
    f32x16 pA0, pA1, pB0, pB1; float mnA, mnB, alA, alB; bf16x8 pa0, pa1, pa2, pa3;
    SWRITE_HV(0); SBAR();
    if (NT > 1) SLOAD_H(Kh, Vh, Gh, KBASE(1));
    SBAR(); qkt<0>(pA0, pA1, K_lds, r32, hi, S.qr, G_lds);
    MASKT(pA0, pA1, 0); partialSM(pA0, pA1, m_reg, mnA, alA);
    if (NT > 1) { VMW(); SWRITE_H(1); }
    __syncthreads();
#define HALF_STEP(PX0, PX1, mnX, alX, PY0, PY1, alY, t, KB, VB, SB) do {                                                      \
        SBAR(); qkt<KB>(PX0, PX1, K_lds, r32, hi, S.qr, G_lds + (KB) * 64);                                             \
        finishSM(PY0, PY1, alY, l_reg, pa0, pa1, pa2, pa3); SBAR();                                                           \
        if ((t) + 1 < NT) { SLOAD_H(Kh, Vh, Gh, KBASE((t) + 1)); SBAR(); }                                               \
        pv_tile<VB>(o, vb0, pa0, pa1, pa2, pa3); MASKT(PX0, PX1, (t)); partialSM(PX0, PX1, m_reg, mnX, alX);                                        \
        __syncthreads();                                                                                                      \
        if ((t) + 1 < NT) { VMW(); SWRITE_H(SB); }                                                                          \
        RESC(alX); __syncthreads(); } while (0)
    for (int t = 1; t + 1 < NT; t += 2) {
        HALF_STEP(pB0, pB1, mnB, alB, pA0, pA1, alA, t, 1, 0, 0);
        HALF_STEP(pA0, pA1, mnA, alA, pB0, pB1, alB, t + 1, 0, 1, 1);
    }
    const bool even = (NT & 1) == 0;
    if (even) { SBAR(); qkt<1>(pB0, pB1, K_lds, r32, hi, S.qr, G_lds + 64); SBAR(); }
    SLOAD_H(nxt.K, nxt.V, nxt.G, kbn); SBAR();
#pragma unroll
    for (int d0 = 0; d0 < 8; ++d0) S.qr[d0] = load8(nxt.Q + (size_t)(wid * QBLK + r32) * D + d0 * 16 + hi * 8);
    SBAR();
    finishSM(pA0, pA1, alA, l_reg, pa0, pa1, pa2, pa3); SBAR();
    pv_tile<0>(o, vb0, pa0, pa1, pa2, pa3);
    if (even) { MASKT(pB0, pB1, NT - 1); partialSM(pB0, pB1, m_reg, mnB, alB); __syncthreads(); RESC(alB);
        finishSM(pB0, pB1, alB, l_reg, pa0, pa1, pa2, pa3); SBAR(); pv_tile<1>(o, vb0, pa0, pa1, pa2, pa3); }
    SBAR(); SEAM_K0();
    if (hi == 0) li_l[r32] = l_reg; asm volatile("s_waitcnt lgkmcnt(0)" ::: "memory");
    float rli[16];
#pragma unroll
    for (int r = 0; r < 16; ++r) rli[r] = __builtin_amdgcn_rcpf(li_l[crow(r, hi)]);
    bf16_t* Ow = cur.O + (size_t)(wid * QBLK) * D;
#pragma unroll
    for (int r = 0; r < 16; ++r) { const int orow = crow(r, hi);
#pragma unroll
        for (int d0 = 0; d0 < 4; ++d0) { const float v = o[d0][r] * rli[r];
            const float vn = __shfl_xor(v, 1);
            if ((r32 & 1) == 0) *(unsigned*)(Ow + (size_t)orow * D + d0 * 32 + r32) = cvt_pk_bf16(v, vn); } }
    __syncthreads();
#undef RESC
#undef KBASE
#undef MASKT
#undef SEAM_K0
#undef HALF_STEP
}
#undef ROW
#undef VMW
#undef VMWN
#undef SLOAD_H
#undef SWRITE_HK
#undef SWRITE_HV
#undef SWRITE_H
struct Item { int bh, qb0, qb1; };
__device__ __forceinline__ Item decode(int L) {
    const int c = L & 255, i = L >> 8, xcd = c & 7, cc = c >> 3, gi = (cc & 1) + 2 * i, qb = ((cc >> 1) + 2 * i + (i >> 2)) & 15;
    Item it; it.bh = ((xcd - gi) & 7) * 16 + gi; it.qb0 = qb; it.qb1 = qb; return it;
}
__device__ __forceinline__ BlockRef mkref(const Item& it, int pass, const bf16_t* Q, const bf16_t* K, const bf16_t* V, const float* G, const int* JLO, bf16_t* O, bf16_t* Odummy, bool dummy) {
    const int qb = pass ? it.qb1 : it.qb0; BlockRef r;
    r.Q = Q + ((size_t)it.bh * SEQ + (size_t)qb * QB) * D; r.O = dummy ? Odummy : O + ((size_t)it.bh * SEQ + (size_t)qb * QB) * D;
    r.K = K + (size_t)it.bh * SEQ * D; r.V = V + (size_t)it.bh * SEQ * D; r.G = G + (size_t)it.bh * SEQ; r.P0 = qb * QB; r.jlo = JLO[it.bh * 16 + qb]; return r;
}
__device__ __forceinline__ void phase(char* lds, const bf16_t* Q, const bf16_t* K, const bf16_t* V, const float* G, const int* JLO, bf16_t* O, bf16_t* Odummy, int total, int wv) {
    const int stride = gridDim.x;
    int L = blockIdx.x; if (L >= total) return;
    Item it = decode(L); int pass = 0;
    BlockRef cur = mkref(it, 0, Q, K, V, G, JLO, O, Odummy, false);
    Seam S;
    prime(cur, lds, S, wv);
    for (;;) {
        const bool more_pass = pass == 0 && it.qb1 != it.qb0, more_item = L + stride < total, last = !more_pass && !more_item;
        Item itn = it; int passn = pass + 1, Ln = L;
        if (!more_pass) { passn = 0; Ln = more_item ? L + stride : L; itn = decode(Ln); }
        const BlockRef nxt = last ? cur : mkref(itn, passn, Q, K, V, G, JLO, O, Odummy, false);
        block(cur, nxt, lds, S, wv);
        if (last) break;
        cur = nxt; it = itn; pass = passn; L = Ln;
    }
}
#undef SBAR
}

struct Args {
    const float *x, *c, *mod_w, *mod_b, *norm_g, *a_w_in, *a_lb, *a_onorm_g, *a_w_out, *kv_mod_w, *kv_mod_b, *kv_norm_g, *kv_w, *kv_fb, *k_norm_g, *b_w_in, *b_q_norm_g, *b_w_out;
    float* out; unsigned char* ws; int one, pad;
};

__device__ __forceinline__ void transpose_item(const float* W, int K, int ldw, int N, bf16_t* WT, float* scr, int item, int lane) {
    const int nblk = N / 32, kb = item / nblk, nb = item % nblk, k0 = 64 * kb, n0 = 32 * nb;
#pragma unroll 8
    for (int i = 0; i < 32; ++i) { const int kk = 2 * i + (lane >> 5); scr[kk * 33 + (lane & 31)] = W[(size_t)(k0 + kk) * ldw + n0 + (lane & 31)]; }
    asm volatile("s_waitcnt lgkmcnt(0)" ::: "memory");
    const int c = lane & 7;
#pragma unroll
    for (int j = 0; j < 4; ++j) { const int n = (lane >> 3) + 8 * j; const float* s = scr + (8 * c) * 33 + n;
        u32x4 o; o.x = cvt_pk_bf16(s[0 * 33], s[1 * 33]); o.y = cvt_pk_bf16(s[2 * 33], s[3 * 33]); o.z = cvt_pk_bf16(s[4 * 33], s[5 * 33]); o.w = cvt_pk_bf16(s[6 * 33], s[7 * 33]);
        *(u32x4*)(WT + (size_t)(n0 + n) * K + k0 + 8 * c) = o; }
    asm volatile("s_waitcnt lgkmcnt(0)" ::: "memory");
}

__device__ __forceinline__ void p0_prologue(const Args& a, char* lds, int wv) {
    const int tid = otid(wv), lane = tid & 63, wave = tid >> 6, G = gridDim.x;
    unsigned char* ws = a.ws;
    float* sc = (float*)lds;
    float* red = (float*)(lds + 32768);
    for (int i = tid; i < NB * DM; i += 512) sc[i] = silu_f(a.c[i]);
    __syncthreads();
    for (int cgp = blockIdx.x; cgp < 256; cgp += G) {
        const int n0 = cgp * 32; const float* Wm; const float* bias; float* outp; int ldn, nloc;
        if (n0 < 3072) { Wm = a.mod_w; bias = a.mod_b; outp = (float*)(ws + WS_MOD0); ldn = 3072; nloc = n0; }
        else if (n0 < 6144) { Wm = a.mod_w + (size_t)DM * 3072; bias = a.mod_b + 3072; outp = (float*)(ws + WS_MOD1); ldn = 3072; nloc = n0 - 3072; }
        else { Wm = a.kv_mod_w; bias = a.kv_mod_b; outp = (float*)(ws + WS_KVMOD); ldn = 2048; nloc = n0 - 6144; }
        const int col = lane & 31, ksub = wave * 2 + (lane >> 5);
        float accb[8];
#pragma unroll
        for (int b = 0; b < 8; ++b) accb[b] = 0.f;
#pragma unroll 8
        for (int kk = 0; kk < 64; ++kk) { const int k = ksub * 64 + kk; const float w = Wm[(size_t)k * ldn + nloc + col];
#pragma unroll
            for (int b = 0; b < 8; ++b) accb[b] = fmaf(sc[b * DM + k], w, accb[b]); }
#pragma unroll
        for (int b = 0; b < 8; ++b) red[(ksub * 8 + b) * 32 + col] = accb[b];
        __syncthreads();
        if (tid < 256) { const int b = tid >> 5, cc = tid & 31; float s = bias[nloc + cc];
#pragma unroll
            for (int j = 0; j < 16; ++j) s += red[(j * 8 + b) * 32 + cc];
            outp[(size_t)b * ldn + nloc + cc] = s; }
        __syncthreads();
    }
    const int gtid = blockIdx.x * 512 + tid, NT = G * 512;
    for (int j = gtid; j < WD; j += NT) ((float*)(ws + WS_LB))[j] = 1.f / (1.f + __expf(a.a_lb[WD + j] - a.a_lb[j]));
    for (int i = gtid; i < NH * DM; i += NT) { const int h = i >> 10, k = i & 1023; ((float*)(ws + WS_WFL))[i] = a.kv_w[(size_t)k * 4112 + 4096 + h]; }
    __syncthreads();
    float* scr = (float*)(lds + wave * 16384);
    const int gw = blockIdx.x * 8 + wave, NGW = G * 8;
    constexpr int I1 = 16 * 256, I2 = 32 * 32, I3 = 16 * 128, I4 = 16 * 128, I5 = 32 * 32, NIT = I1 + I2 + I3 + I4 + I5;
    for (int it = gw; it < NIT; it += NGW) {
        int r = it;
        if (r < I1) { transpose_item(a.a_w_in, 1024, 8192, 8192, (bf16_t*)(ws + WS_W1), scr, r, lane); continue; } r -= I1;
        if (r < I2) { transpose_item(a.a_w_out, 2048, 1024, 1024, (bf16_t*)(ws + WS_W2), scr, r, lane); continue; } r -= I2;
        if (r < I3) { transpose_item(a.kv_w, 1024, 4112, 4096, (bf16_t*)(ws + WS_W3KV), scr, r, lane); continue; } r -= I3;
        if (r < I4) { transpose_item(a.b_w_in, 1024, 4096, 4096, (bf16_t*)(ws + WS_W3Q), scr, r, lane); continue; } r -= I4;
        transpose_item(a.b_w_out, 2048, 1024, 1024, (bf16_t*)(ws + WS_W4), scr, r, lane);
    }
}

template <bool FL, bool DUAL>
__device__ __forceinline__ void norm_phase(const float* x, const float* g, const float* shiftp, const float* scalep, int mstride, bf16_t* outp,
                                           const float* g2, const float* shiftp2, const float* scalep2, int mstride2, bf16_t* outp2,
                                           const float* wfl_g, const float* fb, float* LS, char* lds, int wv) {
    const int tid = otid(wv), lane = tid & 63, wave = tid >> 6;
    float* wfl = (float*)lds;
    if (FL) { for (int i = tid; i < NH * DM / 4; i += 512) ((f32x4*)wfl)[i] = ((const f32x4*)wfl_g)[i]; __syncthreads(); }
    const int gw = blockIdx.x * 8 + wave, NGW = gridDim.x * 8, rpw = (((TOK + NGW - 1) / NGW) + 3) & ~3;
    int curb = -1; f32x4 al[4], be[4], al2[4], be2[4];
    for (int i0 = 0; i0 < rpw; i0 += 4) {
        const int m0 = gw * rpw + i0; if (m0 >= TOK) break;
        const int b = m0 >> 12;
        if (b != curb) { curb = b;
#pragma unroll
            for (int j = 0; j < 4; ++j) { const int col = 4 * lane + 256 * j; const f32x4 gg = *(const f32x4*)(g + col), sc = *(const f32x4*)(scalep + (size_t)b * mstride + col);
                al[j] = gg * (sc + 1.f); be[j] = *(const f32x4*)(shiftp + (size_t)b * mstride + col);
                if (DUAL) { const f32x4 gg2 = *(const f32x4*)(g2 + col), sc2 = *(const f32x4*)(scalep2 + (size_t)b * mstride2 + col);
                    al2[j] = gg2 * (sc2 + 1.f); be2[j] = *(const f32x4*)(shiftp2 + (size_t)b * mstride2 + col); } } }
        f32x4 v[4][4];
#pragma unroll
        for (int q = 0; q < 4; ++q) { const f32x4* xr = (const f32x4*)(x + (size_t)(m0 + q) * DM) + lane;
#pragma unroll
            for (int j = 0; j < 4; ++j) v[q][j] = xr[64 * j]; }
#pragma unroll
        for (int q = 0; q < 4; ++q) { float s2 = 0.f;
#pragma unroll
            for (int j = 0; j < 4; ++j) s2 += (v[q][j].x * v[q][j].x + v[q][j].y * v[q][j].y) + (v[q][j].z * v[q][j].z + v[q][j].w * v[q][j].w);
            const float rstd = __builtin_amdgcn_rsqf(wave_sum(s2) * (1.f / DM) + EPS);
            unsigned long long* o8 = (unsigned long long*)(outp + (size_t)(m0 + q) * DM) + lane;
            unsigned long long* o82 = (unsigned long long*)(outp2 + (size_t)(m0 + q) * DM) + lane;
#pragma unroll
            for (int j = 0; j < 4; ++j) { const f32x4 xh = v[q][j] * rstd;
                if (DUAL) { const f32x4 w2 = xh * al2[j] + be2[j];
                    o82[64 * j] = (unsigned long long)cvt_pk_bf16(w2.x, w2.y) | ((unsigned long long)cvt_pk_bf16(w2.z, w2.w) << 32); }
                v[q][j] = xh * al[j] + be[j];
                o8[64 * j] = (unsigned long long)cvt_pk_bf16(v[q][j].x, v[q][j].y) | ((unsigned long long)cvt_pk_bf16(v[q][j].z, v[q][j].w) << 32); } }
        if (FL) {
            float mine[4] = {0.f, 0.f, 0.f, 0.f};
#pragma unroll 2
            for (int h = 0; h < NH; ++h) { f32x4 w[4];
#pragma unroll
                for (int j = 0; j < 4; ++j) w[j] = *(const f32x4*)(wfl + h * DM + 4 * lane + 256 * j);
#pragma unroll
                for (int q = 0; q < 4; ++q) { float p = 0.f;
#pragma unroll
                    for (int j = 0; j < 4; ++j) p += (v[q][j].x * w[j].x + v[q][j].y * w[j].y) + (v[q][j].z * w[j].z + v[q][j].w * w[j].w);
                    p = wave_sum(p); if (lane == h) mine[q] = p; } }
            if (lane < NH) { const float fbv = fb[lane];
#pragma unroll
                for (int q = 0; q < 4; ++q) { const float z = mine[q] + fbv; const float ls = z < 0.f ? z - log1pf(__expf(z)) : -log1pf(__expf(-z));
                    LS[(size_t)(b * NH + lane) * SEQ + ((m0 + q) & (SEQ - 1))] = ls; } }
        }
    }
}

__device__ __forceinline__ void cumsum_phase(float* LS, int* JLO, const float* kg, const float* qg, char* lds, int wv) {
    const int tid = otid(wv), lane = tid & 63, wave = tid >> 6; float* wtot = (float*)lds; float* gl = (float*)(lds + 1024);
    float mk = fmaxf(fabsf(kg[lane]), fabsf(kg[lane + 64])), mq = fmaxf(fabsf(qg[lane]), fabsf(qg[lane + 64]));
#pragma unroll
    for (int o = 1; o < 64; o <<= 1) { mk = fmaxf(mk, __shfl_xor(mk, o)); mq = fmaxf(mq, __shfl_xor(mq, o)); }
    const float TH = (40.f + 2.f * (1.05f * 128.f * 1.4426950408889634f * 0.08838834764831845f * mk * mq)) / (1.4426950408889634f * 0.08838834764831845f);
    for (int bh = blockIdx.x; bh < BH; bh += gridDim.x) {
        float* p = LS + (size_t)bh * SEQ + tid * 8; f32x4 a = *(f32x4*)p, b = *(f32x4*)(p + 4);
        float v[8] = {a.x, a.y, a.z, a.w, b.x, b.y, b.z, b.w};
#pragma unroll
        for (int i = 1; i < 8; ++i) v[i] += v[i - 1];
        float run = v[7];
#pragma unroll
        for (int o = 1; o < 64; o <<= 1) { const float t = __shfl_up(run, o); if (lane >= o) run += t; }
        if (lane == 63) wtot[wave] = run;
        __syncthreads();
        float off = run - v[7];
        for (int w = 0; w < wave; ++w) off += wtot[w];
        const float k = -11.313708498984761f;
        a = (f32x4){(v[0] + off) * k, (v[1] + off) * k, (v[2] + off) * k, (v[3] + off) * k}; b = (f32x4){(v[4] + off) * k, (v[5] + off) * k, (v[6] + off) * k, (v[7] + off) * k};
        *(f32x4*)p = a; *(f32x4*)(p + 4) = b;
        *(f32x4*)(gl + tid * 8) = a; *(f32x4*)(gl + tid * 8 + 4) = b;
        __syncthreads();
#pragma unroll
        for (int rep = 0; rep < 2; ++rep) { const int qb = wave + 8 * rep, P0 = qb * 256;
            const bool skip = (64 * lane + 63 < P0) && (gl[P0] - gl[64 * lane + 63] > TH);
            const unsigned long long mask = __ballot(skip);
            if (lane == 0) JLO[bh * 16 + qb] = __popcll(mask); }
        __syncthreads();
    }
}

__device__ __forceinline__ void p4_scan(const Args& a, char* lds, int dry, int wv, unsigned* prog) {
    const int tid = otid(wv), lane = tid & 63, w = tid >> 6, r = lane & 15, gq = lane >> 4, vg = w & 3, kh = w >> 2;
    unsigned char* ws = a.ws;
    bf16_t* R0 = (bf16_t*)(ws + WS_R0); const bf16_t* R1 = (const bf16_t*)(ws + WS_R1); const bf16_t* R2 = (const bf16_t*)(ws + WS_R2);
    const float* LB = (const float*)(ws + WS_LB);
    constexpr int BUF = 45568, O_QD = 0, O_KT = 17408, O_AT = 35840, O_DL = 45056, O_XS = 2 * BUF, O_PART = O_XS + 32768, O_V = O_PART + 2048;
    typedef short v4i16_t __attribute__((ext_vector_type(4)));
    const LAS char* const vtr0 = (const LAS char*)(LAS unsigned char*)(lds) + O_V + (8 * gq + (r >> 2)) * 272 + (32 * vg + 4 * (r & 3)) * 2;
    const int pk0 = 4 * (tid & 31), prg = tid >> 5, pc0 = 4 * prg;
    bf16_t* const tf = (bf16_t*)(lds + O_V);
    for (int bh = blockIdx.x; bh < BH; bh += gridDim.x) {
        const int h = bh & 15;
        const f32x4 og0 = *(const f32x4*)(a.a_onorm_g + h * HD + 32 * vg + 4 * gq), og1 = *(const f32x4*)(a.a_onorm_g + h * HD + 32 * vg + 16 + 4 * gq);
        const f32x4 lbv4 = *(const f32x4*)(LB + h * HD + pk0), om4 = 1.f - lbv4;
        f32x4 st[4][2];
#pragma unroll
        for (int i = 0; i < 4; ++i) { st[i][0] = (f32x4){0.f, 0.f, 0.f, 0.f}; st[i][1] = (f32x4){0.f, 0.f, 0.f, 0.f}; }
        u32x2 sqA[4], sfA[4], sqB[4], sfB[4]; u32x4 svA[2], svB[2]; bf16x8 vb[2][2];
        char* const xs_own = lds + O_XS + w * 4096 + lane * 16; const char* const xs_par = lds + O_XS + (w ^ 4) * 4096 + lane * 16;
        { const u32x4 z = {0u, 0u, 0u, 0u};
#pragma unroll
          for (int f = 0; f < 4; ++f) *(u32x4*)(xs_own + f * 1024) = z; }
#define P4_LOAD(X, n_) do { const size_t blk_ = ((size_t)bh * SEQ + (size_t)(n_) * 64) * HD; \
            _Pragma("unroll") for (int i = 0; i < 4; ++i) { sq##X[i] = *(const u32x2*)(R0 + blk_ + (size_t)(pc0 + i) * HD + pk0); sf##X[i] = *(const u32x2*)(R1 + blk_ + (size_t)(pc0 + i) * HD + pk0); } \
            _Pragma("unroll") for (int rep = 0; rep < 2; ++rep) { const int i = tid + rep * 512; sv##X[rep] = *(const u32x4*)(R2 + blk_ + (size_t)i * 8); } } while (0)
#define P4_WRITE_V(X) do { _Pragma("unroll") for (int rep = 0; rep < 2; ++rep) { const int i = tid + rep * 512; *(u32x4*)(lds + O_V + (i >> 4) * 272 + (i & 15) * 16) = sv##X[rep]; } } while (0)
#define P4_PACK(DST, ksl, vt) do { u32x4 bw_; bw_.x = cvt_pk_bf16(st[2 * (ksl)][vt][0], st[2 * (ksl)][vt][1]); bw_.y = cvt_pk_bf16(st[2 * (ksl)][vt][2], st[2 * (ksl)][vt][3]); \
            bw_.z = cvt_pk_bf16(st[2 * (ksl) + 1][vt][0], st[2 * (ksl) + 1][vt][1]); bw_.w = cvt_pk_bf16(st[2 * (ksl) + 1][vt][2], st[2 * (ksl) + 1][vt][3]); DST = bw_; } while (0)
#define P4_PREP(X, bf_, PUB) do { char* B_ = lds + (bf_) * BUF; bf16_t* tq = (bf16_t*)(B_ + O_QD); float* part2 = (float*)(B_ + O_AT); \
              \
            float ee[4][4]; f32x4 kq_[4]; f32x4 run = {1.f, 1.f, 1.f, 1.f}; \
            _Pragma("unroll") for (int i = 0; i < 4; ++i) { const u32x2 wz = sf##X[i]; \
                const f32x4 fz = {__uint_as_float(wz.x << 16), __uint_as_float(wz.x & 0xffff0000u), __uint_as_float(wz.y << 16), __uint_as_float(wz.y & 0xffff0000u)}; \
                _Pragma("unroll") for (int j = 0; j < 4; ++j) { const float sg = __builtin_amdgcn_rcpf(1.f + __expf(-fz[j])); const float f = lbv4[j] + om4[j] * sg; run[j] *= f; ee[i][j] = run[j]; kq_[i][j] = 1.f - f; } } \
            *(f32x4*)(part2 + prg * 128 + pk0) = run; \
            asm volatile("s_waitcnt vmcnt(0)" ::: "memory");     \
            __syncthreads(); \
            if ((PUB) > 0 && tid == 0) __hip_atomic_store(prog + bh * 16, (unsigned)(PUB), __ATOMIC_RELAXED, __HIP_MEMORY_SCOPE_AGENT); \
            _Pragma("unroll") for (int ksl = 0; ksl < 2; ++ksl) _Pragma("unroll") for (int vt = 0; vt < 2; ++vt) { u32x4 t_; P4_PACK(t_, ksl, vt); *(u32x4*)(xs_own + (ksl * 2 + vt) * 1024) = t_; } \
            if (tid < 32) { f32x4 pa_ = {1.f, 1.f, 1.f, 1.f};     \
                _Pragma("unroll") for (int g = 0; g < 16; ++g) { f32x4* pp_ = (f32x4*)(part2 + g * 128 + 4 * tid); const f32x4 pg = *pp_; *pp_ = pa_; pa_ = pa_ * pg; } \
                *(f32x4*)(part2 + 16 * 128 + 4 * tid) = pa_; } \
            __syncthreads(); \
            const f32x4 offp = *(const f32x4*)(part2 + prg * 128 + pk0), totp = *(const f32x4*)(part2 + 16 * 128 + pk0); \
            float ks_[4][4]; \
            _Pragma("unroll") for (int i = 0; i < 4; ++i) { const u32x2 wq = sq##X[i]; \
                const f32x4 qv = {__uint_as_float(wq.x << 16), __uint_as_float(wq.x & 0xffff0000u), __uint_as_float(wq.y << 16), __uint_as_float(wq.y & 0xffff0000u)}; f32x4 qd, ki; \
                  \
                const u32x2 wk = {cvt_pk_bf16(kq_[i][0], kq_[i][1]), cvt_pk_bf16(kq_[i][2], kq_[i][3])}; \
                const f32x4 kv = {__uint_as_float(wk.x << 16), __uint_as_float(wk.x & 0xffff0000u), __uint_as_float(wk.y << 16), __uint_as_float(wk.y & 0xffff0000u)}; \
                _Pragma("unroll") for (int j = 0; j < 4; ++j) { const float ea = offp[j] * ee[i][j]; const float ie = __builtin_amdgcn_rcpf(ea); qd[j] = qv[j] * ea; ki[j] = kv[j] * ie; ks_[j][i] = ki[j] * totp[j]; } \
                u32x2 o1, o2; o1.x = cvt_pk_bf16(qd[0], qd[1]); o1.y = cvt_pk_bf16(qd[2], qd[3]); o2.x = cvt_pk_bf16(ki[0], ki[1]); o2.y = cvt_pk_bf16(ki[2], ki[3]); \
                *(u32x2*)(tq + (pc0 + i) * 136 + pk0) = o1; *(u32x2*)(tf + (pc0 + i) * 136 + pk0) = o2; } \
            _Pragma("unroll") for (int j = 0; j < 4; ++j) { u32x2 wk; wk.x = cvt_pk_bf16(ks_[j][0], ks_[j][1]); wk.y = cvt_pk_bf16(ks_[j][2], ks_[j][3]); *(u32x2*)(B_ + O_KT + (pk0 + j) * 144 + pc0 * 2) = wk; } \
            if (prg == 0) *(f32x4*)(B_ + O_DL + pk0 * 4) = totp; \
            __syncthreads(); \
            { const int mt = w >> 1, nt0 = (w & 1) * 2; f32x4 acc2[2] = {{0.f, 0.f, 0.f, 0.f}, {0.f, 0.f, 0.f, 0.f}}; \
              _Pragma("unroll") for (int ks = 0; ks < 4; ++ks) { const bf16x8 Aq = *(const bf16x8*)(tq + (16 * mt + r) * 136 + ks * 32 + gq * 8); \
                  _Pragma("unroll") for (int j = 0; j < 2; ++j) { const bf16x8 Bk = *(const bf16x8*)(tf + (16 * (nt0 + j) + r) * 136 + ks * 32 + gq * 8); \
                      acc2[j] = __builtin_amdgcn_mfma_f32_16x16x32_bf16(Bk, Aq, acc2[j], 0, 0, 0); } }     \
              char* ap = B_ + O_AT; \
              __syncthreads();     \
              _Pragma("unroll") for (int j = 0; j < 2; ++j) { const int c = 16 * mt + r, s0_ = 16 * (nt0 + j) + 4 * gq; \
                  u32x2 wa; wa.x = cvt_pk_bf16(s0_ <= c ? acc2[j][0] : 0.f, s0_ + 1 <= c ? acc2[j][1] : 0.f); wa.y = cvt_pk_bf16(s0_ + 2 <= c ? acc2[j][2] : 0.f, s0_ + 3 <= c ? acc2[j][3] : 0.f); \
                  *(u32x2*)(ap + c * 144 + s0_ * 2) = wa; } } \
            P4_WRITE_V(X); \
            __syncthreads(); } while (0)
#define P4_STEP(n_, CUR, X, Y) do { const char* B = lds + (CUR) * BUF; \
            _Pragma("unroll") for (int vt = 0; vt < 2; ++vt) _Pragma("unroll") for (int cs = 0; cs < 2; ++cs) { \
                const v4i16_t lo_ = __builtin_amdgcn_ds_read_tr16_b64_v4i16((LAS v4i16_t*)(vtr0 + cs * 32 * 272 + vt * 32)); \
                const v4i16_t hi_ = __builtin_amdgcn_ds_read_tr16_b64_v4i16((LAS v4i16_t*)(vtr0 + cs * 32 * 272 + vt * 32 + 4 * 272)); \
                vb[vt][cs] = (bf16x8){lo_[0], lo_[1], lo_[2], lo_[3], hi_[0], hi_[1], hi_[2], hi_[3]}; } \
            P4_LOAD(X, ((n_) + 2 < 64) ? (n_) + 2 : 63); \
            f32x4 oo[2][2]; \
            _Pragma("unroll") for (int ml = 0; ml < 2; ++ml) { oo[ml][0] = (f32x4){0.f, 0.f, 0.f, 0.f}; oo[ml][1] = (f32x4){0.f, 0.f, 0.f, 0.f}; \
                _Pragma("unroll") for (int ks = 0; ks < 2; ++ks) { const bf16x8 Bq = *(const bf16x8*)(B + O_AT + (32 * kh + 16 * ml + r) * 144 + ks * 64 + gq * 16); \
                    _Pragma("unroll") for (int vt = 0; vt < 2; ++vt) oo[ml][vt] = __builtin_amdgcn_mfma_f32_16x16x32_bf16(vb[vt][ks], Bq, oo[ml][vt], 0, 0, 0); } } \
            _Pragma("unroll") for (int hf = 0; hf < 2; ++hf) _Pragma("unroll") for (int ksl = 0; ksl < 2; ++ksl) { const int ksg = 2 * (hf == 0 ? kh : 1 - kh) + ksl; u32x4 sf_[2]; \
                _Pragma("unroll") for (int vt = 0; vt < 2; ++vt) sf_[vt] = *(const u32x4*)((hf == 0 ? (const char*)xs_own : xs_par) + (ksl * 2 + vt) * 1024); \
                _Pragma("unroll") for (int ml = 0; ml < 2; ++ml) { const char* qa = B + O_QD + (32 * kh + 16 * ml + r) * 272 + ksg * 64 + gq * 8; \
                    const u32x2 a0 = *(const u32x2*)qa, a1 = *(const u32x2*)(qa + 32); const u32x4 aw = {a0.x, a0.y, a1.x, a1.y}; \
                    _Pragma("unroll") for (int vt = 0; vt < 2; ++vt) oo[ml][vt] = __builtin_amdgcn_mfma_f32_16x16x32_bf16(__builtin_bit_cast(bf16x8, sf_[vt]), __builtin_bit_cast(bf16x8, aw), oo[ml][vt], 0, 0, 0); } } \
            float* part = (float*)(lds + O_PART) + (CUR) * 256; \
            _Pragma("unroll") for (int ml = 0; ml < 2; ++ml) { float s_ = 0.f; \
                _Pragma("unroll") for (int vt = 0; vt < 2; ++vt) s_ += (oo[ml][vt][0] * oo[ml][vt][0] + oo[ml][vt][1] * oo[ml][vt][1]) + (oo[ml][vt][2] * oo[ml][vt][2] + oo[ml][vt][3] * oo[ml][vt][3]); \
                s_ += __shfl_xor(s_, 16); s_ += __shfl_xor(s_, 32); if (gq == 0) part[(32 * kh + 16 * ml + r) * 4 + vg] = s_; } \
            _Pragma("unroll") for (int i = 0; i < 4; ++i) { const f32x4 dlv = *(const f32x4*)(B + O_DL + (64 * kh + 16 * i + 4 * gq) * 4); st[i][0] = st[i][0] * dlv; st[i][1] = st[i][1] * dlv; \
                _Pragma("unroll") for (int cs = 0; cs < 2; ++cs) { const bf16x8 A = *(const bf16x8*)(B + O_KT + (64 * kh + 16 * i + r) * 144 + cs * 64 + gq * 16); \
                    _Pragma("unroll") for (int vt = 0; vt < 2; ++vt) st[i][vt] = __builtin_amdgcn_mfma_f32_16x16x32_bf16(A, vb[vt][cs], st[i][vt], 0, 0, 0); } } \
            P4_PREP(Y, (CUR) ^ 1, (n_)); \
            { bf16_t* op = R0 + ((size_t)bh * SEQ + (size_t)(n_) * 64) * HD + 32 * vg + 4 * gq; \
              _Pragma("unroll") for (int ml = 0; ml < 2; ++ml) { const int c = 32 * kh + 16 * ml + r; const f32x4 p0 = *(const f32x4*)(part + c * 4); \
                const float rs = __builtin_amdgcn_rsqf(((p0.x + p0.y) + (p0.z + p0.w)) * (1.f / HD) + EPS); \
                const f32x4 ov0 = oo[ml][0] * og0 * rs, ov1 = oo[ml][1] * og1 * rs; u32x2 pk0, pk1; pk0.x = cvt_pk_bf16(ov0[0], ov0[1]); pk0.y = cvt_pk_bf16(ov0[2], ov0[3]); pk1.x = cvt_pk_bf16(ov1[0], ov1[1]); pk1.y = cvt_pk_bf16(ov1[2], ov1[3]); \
                if (!dry) { __hip_atomic_store((unsigned long long*)(op + (size_t)c * HD), __builtin_bit_cast(unsigned long long, pk0), __ATOMIC_RELAXED, __HIP_MEMORY_SCOPE_AGENT); \
                            __hip_atomic_store((unsigned long long*)(op + (size_t)c * HD + 16), __builtin_bit_cast(unsigned long long, pk1), __ATOMIC_RELAXED, __HIP_MEMORY_SCOPE_AGENT); } else asm volatile("" :: "v"(pk0), "v"(pk1)); } } } while (0)
        P4_LOAD(A, 0); P4_LOAD(B, 1);
        __syncthreads();
        P4_PREP(A, 0, 0);
        for (int n = 0; n < 64; n += 2) { P4_STEP(n, 0, A, B); P4_STEP(n + 1, 1, B, A); }
        asm volatile("s_waitcnt vmcnt(0)" ::: "memory");
        __syncthreads();
        if (tid == 0) __hip_atomic_store(prog + bh * 16, 64u, __ATOMIC_RELAXED, __HIP_MEMORY_SCOPE_AGENT);
#undef P4_LOAD
#undef P4_WRITE_V
#undef P4_PREP
#undef P4_PACK
#undef P4_STEP
    }
}

#define XB_TMO      128
#define XB_XCNT(j)  (256  + 64 * (j))
#define XB_XSUB(j)  (1280 + 64 * (j))
#define XB_XGEN(j)  (2304 + 64 * (j))
#define XB_TOP      3328
#define XB_TOPGEN   3392
#define XCD_BAR_WORDS 3456
#define XB_SPIN_CAP (1u << 22)
__device__ __forceinline__ unsigned xb_ld(unsigned* p)              { return __hip_atomic_load(p, __ATOMIC_RELAXED, __HIP_MEMORY_SCOPE_AGENT); }
__device__ __forceinline__ unsigned xb_add(unsigned* p, unsigned v) { return __hip_atomic_fetch_add(p, v, __ATOMIC_RELAXED, __HIP_MEMORY_SCOPE_AGENT); }
__device__ __forceinline__ unsigned xb_xcc_id() { return (unsigned)__builtin_amdgcn_s_getreg((3 << 11) | 20) & 0xFu; }
#define XB_SPIN(cond, bar) do { unsigned _sp = 0; while (cond) { __builtin_amdgcn_s_sleep(1); \
    if ((++_sp & 255u) == 0u) { if (xb_ld(&(bar)[XB_TMO])) break; if (_sp > XB_SPIN_CAP) { atomicAdd(&(bar)[XB_TMO], 1u); break; } } } } while (0)
struct XcdBarrier { unsigned* bar; unsigned x; volatile LAS unsigned* st; };
__device__ __forceinline__ XcdBarrier xcd_barrier_post(unsigned* bar, volatile LAS unsigned* st) {
    XcdBarrier b; b.bar = bar; b.x = xb_xcc_id(); b.st = st;
    if (threadIdx.x == 0) (void)xb_add(&bar[XB_XCNT(b.x)], 1u);
    return b;
}
__device__ __forceinline__ void xcd_barrier_complete(unsigned* bar, unsigned x, unsigned& nloc, unsigned& nx) {
    const unsigned G = gridDim.x * gridDim.y * gridDim.z;
    unsigned sum, cnt, mine, sp = 0u;
    for (;;) {
        sum = 0u; cnt = 0u; mine = 0u;
#pragma unroll
        for (unsigned j = 0; j < 16; ++j) { const unsigned c = xb_ld(&bar[XB_XCNT(j)]); sum += c; cnt += (c > 0u) ? 1u : 0u; mine = (j == x) ? c : mine; }
        if (sum == G) break;
        __builtin_amdgcn_s_sleep(1);
        if ((++sp & 255u) == 0u) { if (xb_ld(&bar[XB_TMO])) break; if (sp > XB_SPIN_CAP) { atomicAdd(&bar[XB_TMO], 1u); break; } }
    }
    nloc = mine > 0u ? mine : 1u; nx = cnt > 0u ? cnt : 1u;
}
__device__ __forceinline__ void xcd_barrier(unsigned* bar_, volatile LAS unsigned* st_, int wv) {
    const int tid0 = otid(wv);
    asm volatile("" : "+s"(bar_));
    XcdBarrier b; b.bar = bar_; b.st = st_; b.x = 0;
    asm volatile("s_waitcnt vmcnt(0)" ::: "memory");
    __syncthreads();
    if (tid0 == 0) {
        unsigned* bar = b.bar; b.x = xb_xcc_id();
        __builtin_amdgcn_s_waitcnt(0);
        unsigned nloc = b.st[0], nx = b.st[1];
        if (nloc == 0u) { xcd_barrier_complete(bar, b.x, nloc, nx); b.st[0] = nloc; b.st[1] = nx; }
        const unsigned old = xb_add(&bar[XB_XSUB(b.x)], 1u);
        const unsigned gen = old / nloc;
        if (old + 1u == (gen + 1u) * nloc) {
            __builtin_amdgcn_fence(__ATOMIC_RELEASE, "agent");
            asm volatile("s_waitcnt vmcnt(0)" ::: "memory");
            const unsigned og = xb_add(&bar[XB_TOP], 1u);
            const unsigned tg = og / nx;
            if (og + 1u == (tg + 1u) * nx) xb_add(&bar[XB_TOPGEN], 1u);
            else XB_SPIN(xb_ld(&bar[XB_TOPGEN]) == tg, bar);
            __builtin_amdgcn_fence(__ATOMIC_ACQUIRE, "agent");
            xb_add(&bar[XB_XGEN(b.x)], 1u);
            asm volatile("s_waitcnt vmcnt(0)" ::: "memory");
        } else {
            XB_SPIN(xb_ld(&bar[XB_XGEN(b.x)]) == gen, bar);
            __builtin_amdgcn_fence(__ATOMIC_ACQUIRE, "agent");
            asm volatile("s_waitcnt vmcnt(0)" ::: "memory");
        }
    }
    __syncthreads();
}

__global__ void __launch_bounds__(512, 2) yoco_fwd(Args a) {
    extern __shared__ __attribute__((aligned(16))) unsigned char lds_raw[];
    char* lds = (char*)lds_raw; LAS unsigned char* ldsl = (LAS unsigned char*)lds_raw;
    cg::grid_group grid = cg::this_grid();
    const int wv = __builtin_amdgcn_readfirstlane((int)threadIdx.x >> 6);
    unsigned char* ws = a.ws;
    bf16_t* R0 = (bf16_t*)(ws + WS_R0); bf16_t* R1 = (bf16_t*)(ws + WS_R1); bf16_t* R2 = (bf16_t*)(ws + WS_R2);
    bf16_t* XA = (bf16_t*)(ws + WS_XA); bf16_t* H0 = (bf16_t*)a.out;
    const float* MOD0 = (const float*)(ws + WS_MOD0); const float* MOD1 = (const float*)(ws + WS_MOD1); const float* KVMOD = (const float*)(ws + WS_KVMOD);
    float* LSG = (float*)(ws + WS_LSG);
    const int G = gridDim.x, c = blockIdx.x;
    constexpr size_t TS = 64 * MiB;

    unsigned* barw = (unsigned*)(ws + WS_SM + 786432);
    volatile LAS unsigned* bst = (volatile LAS unsigned*)(ldsl + 143360);
    if (threadIdx.x == 0) { bst[0] = 0u; bst[1] = 0u; }
    if (a.one == 0) grid.sync();
    (void)xcd_barrier_post(barw, bst);
#define GSYNC() xcd_barrier((unsigned*)(a.ws + WS_SM + 786432), (volatile LAS unsigned*)(ldsl + 143360), wv)
    p0_prologue(a, lds, wv);
    GSYNC();
    norm_phase<false, false>(a.x, a.norm_g, MOD0, MOD0 + 1024, 3072, H0, nullptr, nullptr, nullptr, 0, nullptr, nullptr, nullptr, nullptr, lds, wv);
    GSYNC();
    { pg8::Gemm g{H0, (const bf16_t*)(ws + WS_W1), TOK, 6144, DM, 2048u, 256, (size_t)4096 * 2048}; pg8::StaticOrder S; S.init(TOK, 6144, G, c);
      pg8::EpiHead E{R0, TS}; pg8::gemm_phase(ldsl, g, S, E, wv);
    }
    GSYNC();
    unsigned* prog = (unsigned*)(ws + WS_SM + 819200);
    { pg8::Gemm g{H0, (const bf16_t*)(ws + WS_W1) + (size_t)6144 * DM, TOK, 2048, DM, 2048u, 256, (size_t)4096 * 2048};
      if (G == 256) {
          if (c < 128) p4_scan(a, lds, 0, wv, prog);
          else { pg8::EarlyOrder S{c - 128}; pg8::EpiMulSiluWait E{R0, prog}; pg8::gemm_phase(ldsl, g, S, E, wv); }
          GSYNC();
          { pg8::RestOrder S{c}; pg8::EpiMulSilu E{R0}; pg8::gemm_phase(ldsl, g, S, E, wv); }
      } else {
          p4_scan(a, lds, 0, wv, prog);
          GSYNC();
          { pg8::StaticOrder S; S.init(TOK, 2048, G, c); pg8::EpiMulSilu E{R0}; pg8::gemm_phase(ldsl, g, S, E, wv); }
      } }
    GSYNC();
    { pg8::Gemm g{R0, (const bf16_t*)(ws + WS_W2), TOK, DM, WD, 256u, (size_t)SEQ * 256, (size_t)16 * SEQ * 256}; pg8::StaticOrder S; S.init(TOK, DM, G, c);
      pg8::EpiRes E{a.x, a.out, MOD0 + 2048}; pg8::gemm_phase(ldsl, g, S, E, wv);
    }
    GSYNC();
    norm_phase<true, true>(a.out, a.kv_norm_g, KVMOD, KVMOD + 1024, 2048, R0, a.norm_g + DM, MOD1, MOD1 + 1024, 3072, XA, (const float*)(ws + WS_WFL), a.kv_fb, LSG, lds, wv);
    GSYNC();
    cumsum_phase(LSG, (int*)(ws + WS_SM + 802816), a.k_norm_g, a.b_q_norm_g, lds, wv);
    { pg8::Gemm g{R0, (const bf16_t*)(ws + WS_W3KV), TOK, 4096, DM, 2048u, 256, (size_t)4096 * 2048}; pg8::StaticOrder S; S.init(TOK, 4096, G, c);
      pg8::EpiHeadNorm E{R1, TS, 1, a.k_norm_g, (LAS float*)(ldsl + 131072)}; pg8::gemm_phase(ldsl, g, S, E, wv);
    }
    GSYNC();
    { pg8::Gemm g{XA, (const bf16_t*)(ws + WS_W3Q), TOK, 2048, DM, 2048u, 256, (size_t)4096 * 2048}; pg8::StaticOrder S; S.init(TOK, 2048, G, c);
      pg8::EpiHeadNorm E{R0, TS, 1, a.b_q_norm_g, (LAS float*)(ldsl + 131072)}; pg8::gemm_phase(ldsl, g, S, E, wv); }
    GSYNC();
    att::phase(lds, R0, R1, R2, LSG, (const int*)(ws + WS_SM + 802816), R0, (bf16_t*)(ws + WS_SM + 716800), 2048, wv);
    GSYNC();
    { pg8::Gemm g{XA, (const bf16_t*)(ws + WS_W3G), TOK, 2048, DM, 2048u, 256, (size_t)4096 * 2048}; pg8::StaticOrder S; S.init(TOK, 2048, G, c);
      pg8::EpiMulSilu E{R0}; pg8::gemm_phase(ldsl, g, S, E, wv); }
    GSYNC();
    { pg8::Gemm g{R0, (const bf16_t*)(ws + WS_W4), TOK, DM, WD, 256u, (size_t)SEQ * 256, (size_t)16 * SEQ * 256}; pg8::StaticOrder S; S.init(TOK, DM, G, c);
      pg8::EpiRes E{a.out, a.out, MOD1 + 2048}; pg8::gemm_phase(ldsl, g, S, E, wv); }
}

extern "C" void kernel_launch(void* const* d_in, const int* in_sizes, int n_in, void* d_out, int out_size, void* d_ws, size_t ws_size, hipStream_t stream) {
    static int grid = 0;
    if (grid == 0) {
        int dev = 0, cus = 0, per_cu = 0;
        hipGetDevice(&dev); hipDeviceGetAttribute(&cus, hipDeviceAttributeMultiprocessorCount, dev);
        hipFuncSetAttribute((const void*)yoco_fwd, hipFuncAttributeMaxDynamicSharedMemorySize, LDS_BYTES);
        hipOccupancyMaxActiveBlocksPerMultiprocessor(&per_cu, (const void*)yoco_fwd, 512, LDS_BYTES);
        (void)hipGetLastError();
        if (cus <= 0) cus = 256;
        grid = cus;
        if (per_cu < 1) fprintf(stderr, "kernel_launch: occupancy query reports %d blocks/CU\n", per_cu);
        if (ws_size < 512 * MiB) fprintf(stderr, "kernel_launch: workspace too small (%zu)\n", ws_size);
    }
    if (hipMemsetAsync((char*)d_ws + WS_SM + 786432, 0, 40960, stream) != hipSuccess) fprintf(stderr, "kernel_launch: memset of barrier words failed\n");
    Args a{};
    const float** pp = (const float**)&a;
    for (int i = 0; i < 18; ++i) pp[i] = (const float*)d_in[i];
    a.out = (float*)d_out; a.ws = (unsigned char*)d_ws; a.one = 1;
    void* args[] = {&a};
    hipError_t e = hipLaunchCooperativeKernel((const void*)yoco_fwd, dim3(grid), dim3(512), args, LDS_BYTES, stream);
    if (e != hipSuccess) fprintf(stderr, "cooperative launch failed: %s (grid %d)\n", hipGetErrorString(e), grid);
}
```

```cpp
#include <hip/hip_runtime.h>
#include <hip/hip_cooperative_groups.h>
#include <cstdio>
#include <cstdint>
namespace cg = cooperative_groups;

#define LAS __attribute__((address_space(3)))
typedef unsigned short bf16_t;
typedef short bf16x8 __attribute__((ext_vector_type(8)));
typedef short s16x4 __attribute__((ext_vector_type(4)));
typedef float f32x4 __attribute__((ext_vector_type(4)));
typedef float f32x16 __attribute__((ext_vector_type(16)));
typedef unsigned u32x4 __attribute__((ext_vector_type(4)));
typedef unsigned u32x2 __attribute__((ext_vector_type(2)));

constexpr int NB = 8, SEQ = 4096, DM = 1024, WD = 2048, NH = 16, HD = 128, BH = NB * NH, TOK = NB * SEQ;
constexpr float EPS = 1e-6f;
constexpr size_t MiB = 1u << 20;
constexpr size_t WS_R0 = 0, WS_R1 = 128 * MiB, WS_R2 = 256 * MiB, WS_XA = 384 * MiB;
constexpr size_t WS_W1 = 448 * MiB, WS_W2 = 464 * MiB, WS_W3KV = 468 * MiB, WS_W3Q = 476 * MiB, WS_W3G = 480 * MiB, WS_W4 = 484 * MiB;
constexpr size_t WS_SM = 488 * MiB;
constexpr size_t WS_MOD0 = WS_SM, WS_MOD1 = WS_SM + 98304, WS_KVMOD = WS_SM + 196608, WS_LB = WS_SM + 262144, WS_WFL = WS_SM + 270336;
constexpr size_t WS_LSG = WS_SM + 1 * MiB, WS_DL = WS_SM + 4 * MiB;
constexpr int LDS_BYTES = 147456;

__device__ __forceinline__ float bf2f(unsigned short h) { return __uint_as_float(((unsigned)h) << 16); }
typedef float f32x2_t __attribute__((ext_vector_type(2))); typedef __bf16 bf16x2_t __attribute__((ext_vector_type(2)));
__device__ __forceinline__ unsigned cvt_pk_bf16(float lo, float hi) { f32x2_t v = {lo, hi}; bf16x2_t b = __builtin_convertvector(v, bf16x2_t); return __builtin_bit_cast(unsigned, b); }
__device__ __forceinline__ unsigned short f2bf(float f) { return (unsigned short)(cvt_pk_bf16(f, 0.f) & 0xffffu); }
__device__ __forceinline__ float wave_sum(float v) {
#pragma unroll
    for (int o = 1; o < 64; o <<= 1) v += __shfl_xor(v, o);
    return v;
}
__device__ __forceinline__ int otid(int wv) { int t = wv * 64 + (int)__builtin_amdgcn_mbcnt_hi(~0u, __builtin_amdgcn_mbcnt_lo(~0u, 0u)); asm volatile("" : "+v"(t)); return t; }
__device__ __forceinline__ float silu_f(float x) { return x * __builtin_amdgcn_rcpf(1.f + __builtin_amdgcn_exp2f(-1.4426950408889634f * x)); }

namespace pg8 {
constexpr int BM = 256, BK = 64, HALF = 128, HTB = HALF * BK * 2, STAGE_BYTES = 8 * HTB, NXCD = 8, WGM = 8;
__host__ __device__ __forceinline__ int lds_byte(int r, int c) { const int st = (r >> 4) * 2 + (c >> 5), rr = r & 15, cc = c & 31, ob = rr * 64 + cc * 2; return st * 1024 + (ob ^ (((ob >> 9) & 1) << 5)); }
__host__ __device__ __forceinline__ void stage_rc(int b, int& R, int& C) { const int st = b / 1024, sb = b % 1024, swz = sb ^ (((sb >> 9) & 1) << 5); R = (st >> 1) * 16 + swz / 64; C = (st & 1) * 32 + (swz % 64) / 2; }
__host__ __device__ __forceinline__ int perm32(int rho) { const int n = rho >> 4, i = rho & 15; return 8 * (i >> 2) + 4 * n + (i & 3); }

struct Unit { int pm, pn; };
struct Gemm { const bf16_t* A; const bf16_t* Bt; int M, N, K; unsigned lda; size_t hsA, bsA; };

struct StaticOrder {
    int nM, nN, nwg, G, c;
    __device__ void init(int M, int N, int G_, int c_) { nM = M / BM; nN = N / BM; nwg = nM * nN; G = G_; c = c_; }
    __device__ bool next(int i, Unit& u) const {
        const long L = (long)i * G + c; if (L >= nwg) return false;
        int wgid = (int)L; { const int q = nwg / NXCD, r = nwg % NXCD, xcd = wgid % NXCD, off = wgid / NXCD; wgid = (xcd < r ? xcd * (q + 1) : r * (q + 1) + (xcd - r) * q) + off; }
        const int nig = WGM * nN, gid = wgid / nig, fm = gid * WGM, gsz = (nM - fm) < WGM ? (nM - fm) : WGM;
        u.pm = fm + ((wgid % nig) % gsz); u.pn = (wgid % nig) / gsz; return true;
    }
};

struct EarlyOrder {
    int e;
    __device__ bool next(int i, Unit& u) const { if (i >= 6) return false; const int uu = i * 128 + e, rp = uu >> 6, idx = uu & 63; u.pm = (idx >> 3) * 16 + rp; u.pn = idx & 7; return true; }
};
struct RestOrder {
    int c;
    __device__ bool next(int i, Unit& u) const { if (i >= 1) return false; const int rp = 12 + (c >> 6), idx = c & 63; u.pm = (idx >> 3) * 16 + rp; u.pn = idx & 7; return true; }
};

struct EpiHead {
    bf16_t* base0; size_t tstride;
    __device__ __forceinline__ void operator()(const f32x4 (&acc)[2][2][4][2], const Unit& u, int wr, int wc, int fr, int fq) const {
        const int b = u.pm >> 4, s0 = (u.pm & 15) * 256 + wr * 64 + fr, t = u.pn >> 3, hd0 = (u.pn & 7) * 2;
        bf16_t* base = base0 + (size_t)t * tstride + wc * 32 + 8 * fq;
#pragma unroll
        for (int ai = 0; ai < 2; ++ai)
#pragma unroll
            for (int m = 0; m < 4; ++m)
#pragma unroll
                for (int bj = 0; bj < 2; ++bj) {
                    const f32x4 v0 = acc[ai][bj][m][0], v1 = acc[ai][bj][m][1];
                    u32x4 w; w.x = cvt_pk_bf16(v0[0], v0[1]); w.y = cvt_pk_bf16(v0[2], v0[3]); w.z = cvt_pk_bf16(v1[0], v1[1]); w.w = cvt_pk_bf16(v1[2], v1[3]);
                    *(u32x4*)(base + ((size_t)(b * 16 + hd0 + bj) * SEQ + s0 + ai * HALF + m * 16) * HD) = w;
                }
    }
};
struct EpiHeadNorm {
    bf16_t* base0; size_t tstride; int nnorm; const float* g; LAS float* xch;
    __device__ __forceinline__ void operator()(const f32x4 (&acc)[2][2][4][2], const Unit& u, int wr, int wc, int fr, int fq) const {
        const int b = u.pm >> 4, s0 = (u.pm & 15) * 256 + wr * 64 + fr, t = u.pn >> 3, hd0 = (u.pn & 7) * 2;
        bf16_t* base = base0 + (size_t)t * tstride + wc * 32 + 8 * fq;
        if (t < nnorm) {
#pragma unroll
            for (int ai = 0; ai < 2; ++ai)
#pragma unroll
                for (int m = 0; m < 4; ++m)
#pragma unroll
                    for (int bj = 0; bj < 2; ++bj) { const f32x4 v0 = acc[ai][bj][m][0], v1 = acc[ai][bj][m][1];
                        float sq = ((v0[0] * v0[0] + v0[1] * v0[1]) + (v0[2] * v0[2] + v0[3] * v0[3])) + ((v1[0] * v1[0] + v1[1] * v1[1]) + (v1[2] * v1[2] + v1[3] * v1[3]));
                        sq += __shfl_xor(sq, 16); sq += __shfl_xor(sq, 32);
                        if (fq == 0) xch[((ai * HALF + wr * 64 + m * 16 + fr) * 2 + bj) * 4 + wc] = sq; }
            asm volatile("s_waitcnt lgkmcnt(0)" ::: "memory"); __builtin_amdgcn_s_barrier(); asm volatile("" ::: "memory");
            const f32x4 g0 = *(const f32x4*)(g + wc * 32 + 8 * fq), g1 = *(const f32x4*)(g + wc * 32 + 8 * fq + 4);
#pragma unroll
            for (int ai = 0; ai < 2; ++ai)
#pragma unroll
                for (int m = 0; m < 4; ++m)
#pragma unroll
                    for (int bj = 0; bj < 2; ++bj) {
                        const f32x4 p = *(const LAS f32x4*)(xch + ((ai * HALF + wr * 64 + m * 16 + fr) * 2 + bj) * 4);
                        const float rs = __builtin_amdgcn_rsqf(((p[0] + p[1]) + (p[2] + p[3])) * (1.f / 128.f) + EPS);
                        const f32x4 v0 = acc[ai][bj][m][0] * g0 * rs, v1 = acc[ai][bj][m][1] * g1 * rs;
                        u32x4 w; w.x = cvt_pk_bf16(v0[0], v0[1]); w.y = cvt_pk_bf16(v0[2], v0[3]); w.z = cvt_pk_bf16(v1[0], v1[1]); w.w = cvt_pk_bf16(v1[2], v1[3]);
                        *(u32x4*)(base + ((size_t)(b * 16 + hd0 + bj) * SEQ + s0 + ai * HALF + m * 16) * HD) = w;
                    }
        } else {
#pragma unroll
            for (int ai = 0; ai < 2; ++ai)
#pragma unroll
                for (int m = 0; m < 4; ++m)
#pragma unroll
                    for (int bj = 0; bj < 2; ++bj) {
                        const f32x4 v0 = acc[ai][bj][m][0], v1 = acc[ai][bj][m][1];
                        u32x4 w; w.x = cvt_pk_bf16(v0[0], v0[1]); w.y = cvt_pk_bf16(v0[2], v0[3]); w.z = cvt_pk_bf16(v1[0], v1[1]); w.w = cvt_pk_bf16(v1[2], v1[3]);
                        *(u32x4*)(base + ((size_t)(b * 16 + hd0 + bj) * SEQ + s0 + ai * HALF + m * 16) * HD) = w;
                    }
        }
    }
};
struct EpiMulSilu {
    bf16_t* X;
    __device__ __forceinline__ void operator()(const f32x4 (&acc)[2][2][4][2], const Unit& u, int wr, int wc, int fr, int fq) const {
        const int b = u.pm >> 4, s0 = (u.pm & 15) * 256 + wr * 64 + fr, hd0 = (u.pn & 7) * 2;
        bf16_t* base = X + wc * 32 + 8 * fq;
        u32x4 pre[2][2];
#define EM_PTR(bt, bj) ((u32x4*)(base + ((size_t)(b * 16 + hd0 + (bj)) * SEQ + s0 + ((bt) >> 2) * HALF + ((bt) & 3) * 16) * HD))
        pre[0][0] = *EM_PTR(0, 0); pre[0][1] = *EM_PTR(0, 1);
#pragma unroll
        for (int bt = 0; bt < 8; ++bt) {
            if (bt + 1 < 8) { pre[(bt + 1) & 1][0] = *EM_PTR(bt + 1, 0); pre[(bt + 1) & 1][1] = *EM_PTR(bt + 1, 1); }
            asm volatile("" ::: "memory");
#pragma unroll
            for (int bj = 0; bj < 2; ++bj) {
                const u32x4 x = pre[bt & 1][bj]; const f32x4 v0 = acc[bt >> 2][bj][bt & 3][0], v1 = acc[bt >> 2][bj][bt & 3][1];
                u32x4 w;
                w.x = cvt_pk_bf16(__uint_as_float(x.x << 16) * silu_f(v0[0]), __uint_as_float(x.x & 0xffff0000u) * silu_f(v0[1]));
                w.y = cvt_pk_bf16(__uint_as_float(x.y << 16) * silu_f(v0[2]), __uint_as_float(x.y & 0xffff0000u) * silu_f(v0[3]));
                w.z = cvt_pk_bf16(__uint_as_float(x.z << 16) * silu_f(v1[0]), __uint_as_float(x.z & 0xffff0000u) * silu_f(v1[1]));
                w.w = cvt_pk_bf16(__uint_as_float(x.w << 16) * silu_f(v1[2]), __uint_as_float(x.w & 0xffff0000u) * silu_f(v1[3]));
                *EM_PTR(bt, bj) = w;
            }
            asm volatile("" ::: "memory");
        }
#undef EM_PTR
    }
};
struct EpiMulSiluWait {
    bf16_t* X; unsigned* prog;
    __device__ __forceinline__ void operator()(const f32x4 (&acc)[2][2][4][2], const Unit& u, int wr, int wc, int fr, int fq) const {
        const int b = u.pm >> 4, s0 = (u.pm & 15) * 256 + wr * 64 + fr, hd0 = (u.pn & 7) * 2;
        { const unsigned need = 4u * (unsigned)(u.pm & 15) + 4u; unsigned* p0 = prog + (b * 16 + hd0) * 16; unsigned* p1 = p0 + 16; unsigned sp = 0;
          while ((__hip_atomic_load(p0, __ATOMIC_RELAXED, __HIP_MEMORY_SCOPE_AGENT) < need || __hip_atomic_load(p1, __ATOMIC_RELAXED, __HIP_MEMORY_SCOPE_AGENT) < need) && ++sp < (1u << 22)) __builtin_amdgcn_s_sleep(8);
          __builtin_amdgcn_fence(__ATOMIC_ACQUIRE, "agent"); asm volatile("s_waitcnt vmcnt(0)" ::: "memory"); }
        bf16_t* base = X + wc * 32 + 8 * fq;
        u32x4 pre[2][2];
#define EM_PTR(bt, bj) ((u32x4*)(base + ((size_t)(b * 16 + hd0 + (bj)) * SEQ + s0 + ((bt) >> 2) * HALF + ((bt) & 3) * 16) * HD))
        pre[0][0] = *EM_PTR(0, 0); pre[0][1] = *EM_PTR(0, 1);
#pragma unroll
        for (int bt = 0; bt < 8; ++bt) {
            if (bt + 1 < 8) { pre[(bt + 1) & 1][0] = *EM_PTR(bt + 1, 0); pre[(bt + 1) & 1][1] = *EM_PTR(bt + 1, 1); }
            asm volatile("" ::: "memory");
#pragma unroll
            for (int bj = 0; bj < 2; ++bj) {
                const u32x4 x = pre[bt & 1][bj]; const f32x4 v0 = acc[bt >> 2][bj][bt & 3][0], v1 = acc[bt >> 2][bj][bt & 3][1];
                u32x4 w;
                w.x = cvt_pk_bf16(__uint_as_float(x.x << 16) * silu_f(v0[0]), __uint_as_float(x.x & 0xffff0000u) * silu_f(v0[1]));
                w.y = cvt_pk_bf16(__uint_as_float(x.y << 16) * silu_f(v0[2]), __uint_as_float(x.y & 0xffff0000u) * silu_f(v0[3]));
                w.z = cvt_pk_bf16(__uint_as_float(x.z << 16) * silu_f(v1[0]), __uint_as_float(x.z & 0xffff0000u) * silu_f(v1[1]));
                w.w = cvt_pk_bf16(__uint_as_float(x.w << 16) * silu_f(v1[2]), __uint_as_float(x.w & 0xffff0000u) * silu_f(v1[3]));
                *EM_PTR(bt, bj) = w;
            }
            asm volatile("" ::: "memory");
        }
#undef EM_PTR
    }
};
struct EpiRes {
    const float* base; float* out; const float* gate;
    __device__ __forceinline__ void operator()(const f32x4 (&acc)[2][2][4][2], const Unit& u, int wr, int wc, int fr, int fq) const {
        const int b = u.pm >> 4, row0 = u.pm * BM + wr * 64 + fr, col0 = u.pn * BM + wc * 32 + 8 * fq;
        f32x4 gv[2][2];
#pragma unroll
        for (int bj = 0; bj < 2; ++bj)
#pragma unroll
            for (int n = 0; n < 2; ++n) gv[bj][n] = *(const f32x4*)(gate + (size_t)b * 3072 + col0 + bj * HALF + 4 * n);
        f32x4 pre[2][2][2][2];
#define ER_OFF(bt, mm) ((size_t)(row0 + ((bt) >> 1) * HALF + (2 * ((bt) & 1) + (mm)) * 16) * DM + col0)
#define ER_LOAD(bt, sl) do { _Pragma("unroll") for (int mm = 0; mm < 2; ++mm) _Pragma("unroll") for (int bj = 0; bj < 2; ++bj) _Pragma("unroll") for (int n = 0; n < 2; ++n) \
            pre[sl][mm][bj][n] = *(const f32x4*)(base + ER_OFF(bt, mm) + bj * HALF + 4 * n); } while (0)
        ER_LOAD(0, 0);
#pragma unroll
        for (int bt = 0; bt < 4; ++bt) {
            if (bt + 1 < 4) { if (bt & 1) ER_LOAD(bt + 1, 0); else ER_LOAD(bt + 1, 1); }
            asm volatile("" ::: "memory");
#pragma unroll
            for (int mm = 0; mm < 2; ++mm)
#pragma unroll
                for (int bj = 0; bj < 2; ++bj)
#pragma unroll
                    for (int n = 0; n < 2; ++n)
                        *(f32x4*)(out + ER_OFF(bt, mm) + bj * HALF + 4 * n) = pre[bt & 1][mm][bj][n] + gv[bj][n] * acc[bt >> 1][bj][2 * (bt & 1) + mm][n];
            asm volatile("" ::: "memory");
        }
#undef ER_OFF
#undef ER_LOAD
    }
};

template <class Epi, class Sched>
__device__ __forceinline__ void gemm_phase(LAS unsigned char* lds, const Gemm g, const Sched& S, const Epi& E, int wv) {
    const int tid = otid(wv), wid = __builtin_amdgcn_readfirstlane(tid >> 6), lane = tid & 63, wr = wid >> 2, wc = wid & 3, fr = lane & 15, fq = lane >> 4;
    const int K = g.K, nt = K / BK;
    unsigned voffA[2], voffB[2];
#pragma unroll
    for (int i = 0; i < 2; ++i) { int R, C; stage_rc(tid * 16 + i * 8192, R, C); const int Rb = (R & ~31) + perm32(R & 31);
        voffA[i] = (unsigned)R * g.lda + (unsigned)C * 2u; voffB[i] = (unsigned)(Rb * K + C) * 2u; }
    const size_t kstep = (size_t)(BK * 2);
    const size_t hstepA = (size_t)HALF * g.lda, hstepB = (size_t)HALF * K * 2, tstepB = 2 * hstepB, hsA = g.hsA;
    const unsigned ldsw = (unsigned)wid * 1024u;
    const int aoff = lds_byte(wr * 64 + fr, fq * 8), boff = lds_byte(wc * 32 + fr, fq * 8);
#define PG8_SA(b, h) (((b) * 2 + (h)) * HTB)
#define PG8_SB(b, h) ((4 + (b) * 2 + (h)) * HTB)
#define PG8_STAGE(bufoff, gbase, voff) do { _Pragma("unroll") for (int _i = 0; _i < 2; ++_i) \
        __builtin_amdgcn_global_load_lds((const unsigned*)((const char*)(gbase) + (voff)[_i]), (LAS unsigned*)(lds + (bufoff) + ldsw + _i * 8192), 16, 0, 0); } while (0)
#define PG8_LDA(dst, b, h) do { _Pragma("unroll") for (int m = 0; m < 4; ++m) _Pragma("unroll") for (int k = 0; k < 2; ++k) dst[m][k] = *(const LAS bf16x8*)(lds + PG8_SA(b, h) + aoff + m * 2048 + k * 1024); } while (0)
#define PG8_LDB(dst, b, h) do { _Pragma("unroll") for (int n = 0; n < 2; ++n) _Pragma("unroll") for (int k = 0; k < 2; ++k) dst[n][k] = *(const LAS bf16x8*)(lds + PG8_SB(b, h) + boff + n * 2048 + k * 1024); } while (0)
#define PG8_MMA(ai, bj, At, Bt) do { __builtin_amdgcn_s_setprio(1); _Pragma("unroll") for (int m = 0; m < 4; ++m) _Pragma("unroll") for (int n = 0; n < 2; ++n) _Pragma("unroll") for (int k = 0; k < 2; ++k) \
        acc[ai][bj][m][n] = __builtin_amdgcn_mfma_f32_16x16x32_bf16(Bt[n][k], At[m][k], acc[ai][bj][m][n], 0, 0, 0); __builtin_amdgcn_s_setprio(0); } while (0)
#define PG8_WAIT_V(n) asm volatile("s_waitcnt vmcnt(" #n ")" ::: "memory")
#define PG8_WAIT_L(n) asm volatile("s_waitcnt lgkmcnt(" #n ")" ::: "memory")
#define PG8_BAR __builtin_amdgcn_s_barrier()
#define PG8_SCHED __builtin_amdgcn_sched_barrier(0)
#define PG8_ATILE(u) ((const char*)g.A + (size_t)((u).pm >> 4) * g.bsA + (size_t)((u).pm & 15) * 256 * g.lda)
    Unit cur, nxt; int ui = 0;
    if (!S.next(0, cur)) return;
    f32x4 acc[2][2][4][2];
#pragma unroll
    for (int a = 0; a < 2; ++a)
#pragma unroll
        for (int b = 0; b < 2; ++b)
#pragma unroll
            for (int m = 0; m < 4; ++m)
#pragma unroll
                for (int n = 0; n < 2; ++n) acc[a][b][m][n] = (f32x4){0.f, 0.f, 0.f, 0.f};
    bf16x8 At[4][2], B0[2][2], B1[2][2];
    const char* cA = PG8_ATILE(cur); const char* cB = (const char*)g.Bt + (size_t)cur.pn * tstepB;
    PG8_STAGE(PG8_SB(0, 0), cB, voffB); PG8_STAGE(PG8_SB(0, 1), cB + hstepB, voffB); PG8_STAGE(PG8_SA(0, 0), cA, voffA); PG8_STAGE(PG8_SA(0, 1), cA + hstepA, voffA);
    if (wr == 1) PG8_BAR;
    PG8_WAIT_V(2); PG8_BAR;
    PG8_STAGE(PG8_SB(1, 0), cB + kstep, voffB); PG8_STAGE(PG8_SA(1, 0), cA + kstep, voffA); PG8_STAGE(PG8_SB(1, 1), cB + hstepB + kstep, voffB);
    PG8_WAIT_V(6); PG8_BAR;
    for (;;) {
        const bool has_next = S.next(ui + 1, nxt);
        const char* nA = has_next ? PG8_ATILE(nxt) : cA; const char* nB = has_next ? (const char*)g.Bt + (size_t)nxt.pn * tstepB : cB;
        for (int t = 0; t < nt; t += 2) {
            const bool last = (t == nt - 2);
            const char* a1 = cA + (size_t)(t >> 1) * hsA + kstep;
            const char* a2 = last ? nA : cA + (size_t)((t >> 1) + 1) * hsA; const char* b2 = last ? nB : cB + (size_t)(t + 2) * kstep;
            const char* a3 = a2 + kstep; const char* b3 = b2 + kstep;
            PG8_LDB(B0, 0, 0); PG8_LDB(B1, 0, 1); PG8_SCHED; PG8_LDA(At, 0, 0); PG8_STAGE(PG8_SA(1, 1), a1 + hstepA, voffA);
            PG8_WAIT_V(8); PG8_WAIT_L(0); PG8_BAR; PG8_MMA(0, 0, At, B0); PG8_MMA(0, 1, At, B1); PG8_BAR; PG8_SCHED;
            PG8_LDA(At, 0, 1); PG8_STAGE(PG8_SB(0, 0), b2, voffB); PG8_STAGE(PG8_SB(0, 1), b2 + hstepB, voffB); PG8_STAGE(PG8_SA(0, 0), a2, voffA);
            PG8_WAIT_V(8); PG8_WAIT_L(0); PG8_BAR; PG8_MMA(1, 0, At, B0); PG8_MMA(1, 1, At, B1); PG8_BAR; PG8_SCHED;
            PG8_LDB(B0, 1, 0); PG8_LDB(B1, 1, 1); PG8_SCHED; PG8_LDA(At, 1, 0); PG8_STAGE(PG8_SA(0, 1), a2 + hstepA, voffA);
            PG8_WAIT_V(8); PG8_WAIT_L(0); PG8_BAR; PG8_MMA(0, 0, At, B0); PG8_MMA(0, 1, At, B1); PG8_BAR; PG8_SCHED;
            PG8_LDA(At, 1, 1); PG8_STAGE(PG8_SB(1, 0), b3, voffB); PG8_STAGE(PG8_SB(1, 1), b3 + hstepB, voffB); PG8_STAGE(PG8_SA(1, 0), a3, voffA);
            PG8_WAIT_V(8); PG8_WAIT_L(0); PG8_BAR; PG8_MMA(1, 0, At, B0); PG8_MMA(1, 1, At, B1); PG8_BAR; PG8_SCHED;
        }
        if (wr == 0) PG8_BAR;
        E(acc, cur, wr, wc, fr, fq);
        if (!has_next) break;
#pragma unroll
        for (int a = 0; a < 2; ++a)
#pragma unroll
            for (int b = 0; b < 2; ++b)
#pragma unroll
                for (int m = 0; m < 4; ++m)
#pragma unroll
                    for (int n = 0; n < 2; ++n) acc[a][b][m][n] = (f32x4){0.f, 0.f, 0.f, 0.f};
        cur = nxt; cA = nA; cB = nB; ++ui;
        if (wr == 1) PG8_BAR;
    }
    PG8_WAIT_V(0);
    PG8_BAR;
#undef PG8_SA
#undef PG8_SB
#undef PG8_STAGE
#undef PG8_LDA
#undef PG8_LDB
#undef PG8_MMA
#undef PG8_WAIT_V
#undef PG8_WAIT_L
#undef PG8_BAR
#undef PG8_SCHED
#undef PG8_ATILE
}
}

namespace att {
constexpr int D = 128, NW = 8, QBLK = 32, KVBLK = 64, QB = NW * QBLK;
constexpr int SHM_V = KVBLK * D * 2, SHM_K = KVBLK * D * 2;
constexpr int OFF_WS = 2 * SHM_V + 2 * SHM_K, OFF_G = OFF_WS + NW * 64 * 4, ATT_LDS = OFF_G + 512;
constexpr float SCALE = 0.08838834764831845f, C2 = 1.4426950408889634f * SCALE, THR2 = 24.f;
#define KSWZ(row, colB) ((row) * 256 + ((colB) ^ (((row) & 7) << 4)))
#define SBAR() __builtin_amdgcn_sched_barrier(0)
__device__ __forceinline__ int v_st(int k, int c) { const int kk = (k & ~0xC) | ((k & 4) << 1) | ((k & 8) >> 1); return ((kk >> 3) * 4 + (c >> 5)) * 512 + ((kk & 7) * 32 + (c & 31)) * 2; }
__device__ __forceinline__ int v_rd_base(int lane) { return ((lane & 3) << 3) | (((lane >> 2) & 3) << 6) | (((lane >> 4) & 1) << 5) | (((lane >> 5) & 1) << 8); }
constexpr int v_rd_off(int d0, int ks, int half) { return d0 * 512 + ks * 4096 + half * 2048; }
__device__ __forceinline__ int crow(int r, int hi) { return (r & 3) + 8 * (r >> 2) + 4 * hi; }
__device__ __forceinline__ bf16x8 load8(const bf16_t* p) { return *reinterpret_cast<const bf16x8*>(p); }
__device__ __forceinline__ void mask_tile(f32x16& p0, f32x16& p1, int dq, unsigned W) {
    const float NEG = -__builtin_inff();
#pragma unroll
    for (int r = 0; r < 16; ++r) {
        const int c = (r & 3) + 8 * (r >> 2);
        if ((unsigned)(dq - c) >= W) p0[r] = NEG;
        if ((unsigned)(dq - c - 32) >= W) p1[r] = NEG;
    }
}
__device__ __forceinline__ void partialSM(f32x16& p0, f32x16& p1, float& m_reg, float& mn, float& alpha) {
    float pmax = p0[0];
#pragma unroll
    for (int r = 1; r < 16; ++r) pmax = fmaxf(pmax, p0[r]);
#pragma unroll
    for (int r = 0; r < 16; ++r) pmax = fmaxf(pmax, p1[r]);
    { auto rr = __builtin_amdgcn_permlane32_swap(__float_as_uint(pmax), __float_as_uint(pmax), false, false);
      pmax = fmaxf(__uint_as_float(rr[0]), __uint_as_float(rr[1])); }
    if (__builtin_expect(__all((pmax - m_reg) * C2 <= THR2), 1)) { mn = m_reg; alpha = 1.f; }
    else { mn = fmaxf(m_reg, pmax); alpha = __builtin_amdgcn_exp2f((m_reg - mn) * C2); m_reg = mn; }
    const float mnL = -mn * C2;
#pragma unroll
    for (int r = 0; r < 16; ++r) { p0[r] = fmaf(p0[r], C2, mnL); p1[r] = fmaf(p1[r], C2, mnL); }
#pragma unroll
    for (int r = 0; r < 16; ++r) p0[r] = __builtin_amdgcn_exp2f(p0[r]);
}
__device__ __forceinline__ void finishSM(f32x16& p0, f32x16& p1, float alpha, float& l_reg, bf16x8& pa0, bf16x8& pa1, bf16x8& pa2, bf16x8& pa3) {
#pragma unroll
    for (int r = 0; r < 16; ++r) p1[r] = __builtin_amdgcn_exp2f(p1[r]);
    float ps = 0;
#pragma unroll
    for (int r = 0; r < 16; ++r) ps += p0[r];
#pragma unroll
    for (int r = 0; r < 16; ++r) ps += p1[r];
    { auto rr = __builtin_amdgcn_permlane32_swap(__float_as_uint(ps), __float_as_uint(ps), false, false);
      ps = __uint_as_float(rr[0]) + __uint_as_float(rr[1]); }
    l_reg = l_reg * alpha + ps;
#define PK4(P, B_, OUT) do { unsigned a0 = cvt_pk_bf16(P[B_+0], P[B_+1]), a1 = cvt_pk_bf16(P[B_+2], P[B_+3]);                          \
        unsigned b0 = cvt_pk_bf16(P[B_+4], P[B_+5]), b1 = cvt_pk_bf16(P[B_+6], P[B_+7]);                                             \
        auto r0 = __builtin_amdgcn_permlane32_swap(a0, b0, false, false); auto r1 = __builtin_amdgcn_permlane32_swap(a1, b1, false, false); \
        u32x4 w = {r0[0], r1[0], r0[1], r1[1]}; OUT = *reinterpret_cast<bf16x8*>(&w); } while (0)
    PK4(p0, 0, pa0); PK4(p0, 8, pa1); PK4(p1, 0, pa2); PK4(p1, 8, pa3);
#undef PK4
}
template <int KB>
__device__ __forceinline__ void qkt(f32x16& p0, f32x16& p1, const char* K_lds, int r32, int hi, const bf16x8* qr, const float* gl) {
#pragma unroll
    for (int i = 0; i < 4; ++i) { const f32x4 g0 = *(const f32x4*)(gl + 8 * i + 4 * hi), g1 = *(const f32x4*)(gl + 32 + 8 * i + 4 * hi);
#pragma unroll
        for (int j = 0; j < 4; ++j) { p0[4 * i + j] = g0[j]; p1[4 * i + j] = g1[j]; } }
    const char* kb[4];
#pragma unroll
    for (int dd = 0; dd < 4; ++dd) kb[dd] = K_lds + KB * SHM_K + KSWZ(r32, (dd * 16 + hi * 8) * 2);
#pragma unroll
    for (int d0 = 0; d0 < 8; ++d0) { const char* a = kb[d0 & 3] + (d0 >> 2) * 128;
        bf16x8 b0 = *reinterpret_cast<const bf16x8*>(a);
        bf16x8 b1 = *reinterpret_cast<const bf16x8*>(a + 32 * 256);
        p0 = __builtin_amdgcn_mfma_f32_32x32x16_bf16(b0, qr[d0], p0, 0, 0, 0);
        p1 = __builtin_amdgcn_mfma_f32_32x32x16_bf16(b1, qr[d0], p1, 0, 0, 0); }
}
template <int VB>
__device__ __forceinline__ void pv_tile(f32x16* o, int vb0, bf16x8 pa0, bf16x8 pa1, bf16x8 pa2, bf16x8 pa3) {
#define TRRD(dst, off) asm volatile("ds_read_b64_tr_b16 %0, %1 offset:%2" : "=&v"(dst) : "v"(vb0), "i"(off) : "memory")
#define PV_D0(d0) do { s16x4 l0, l1, l2, l3, h0, h1, h2, h3; constexpr int b_ = VB * SHM_V + v_rd_off(d0, 0, 0); \
        TRRD(l0, b_); TRRD(h0, b_ + 2048); TRRD(l1, b_ + 4096); TRRD(h1, b_ + 6144); TRRD(l2, b_ + 8192); TRRD(h2, b_ + 10240); TRRD(l3, b_ + 12288); TRRD(h3, b_ + 14336); \
        asm volatile("s_waitcnt lgkmcnt(0)" ::: "memory"); SBAR();   \
        o[d0] = __builtin_amdgcn_mfma_f32_32x32x16_bf16(pa0, (bf16x8){l0[0], l0[1], l0[2], l0[3], h0[0], h0[1], h0[2], h0[3]}, o[d0], 0, 0, 0);   \
        o[d0] = __builtin_amdgcn_mfma_f32_32x32x16_bf16(pa1, (bf16x8){l1[0], l1[1], l1[2], l1[3], h1[0], h1[1], h1[2], h1[3]}, o[d0], 0, 0, 0);   \
        o[d0] = __builtin_amdgcn_mfma_f32_32x32x16_bf16(pa2, (bf16x8){l2[0], l2[1], l2[2], l2[3], h2[0], h2[1], h2[2], h2[3]}, o[d0], 0, 0, 0);   \
        o[d0] = __builtin_amdgcn_mfma_f32_32x32x16_bf16(pa3, (bf16x8){l3[0], l3[1], l3[2], l3[3], h3[0], h3[1], h3[2], h3[3]}, o[d0], 0, 0, 0); } while (0)
    PV_D0(0); PV_D0(1); PV_D0(2); PV_D0(3);
#undef PV_D0
#undef TRRD
}
struct BlockRef { const bf16_t* Q; const bf16_t* K; const bf16_t* V; const float* G; bf16_t* O; int P0, jlo; };
struct Seam { bf16x8 qr[8]; bf16x8 st_v0, st_v1, st_k0, st_k1; float sg; };
#define ROW(p, k0, rr) ((p) + (size_t)((k0) + (rr)) * D + sc)
#define VMW() asm volatile("s_waitcnt vmcnt(0)" ::: "memory")
#define VMWN(n) asm volatile("s_waitcnt vmcnt(%0)" :: "i"(n) : "memory")
#define SLOAD_H(Kp, Vp, Gp, k0) do { S.st_v0 = load8(ROW(Vp, k0, sr)); S.st_v1 = load8(ROW(Vp, k0, 32 + sr));              \
                         S.st_k0 = load8(ROW(Kp, k0, sr)); S.st_k1 = load8(ROW(Kp, k0, 32 + sr)); S.sg = (Gp)[(k0) + (tid & 63)]; } while (0)
#define SWRITE_HK(bf) do { *(bf16x8*)(K_lds + (bf) * SHM_K + kws) = S.st_k0; *(bf16x8*)(K_lds + (bf) * SHM_K + kws + 32 * 256) = S.st_k1; \
                           if (tid < 64) G_lds[(bf) * 64 + tid] = S.sg; } while (0)
#define SWRITE_HV(bf) do { *(bf16x8*)(V_lds + (bf) * SHM_V + vst0) = S.st_v0; *(bf16x8*)(V_lds + (bf) * SHM_V + vst1) = S.st_v1; } while (0)
#define SWRITE_H(bf) do { SWRITE_HV(bf); SWRITE_HK(bf); } while (0)
__device__ __forceinline__ void prime(const BlockRef& cur, char* lds, Seam& S, int wv) {
    const int tid = otid(wv), wid = __builtin_amdgcn_readfirstlane(tid >> 6), lane = tid & 63, r32 = lane & 31, hi = lane >> 5;
    const int sr = tid >> 4, sc = (tid & 15) * 8, kws = KSWZ(sr, sc * 2); char* K_lds = lds + 2 * SHM_V; float* G_lds = (float*)(lds + OFF_G);
#pragma unroll
    for (int d0 = 0; d0 < 8; ++d0) S.qr[d0] = load8(cur.Q + (size_t)(wid * QBLK + r32) * D + d0 * 16 + hi * 8);
    SLOAD_H(cur.K, cur.V, cur.G, cur.jlo * KVBLK); VMW(); SWRITE_HK(0);
    __syncthreads();
}
__device__ __forceinline__ void block(const BlockRef& cur, const BlockRef& nxt, char* lds, Seam& S, int wv) {
    const int tid = otid(wv), wid = __builtin_amdgcn_readfirstlane(tid >> 6), lane = tid & 63, r32 = lane & 31, hi = lane >> 5;
    const int W = SEQ;
    const int j_hi = (cur.P0 + QB - 1) / KVBLK + 1;
    const int j_lo = cur.jlo, NT = j_hi - j_lo, kbn = nxt.jlo * KVBLK;
    const int qlo = cur.P0 + wid * QBLK, qm = qlo + r32 - 4 * hi;
    char* V_lds = lds; char* K_lds = lds + 2 * SHM_V; float* G_lds = (float*)(lds + OFF_G);
    float* ws = (float*)(lds + OFF_WS) + wid * 64; float* li_l = ws, * al_l = ws + 32;
    float m_reg = -1e30f, l_reg = 0; f32x16 o[4] = {};
    const int sr = tid >> 4, sc = (tid & 15) * 8, vst0 = v_st(sr, sc), vst1 = v_st(32 + sr, sc), kws = KSWZ(sr, sc * 2);
    const int vb0 = (int)(uintptr_t)V_lds + v_rd_base(lane);
    const bf16_t* Kh = cur.K; const bf16_t* Vh = cur.V; const float* Gh = cur.G;
#define RESC(a) do { if (__any((a) < 1.f)) { if (hi == 0) al_l[r32] = (a); asm volatile("s_waitcnt lgkmcnt(0)" ::: "memory");              \
                     _Pragma("unroll") for (int d_ = 0; d_ < 4; ++d_) _Pragma("unroll") for (int r = 0; r < 16; ++r) o[d_][r] *= al_l[crow(r, hi)]; } } while (0)
#define KBASE(t) ((j_lo + (t)) * KVBLK)
#define MASKT(P0_, P1_, t) do { const int kb_ = KBASE(t); if (kb_ + KVBLK - 1 > qlo) mask_tile(P0_, P1_, qm - kb_, (unsigned)W); } while (0)
    constexpr int NQL = 8;
#define SEAM_K0() do { VMWN(NQL); SWRITE_HK(0); SBAR(); } while (0)
    f32x16 pA0, pA1, pB0, pB1; float mnA, mnB, alA, alB; bf16x8 pa0, pa1, pa2, pa3;
    SWRITE_HV(0); SBAR();
    if (NT > 1) SLOAD_H(Kh, Vh, Gh, KBASE(1));
    SBAR(); qkt<0>(pA0, pA1, K_lds, r32, hi, S.qr, G_lds);
    MASKT(pA0, pA1, 0); partialSM(pA0, pA1, m_reg, mnA, alA);
    if (NT > 1) { VMW(); SWRITE_H(1); }
    __syncthreads();
#define HALF_STEP(PX0, PX1, mnX, alX, PY0, PY1, alY, t, KB, VB, SB) do {                                                      \
        SBAR(); qkt<KB>(PX0, PX1, K_lds, r32, hi, S.qr, G_lds + (KB) * 64);                                             \
        finishSM(PY0, PY1, alY, l_reg, pa0, pa1, pa2, pa3); SBAR();                                                           \
        if ((t) + 1 < NT) { SLOAD_H(Kh, Vh, Gh, KBASE((t) + 1)); SBAR(); }                                               \
        pv_tile<VB>(o, vb0, pa0, pa1, pa2, pa3); MASKT(PX0, PX1, (t)); partialSM(PX0, PX1, m_reg, mnX, alX);                                        \
        __syncthreads();                                                                                                      \
        if ((t) + 1 < NT) { VMW(); SWRITE_H(SB); }                                                                          \
        RESC(alX); __syncthreads(); } while (0)
    for (int t = 1; t + 1 < NT; t += 2) {
        HALF_STEP(pB0, pB1, mnB, alB, pA0, pA1, alA, t, 1, 0, 0);
        HALF_STEP(pA0, pA1, mnA, alA, pB0, pB1, alB, t + 1, 0, 1, 1);
    }
    const bool even = (NT & 1) == 0;
    if (even) { SBAR(); qkt<1>(pB0, pB1, K_lds, r32, hi, S.qr, G_lds + 64); SBAR(); }
    SLOAD_H(nxt.K, nxt.V, nxt.G, kbn); SBAR();
#pragma unroll
    for (int d0 = 0; d0 < 8; ++d0) S.qr[d0] = load8(nxt.Q + (size_t)(wid * QBLK + r32) * D + d0 * 16 + hi * 8);
    SBAR();
    finishSM(pA0, pA1, alA, l_reg, pa0, pa1, pa2, pa3); SBAR();
    pv_tile<0>(o, vb0, pa0, pa1, pa2, pa3);
    if (even) { MASKT(pB0, pB1, NT - 1); partialSM(pB0, pB1, m_reg, mnB, alB); __syncthreads(); RESC(alB);
        finishSM(pB0, pB1, alB, l_reg, pa0, pa1, pa2, pa3); SBAR(); pv_tile<1>(o, vb0, pa0, pa1, pa2, pa3); }
    SBAR(); SEAM_K0();
    if (hi == 0) li_l[r32] = l_reg; asm volatile("s_waitcnt lgkmcnt(0)" ::: "memory");
    float rli[16];
#pragma unroll
    for (int r = 0; r < 16; ++r) rli[r] = __builtin_amdgcn_rcpf(li_l[crow(r, hi)]);
    bf16_t* Ow = cur.O + (size_t)(wid * QBLK) * D;
#pragma unroll
    for (int r = 0; r < 16; ++r) { const int orow = crow(r, hi);
#pragma unroll
        for (int d0 = 0; d0 < 4; ++d0) { const float v = o[d0][r] * rli[r];
            const float vn = __shfl_xor(v, 1);
            if ((r32 & 1) == 0) *(unsigned*)(Ow + (size_t)orow * D + d0 * 32 + r32) = cvt_pk_bf16(v, vn); } }
    __syncthreads();
#undef RESC
#undef KBASE
#undef MASKT
#undef SEAM_K0
#undef HALF_STEP
}
#undef ROW
#undef VMW
#undef VMWN
#undef SLOAD_H
#undef SWRITE_HK
#undef SWRITE_HV
#undef SWRITE_H
struct Item { int bh, qb0, qb1; };
__device__ __forceinline__ Item decode(int L) {
    const int c = L & 255, i = L >> 8, xcd = c & 7, cc = c >> 3, gi = (cc & 1) + 2 * i, qb = ((cc >> 1) + 2 * i + (i >> 2)) & 15;
    Item it; it.bh = ((xcd - gi) & 7) * 16 + gi; it.qb0 = qb; it.qb1 = qb; return it;
}
__device__ __forceinline__ BlockRef mkref(const Item& it, int pass, const bf16_t* Q, const bf16_t* K, const bf16_t* V, const float* G, const int* JLO, bf16_t* O, bf16_t* Odummy, bool dummy) {
    const int qb = pass ? it.qb1 : it.qb0; BlockRef r;
    r.Q = Q + ((size_t)it.bh * SEQ + (size_t)qb * QB) * D; r.O = dummy ? Odummy : O + ((size_t)it.bh * SEQ + (size_t)qb * QB) * D;
    r.K = K + (size_t)it.bh * SEQ * D; r.V = V + (size_t)it.bh * SEQ * D; r.G = G + (size_t)it.bh * SEQ; r.P0 = qb * QB; r.jlo = JLO[it.bh * 16 + qb]; return r;
}
__device__ __forceinline__ void phase(char* lds, const bf16_t* Q, const bf16_t* K, const bf16_t* V, const float* G, const int* JLO, bf16_t* O, bf16_t* Odummy, int total, int wv) {
    const int stride = gridDim.x;
    int L = blockIdx.x; if (L >= total) return;
    Item it = decode(L); int pass = 0;
    BlockRef cur = mkref(it, 0, Q, K, V, G, JLO, O, Odummy, false);
    Seam S;
    prime(cur, lds, S, wv);
    for (;;) {
        const bool more_pass = pass == 0 && it.qb1 != it.qb0, more_item = L + stride < total, last = !more_pass && !more_item;
        Item itn = it; int passn = pass + 1, Ln = L;
        if (!more_pass) { passn = 0; Ln = more_item ? L + stride : L; itn = decode(Ln); }
        const BlockRef nxt = last ? cur : mkref(itn, passn, Q, K, V, G, JLO, O, Odummy, false);
        block(cur, nxt, lds, S, wv);
        if (last) break;
        cur = nxt; it = itn; pass = passn; L = Ln;
    }
}
#undef SBAR
}

struct Args {
    const float *x, *c, *mod_w, *mod_b, *norm_g, *a_w_in, *a_lb, *a_onorm_g, *a_w_out, *kv_mod_w, *kv_mod_b, *kv_norm_g, *kv_w, *kv_fb, *k_norm_g, *b_w_in, *b_q_norm_g, *b_w_out;
    float* out; unsigned char* ws; int one, pad;
};

__device__ __forceinline__ void transpose_item(const float* W, int K, int ldw, int N, bf16_t* WT, float* scr, int item, int lane) {
    const int nblk = N / 32, kb = item / nblk, nb = item % nblk, k0 = 64 * kb, n0 = 32 * nb;
#pragma unroll 8
    for (int i = 0; i < 32; ++i) { const int kk = 2 * i + (lane >> 5); scr[kk * 33 + (lane & 31)] = W[(size_t)(k0 + kk) * ldw + n0 + (lane & 31)]; }
    asm volatile("s_waitcnt lgkmcnt(0)" ::: "memory");
    const int c = lane & 7;
#pragma unroll
    for (int j = 0; j < 4; ++j) { const int n = (lane >> 3) + 8 * j; const float* s = scr + (8 * c) * 33 + n;
        u32x4 o; o.x = cvt_pk_bf16(s[0 * 33], s[1 * 33]); o.y = cvt_pk_bf16(s[2 * 33], s[3 * 33]); o.z = cvt_pk_bf16(s[4 * 33], s[5 * 33]); o.w = cvt_pk_bf16(s[6 * 33], s[7 * 33]);
        *(u32x4*)(WT + (size_t)(n0 + n) * K + k0 + 8 * c) = o; }
    asm volatile("s_waitcnt lgkmcnt(0)" ::: "memory");
}

__device__ __forceinline__ void p0_prologue(const Args& a, char* lds, int wv) {
    const int tid = otid(wv), lane = tid & 63, wave = tid >> 6, G = gridDim.x;
    unsigned char* ws = a.ws;
    float* sc = (float*)lds;
    float* red = (float*)(lds + 32768);
    for (int i = tid; i < NB * DM; i += 512) sc[i] = silu_f(a.c[i]);
    __syncthreads();
    for (int cgp = blockIdx.x; cgp < 256; cgp += G) {
        const int n0 = cgp * 32; const float* Wm; const float* bias; float* outp; int ldn, nloc;
        if (n0 < 3072) { Wm = a.mod_w; bias = a.mod_b; outp = (float*)(ws + WS_MOD0); ldn = 3072; nloc = n0; }
        else if (n0 < 6144) { Wm = a.mod_w + (size_t)DM * 3072; bias = a.mod_b + 3072; outp = (float*)(ws + WS_MOD1); ldn = 3072; nloc = n0 - 3072; }
        else { Wm = a.kv_mod_w; bias = a.kv_mod_b; outp = (float*)(ws + WS_KVMOD); ldn = 2048; nloc = n0 - 6144; }
        const int col = lane & 31, ksub = wave * 2 + (lane >> 5);
        float accb[8];
#pragma unroll
        for (int b = 0; b < 8; ++b) accb[b] = 0.f;
#pragma unroll 8
        for (int kk = 0; kk < 64; ++kk) { const int k = ksub * 64 + kk; const float w = Wm[(size_t)k * ldn + nloc + col];
#pragma unroll
            for (int b = 0; b < 8; ++b) accb[b] = fmaf(sc[b * DM + k], w, accb[b]); }
#pragma unroll
        for (int b = 0; b < 8; ++b) red[(ksub * 8 + b) * 32 + col] = accb[b];
        __syncthreads();
        if (tid < 256) { const int b = tid >> 5, cc = tid & 31; float s = bias[nloc + cc];
#pragma unroll
            for (int j = 0; j < 16; ++j) s += red[(j * 8 + b) * 32 + cc];
            outp[(size_t)b * ldn + nloc + cc] = s; }
        __syncthreads();
    }
    const int gtid = blockIdx.x * 512 + tid, NT = G * 512;
    for (int j = gtid; j < WD; j += NT) ((float*)(ws + WS_LB))[j] = 1.f / (1.f + __expf(a.a_lb[WD + j] - a.a_lb[j]));
    for (int i = gtid; i < NH * DM; i += NT) { const int h = i >> 10, k = i & 1023; ((float*)(ws + WS_WFL))[i] = a.kv_w[(size_t)k * 4112 + 4096 + h]; }
    __syncthreads();
    float* scr = (float*)(lds + wave * 16384);
    const int gw = blockIdx.x * 8 + wave, NGW = G * 8;
    constexpr int I1 = 16 * 256, I2 = 32 * 32, I3 = 16 * 128, I4 = 16 * 128, I5 = 32 * 32, NIT = I1 + I2 + I3 + I4 + I5;
    for (int it = gw; it < NIT; it += NGW) {
        int r = it;
        if (r < I1) { transpose_item(a.a_w_in, 1024, 8192, 8192, (bf16_t*)(ws + WS_W1), scr, r, lane); continue; } r -= I1;
        if (r < I2) { transpose_item(a.a_w_out, 2048, 1024, 1024, (bf16_t*)(ws + WS_W2), scr, r, lane); continue; } r -= I2;
        if (r < I3) { transpose_item(a.kv_w, 1024, 4112, 4096, (bf16_t*)(ws + WS_W3KV), scr, r, lane); continue; } r -= I3;
        if (r < I4) { transpose_item(a.b_w_in, 1024, 4096, 4096, (bf16_t*)(ws + WS_W3Q), scr, r, lane); continue; } r -= I4;
        transpose_item(a.b_w_out, 2048, 1024, 1024, (bf16_t*)(ws + WS_W4), scr, r, lane);
    }
}

template <bool FL, bool DUAL>
__device__ __forceinline__ void norm_phase(const float* x, const float* g, const float* shiftp, const float* scalep, int mstride, bf16_t* outp,
                                           const float* g2, const float* shiftp2, const float* scalep2, int mstride2, bf16_t* outp2,
                                           const float* wfl_g, const float* fb, float* LS, char* lds, int wv) {
    const int tid = otid(wv), lane = tid & 63, wave = tid >> 6;
    float* wfl = (float*)lds;
    if (FL) { for (int i = tid; i < NH * DM / 4; i += 512) ((f32x4*)wfl)[i] = ((const f32x4*)wfl_g)[i]; __syncthreads(); }
    const int gw = blockIdx.x * 8 + wave, NGW = gridDim.x * 8, rpw = (((TOK + NGW - 1) / NGW) + 3) & ~3;
    int curb = -1; f32x4 al[4], be[4], al2[4], be2[4];
    for (int i0 = 0; i0 < rpw; i0 += 4) {
        const int m0 = gw * rpw + i0; if (m0 >= TOK) break;
        const int b = m0 >> 12;
        if (b != curb) { curb = b;
#pragma unroll
            for (int j = 0; j < 4; ++j) { const int col = 4 * lane + 256 * j; const f32x4 gg = *(const f32x4*)(g + col), sc = *(const f32x4*)(scalep + (size_t)b * mstride + col);
                al[j] = gg * (sc + 1.f); be[j] = *(const f32x4*)(shiftp + (size_t)b * mstride + col);
                if (DUAL) { const f32x4 gg2 = *(const f32x4*)(g2 + col), sc2 = *(const f32x4*)(scalep2 + (size_t)b * mstride2 + col);
                    al2[j] = gg2 * (sc2 + 1.f); be2[j] = *(const f32x4*)(shiftp2 + (size_t)b * mstride2 + col); } } }
        f32x4 v[4][4];
#pragma unroll
        for (int q = 0; q < 4; ++q) { const f32x4* xr = (const f32x4*)(x + (size_t)(m0 + q) * DM) + lane;
#pragma unroll
            for (int j = 0; j < 4; ++j) v[q][j] = xr[64 * j]; }
#pragma unroll
        for (int q = 0; q < 4; ++q) { float s2 = 0.f;
#pragma unroll
            for (int j = 0; j < 4; ++j) s2 += (v[q][j].x * v[q][j].x + v[q][j].y * v[q][j].y) + (v[q][j].z * v[q][j].z + v[q][j].w * v[q][j].w);
            const float rstd = __builtin_amdgcn_rsqf(wave_sum(s2) * (1.f / DM) + EPS);
            unsigned long long* o8 = (unsigned long long*)(outp + (size_t)(m0 + q) * DM) + lane;
            unsigned long long* o82 = (unsigned long long*)(outp2 + (size_t)(m0 + q) * DM) + lane;
#pragma unroll
            for (int j = 0; j < 4; ++j) { const f32x4 xh = v[q][j] * rstd;
                if (DUAL) { const f32x4 w2 = xh * al2[j] + be2[j];
                    o82[64 * j] = (unsigned long long)cvt_pk_bf16(w2.x, w2.y) | ((unsigned long long)cvt_pk_bf16(w2.z, w2.w) << 32); }
                v[q][j] = xh * al[j] + be[j];
                o8[64 * j] = (unsigned long long)cvt_pk_bf16(v[q][j].x, v[q][j].y) | ((unsigned long long)cvt_pk_bf16(v[q][j].z, v[q][j].w) << 32); } }
        if (FL) {
            float mine[4] = {0.f, 0.f, 0.f, 0.f};
#pragma unroll 2
            for (int h = 0; h < NH; ++h) { f32x4 w[4];
#pragma unroll
                for (int j = 0; j < 4; ++j) w[j] = *(const f32x4*)(wfl + h * DM + 4 * lane + 256 * j);
#pragma unroll
                for (int q = 0; q < 4; ++q) { float p = 0.f;
#pragma unroll
                    for (int j = 0; j < 4; ++j) p += (v[q][j].x * w[j].x + v[q][j].y * w[j].y) + (v[q][j].z * w[j].z + v[q][j].w * w[j].w);
                    p = wave_sum(p); if (lane == h) mine[q] = p; } }
            if (lane < NH) { const float fbv = fb[lane];
#pragma unroll
                for (int q = 0; q < 4; ++q) { const float z = mine[q] + fbv; const float ls = z < 0.f ? z - log1pf(__expf(z)) : -log1pf(__expf(-z));
                    LS[(size_t)(b * NH + lane) * SEQ + ((m0 + q) & (SEQ - 1))] = ls; } }
        }
    }
}

__device__ __forceinline__ void cumsum_phase(float* LS, int* JLO, const float* kg, const float* qg, char* lds, int wv) {
    const int tid = otid(wv), lane = tid & 63, wave = tid >> 6; float* wtot = (float*)lds; float* gl = (float*)(lds + 1024);
    float mk = fmaxf(fabsf(kg[lane]), fabsf(kg[lane + 64])), mq = fmaxf(fabsf(qg[lane]), fabsf(qg[lane + 64]));
#pragma unroll
    for (int o = 1; o < 64; o <<= 1) { mk = fmaxf(mk, __shfl_xor(mk, o)); mq = fmaxf(mq, __shfl_xor(mq, o)); }
    const float TH = (40.f + 2.f * (1.05f * 128.f * 1.4426950408889634f * 0.08838834764831845f * mk * mq)) / (1.4426950408889634f * 0.08838834764831845f);
    for (int bh = blockIdx.x; bh < BH; bh += gridDim.x) {
        float* p = LS + (size_t)bh * SEQ + tid * 8; f32x4 a = *(f32x4*)p, b = *(f32x4*)(p + 4);
        float v[8] = {a.x, a.y, a.z, a.w, b.x, b.y, b.z, b.w};
#pragma unroll
        for (int i = 1; i < 8; ++i) v[i] += v[i - 1];
        float run = v[7];
#pragma unroll
        for (int o = 1; o < 64; o <<= 1) { const float t = __shfl_up(run, o); if (lane >= o) run += t; }
        if (lane == 63) wtot[wave] = run;
        __syncthreads();
        float off = run - v[7];
        for (int w = 0; w < wave; ++w) off += wtot[w];
        const float k = -11.313708498984761f;
        a = (f32x4){(v[0] + off) * k, (v[1] + off) * k, (v[2] + off) * k, (v[3] + off) * k}; b = (f32x4){(v[4] + off) * k, (v[5] + off) * k, (v[6] + off) * k, (v[7] + off) * k};
        *(f32x4*)p = a; *(f32x4*)(p + 4) = b;
        *(f32x4*)(gl + tid * 8) = a; *(f32x4*)(gl + tid * 8 + 4) = b;
        __syncthreads();
#pragma unroll
        for (int rep = 0; rep < 2; ++rep) { const int qb = wave + 8 * rep, P0 = qb * 256;
            const bool skip = (64 * lane + 63 < P0) && (gl[P0] - gl[64 * lane + 63] > TH);
            const unsigned long long mask = __ballot(skip);
            if (lane == 0) JLO[bh * 16 + qb] = __popcll(mask); }
        __syncthreads();
    }
}

__device__ __forceinline__ void p4_scan(const Args& a, char* lds, int dry, int wv, unsigned* prog) {
    const int tid = otid(wv), lane = tid & 63, w = tid >> 6, r = lane & 15, gq = lane >> 4, vg = w & 3, kh = w >> 2;
    unsigned char* ws = a.ws;
    bf16_t* R0 = (bf16_t*)(ws + WS_R0); const bf16_t* R1 = (const bf16_t*)(ws + WS_R1); const bf16_t* R2 = (const bf16_t*)(ws + WS_R2);
    const float* LB = (const float*)(ws + WS_LB);
    constexpr int BUF = 45568, O_QD = 0, O_KT = 17408, O_AT = 35840, O_DL = 45056, O_XS = 2 * BUF, O_PART = O_XS + 32768, O_V = O_PART + 2048;
    typedef short v4i16_t __attribute__((ext_vector_type(4)));
    const LAS char* const vtr0 = (const LAS char*)(LAS unsigned char*)(lds) + O_V + (8 * gq + (r >> 2)) * 272 + (32 * vg + 4 * (r & 3)) * 2;
    const int pk0 = 4 * (tid & 31), prg = tid >> 5, pc0 = 4 * prg;
    bf16_t* const tf = (bf16_t*)(lds + O_V);
    for (int bh = blockIdx.x; bh < BH; bh += gridDim.x) {
        const int h = bh & 15;
        const f32x4 og0 = *(const f32x4*)(a.a_onorm_g + h * HD + 32 * vg + 4 * gq), og1 = *(const f32x4*)(a.a_onorm_g + h * HD + 32 * vg + 16 + 4 * gq);
        const f32x4 lbv4 = *(const f32x4*)(LB + h * HD + pk0), om4 = 1.f - lbv4;
        f32x4 st[4][2];
#pragma unroll
        for (int i = 0; i < 4; ++i) { st[i][0] = (f32x4){0.f, 0.f, 0.f, 0.f}; st[i][1] = (f32x4){0.f, 0.f, 0.f, 0.f}; }
        u32x2 sqA[4], sfA[4], sqB[4], sfB[4]; u32x4 svA[2], svB[2]; bf16x8 vb[2][2];
        char* const xs_own = lds + O_XS + w * 4096 + lane * 16; const char* const xs_par = lds + O_XS + (w ^ 4) * 4096 + lane * 16;
        { const u32x4 z = {0u, 0u, 0u, 0u};
#pragma unroll
          for (int f = 0; f < 4; ++f) *(u32x4*)(xs_own + f * 1024) = z; }
#define P4_LOAD(X, n_) do { const size_t blk_ = ((size_t)bh * SEQ + (size_t)(n_) * 64) * HD; \
            _Pragma("unroll") for (int i = 0; i < 4; ++i) { sq##X[i] = *(const u32x2*)(R0 + blk_ + (size_t)(pc0 + i) * HD + pk0); sf##X[i] = *(const u32x2*)(R1 + blk_ + (size_t)(pc0 + i) * HD + pk0); } \
            _Pragma("unroll") for (int rep = 0; rep < 2; ++rep) { const int i = tid + rep * 512; sv##X[rep] = *(const u32x4*)(R2 + blk_ + (size_t)i * 8); } } while (0)
#define P4_WRITE_V(X) do { _Pragma("unroll") for (int rep = 0; rep < 2; ++rep) { const int i = tid + rep * 512; *(u32x4*)(lds + O_V + (i >> 4) * 272 + (i & 15) * 16) = sv##X[rep]; } } while (0)
#define P4_PACK(DST, ksl, vt) do { u32x4 bw_; bw_.x = cvt_pk_bf16(st[2 * (ksl)][vt][0], st[2 * (ksl)][vt][1]); bw_.y = cvt_pk_bf16(st[2 * (ksl)][vt][2], st[2 * (ksl)][vt][3]); \
            bw_.z = cvt_pk_bf16(st[2 * (ksl) + 1][vt][0], st[2 * (ksl) + 1][vt][1]); bw_.w = cvt_pk_bf16(st[2 * (ksl) + 1][vt][2], st[2 * (ksl) + 1][vt][3]); DST = bw_; } while (0)
#define P4_PREP(X, bf_, PUB) do { char* B_ = lds + (bf_) * BUF; bf16_t* tq = (bf16_t*)(B_ + O_QD); float* part2 = (float*)(B_ + O_AT); \
              \
            float ee[4][4]; f32x4 kq_[4]; f32x4 run = {1.f, 1.f, 1.f, 1.f}; \
            _Pragma("unroll") for (int i = 0; i < 4; ++i) { const u32x2 wz = sf##X[i]; \
                const f32x4 fz = {__uint_as_float(wz.x << 16), __uint_as_float(wz.x & 0xffff0000u), __uint_as_float(wz.y << 16), __uint_as_float(wz.y & 0xffff0000u)}; \
                _Pragma("unroll") for (int j = 0; j < 4; ++j) { const float sg = __builtin_amdgcn_rcpf(1.f + __expf(-fz[j])); const float f = lbv4[j] + om4[j] * sg; run[j] *= f; ee[i][j] = run[j]; kq_[i][j] = 1.f - f; } } \
            *(f32x4*)(part2 + prg * 128 + pk0) = run; \
            __syncthreads(); \
            _Pragma("unroll") for (int ksl = 0; ksl < 2; ++ksl) _Pragma("unroll") for (int vt = 0; vt < 2; ++vt) { u32x4 t_; P4_PACK(t_, ksl, vt); *(u32x4*)(xs_own + (ksl * 2 + vt) * 1024) = t_; } \
            if (tid < 32) { f32x4 pa_ = {1.f, 1.f, 1.f, 1.f};     \
                _Pragma("unroll") for (int g = 0; g < 16; ++g) { f32x4* pp_ = (f32x4*)(part2 + g * 128 + 4 * tid); const f32x4 pg = *pp_; *pp_ = pa_; pa_ = pa_ * pg; } \
                *(f32x4*)(part2 + 16 * 128 + 4 * tid) = pa_; } \
            __syncthreads(); \
            const f32x4 offp = *(const f32x4*)(part2 + prg * 128 + pk0), totp = *(const f32x4*)(part2 + 16 * 128 + pk0); \
            float ks_[4][4]; \
            _Pragma("unroll") for (int i = 0; i < 4; ++i) { const u32x2 wq = sq##X[i]; \
                const f32x4 qv = {__uint_as_float(wq.x << 16), __uint_as_float(wq.x & 0xffff0000u), __uint_as_float(wq.y << 16), __uint_as_float(wq.y & 0xffff0000u)}; f32x4 qd, ki; \
                  \
                const u32x2 wk = {cvt_pk_bf16(kq_[i][0], kq_[i][1]), cvt_pk_bf16(kq_[i][2], kq_[i][3])}; \
                const f32x4 kv = {__uint_as_float(wk.x << 16), __uint_as_float(wk.x & 0xffff0000u), __uint_as_float(wk.y << 16), __uint_as_float(wk.y & 0xffff0000u)}; \
                _Pragma("unroll") for (int j = 0; j < 4; ++j) { const float ea = offp[j] * ee[i][j]; const float ie = __builtin_amdgcn_rcpf(ea); qd[j] = qv[j] * ea; ki[j] = kv[j] * ie; ks_[j][i] = ki[j] * totp[j]; } \
                u32x2 o1, o2; o1.x = cvt_pk_bf16(qd[0], qd[1]); o1.y = cvt_pk_bf16(qd[2], qd[3]); o2.x = cvt_pk_bf16(ki[0], ki[1]); o2.y = cvt_pk_bf16(ki[2], ki[3]); \
                *(u32x2*)(tq + (pc0 + i) * 136 + pk0) = o1; *(u32x2*)(tf + (pc0 + i) * 136 + pk0) = o2; } \
            _Pragma("unroll") for (int j = 0; j < 4; ++j) { u32x2 wk; wk.x = cvt_pk_bf16(ks_[j][0], ks_[j][1]); wk.y = cvt_pk_bf16(ks_[j][2], ks_[j][3]); *(u32x2*)(B_ + O_KT + (pk0 + j) * 144 + pc0 * 2) = wk; } \
            if (prg == 0) *(f32x4*)(B_ + O_DL + pk0 * 4) = totp; \
            __syncthreads(); \
            { const int mt = w >> 1, nt0 = (w & 1) * 2; f32x4 acc2[2] = {{0.f, 0.f, 0.f, 0.f}, {0.f, 0.f, 0.f, 0.f}}; \
              _Pragma("unroll") for (int ks = 0; ks < 4; ++ks) { const bf16x8 Aq = *(const bf16x8*)(tq + (16 * mt + r) * 136 + ks * 32 + gq * 8); \
                  _Pragma("unroll") for (int j = 0; j < 2; ++j) { const bf16x8 Bk = *(const bf16x8*)(tf + (16 * (nt0 + j) + r) * 136 + ks * 32 + gq * 8); \
                      acc2[j] = __builtin_amdgcn_mfma_f32_16x16x32_bf16(Bk, Aq, acc2[j], 0, 0, 0); } }     \
              char* ap = B_ + O_AT; \
              __syncthreads();     \
              _Pragma("unroll") for (int j = 0; j < 2; ++j) { const int c = 16 * mt + r, s0_ = 16 * (nt0 + j) + 4 * gq; \
                  u32x2 wa; wa.x = cvt_pk_bf16(s0_ <= c ? acc2[j][0] : 0.f, s0_ + 1 <= c ? acc2[j][1] : 0.f); wa.y = cvt_pk_bf16(s0_ + 2 <= c ? acc2[j][2] : 0.f, s0_ + 3 <= c ? acc2[j][3] : 0.f); \
                  *(u32x2*)(ap + c * 144 + s0_ * 2) = wa; } } \
            P4_WRITE_V(X); \
            asm volatile("s_waitcnt vmcnt(0)" ::: "memory");     \
            __syncthreads(); \
            if ((PUB) > 0 && tid == 0) __hip_atomic_store(prog + bh * 16, (unsigned)(PUB), __ATOMIC_RELAXED, __HIP_MEMORY_SCOPE_AGENT); } while (0)
#define P4_STEP(n_, CUR, X, Y) do { const char* B = lds + (CUR) * BUF; \
            _Pragma("unroll") for (int vt = 0; vt < 2; ++vt) _Pragma("unroll") for (int cs = 0; cs < 2; ++cs) { \
                const v4i16_t lo_ = __builtin_amdgcn_ds_read_tr16_b64_v4i16((LAS v4i16_t*)(vtr0 + cs * 32 * 272 + vt * 32)); \
                const v4i16_t hi_ = __builtin_amdgcn_ds_read_tr16_b64_v4i16((LAS v4i16_t*)(vtr0 + cs * 32 * 272 + vt * 32 + 4 * 272)); \
                vb[vt][cs] = (bf16x8){lo_[0], lo_[1], lo_[2], lo_[3], hi_[0], hi_[1], hi_[2], hi_[3]}; } \
            P4_LOAD(X, ((n_) + 2 < 64) ? (n_) + 2 : 63); \
            f32x4 oo[2][2]; \
            _Pragma("unroll") for (int ml = 0; ml < 2; ++ml) { oo[ml][0] = (f32x4){0.f, 0.f, 0.f, 0.f}; oo[ml][1] = (f32x4){0.f, 0.f, 0.f, 0.f}; \
                _Pragma("unroll") for (int ks = 0; ks < 2; ++ks) { const bf16x8 Bq = *(const bf16x8*)(B + O_AT + (32 * kh + 16 * ml + r) * 144 + ks * 64 + gq * 16); \
                    _Pragma("unroll") for (int vt = 0; vt < 2; ++vt) oo[ml][vt] = __builtin_amdgcn_mfma_f32_16x16x32_bf16(vb[vt][ks], Bq, oo[ml][vt], 0, 0, 0); } } \
            _Pragma("unroll") for (int hf = 0; hf < 2; ++hf) _Pragma("unroll") for (int ksl = 0; ksl < 2; ++ksl) { const int ksg = 2 * (hf == 0 ? kh : 1 - kh) + ksl; u32x4 sf_[2]; \
                _Pragma("unroll") for (int vt = 0; vt < 2; ++vt) sf_[vt] = *(const u32x4*)((hf == 0 ? (const char*)xs_own : xs_par) + (ksl * 2 + vt) * 1024); \
                _Pragma("unroll") for (int ml = 0; ml < 2; ++ml) { const char* qa = B + O_QD + (32 * kh + 16 * ml + r) * 272 + ksg * 64 + gq * 8; \
                    const u32x2 a0 = *(const u32x2*)qa, a1 = *(const u32x2*)(qa + 32); const u32x4 aw = {a0.x, a0.y, a1.x, a1.y}; \
                    _Pragma("unroll") for (int vt = 0; vt < 2; ++vt) oo[ml][vt] = __builtin_amdgcn_mfma_f32_16x16x32_bf16(__builtin_bit_cast(bf16x8, sf_[vt]), __builtin_bit_cast(bf16x8, aw), oo[ml][vt], 0, 0, 0); } } \
            float* part = (float*)(lds + O_PART) + (CUR) * 256; \
            _Pragma("unroll") for (int ml = 0; ml < 2; ++ml) { float s_ = 0.f; \
                _Pragma("unroll") for (int vt = 0; vt < 2; ++vt) s_ += (oo[ml][vt][0] * oo[ml][vt][0] + oo[ml][vt][1] * oo[ml][vt][1]) + (oo[ml][vt][2] * oo[ml][vt][2] + oo[ml][vt][3] * oo[ml][vt][3]); \
                s_ += __shfl_xor(s_, 16); s_ += __shfl_xor(s_, 32); if (gq == 0) part[(32 * kh + 16 * ml + r) * 4 + vg] = s_; } \
            _Pragma("unroll") for (int i = 0; i < 4; ++i) { const f32x4 dlv = *(const f32x4*)(B + O_DL + (64 * kh + 16 * i + 4 * gq) * 4); st[i][0] = st[i][0] * dlv; st[i][1] = st[i][1] * dlv; \
                _Pragma("unroll") for (int cs = 0; cs < 2; ++cs) { const bf16x8 A = *(const bf16x8*)(B + O_KT + (64 * kh + 16 * i + r) * 144 + cs * 64 + gq * 16); \
                    _Pragma("unroll") for (int vt = 0; vt < 2; ++vt) st[i][vt] = __builtin_amdgcn_mfma_f32_16x16x32_bf16(A, vb[vt][cs], st[i][vt], 0, 0, 0); } } \
            P4_PREP(Y, (CUR) ^ 1, (n_)); \
            { bf16_t* op = R0 + ((size_t)bh * SEQ + (size_t)(n_) * 64) * HD + 32 * vg + 4 * gq; \
              _Pragma("unroll") for (int ml = 0; ml < 2; ++ml) { const int c = 32 * kh + 16 * ml + r; const f32x4 p0 = *(const f32x4*)(part + c * 4); \
                const float rs = __builtin_amdgcn_rsqf(((p0.x + p0.y) + (p0.z + p0.w)) * (1.f / HD) + EPS); \
                const f32x4 ov0 = oo[ml][0] * og0 * rs, ov1 = oo[ml][1] * og1 * rs; u32x2 pk0, pk1; pk0.x = cvt_pk_bf16(ov0[0], ov0[1]); pk0.y = cvt_pk_bf16(ov0[2], ov0[3]); pk1.x = cvt_pk_bf16(ov1[0], ov1[1]); pk1.y = cvt_pk_bf16(ov1[2], ov1[3]); \
                if (!dry) { __hip_atomic_store((unsigned long long*)(op + (size_t)c * HD), __builtin_bit_cast(unsigned long long, pk0), __ATOMIC_RELAXED, __HIP_MEMORY_SCOPE_AGENT); \
                            __hip_atomic_store((unsigned long long*)(op + (size_t)c * HD + 16), __builtin_bit_cast(unsigned long long, pk1), __ATOMIC_RELAXED, __HIP_MEMORY_SCOPE_AGENT); } else asm volatile("" :: "v"(pk0), "v"(pk1)); } } } while (0)
        P4_LOAD(A, 0); P4_LOAD(B, 1);
        __syncthreads();
        P4_PREP(A, 0, 0);
        for (int n = 0; n < 64; n += 2) { P4_STEP(n, 0, A, B); P4_STEP(n + 1, 1, B, A); }
        asm volatile("s_waitcnt vmcnt(0)" ::: "memory");
        __syncthreads();
        if (tid == 0) __hip_atomic_store(prog + bh * 16, 64u, __ATOMIC_RELAXED, __HIP_MEMORY_SCOPE_AGENT);
#undef P4_LOAD
#undef P4_WRITE_V
#undef P4_PREP
#undef P4_PACK
#undef P4_STEP
    }
}

#define XB_TMO      128
#define XB_XCNT(j)  (256  + 64 * (j))
#define XB_XSUB(j)  (1280 + 64 * (j))
#define XB_XGEN(j)  (2304 + 64 * (j))
#define XB_TOP      3328
#define XB_TOPGEN   3392
#define XCD_BAR_WORDS 3456
#define XB_SPIN_CAP (1u << 22)
__device__ __forceinline__ unsigned xb_ld(unsigned* p)              { return __hip_atomic_load(p, __ATOMIC_RELAXED, __HIP_MEMORY_SCOPE_AGENT); }
__device__ __forceinline__ unsigned xb_add(unsigned* p, unsigned v) { return __hip_atomic_fetch_add(p, v, __ATOMIC_RELAXED, __HIP_MEMORY_SCOPE_AGENT); }
__device__ __forceinline__ unsigned xb_xcc_id() { return (unsigned)__builtin_amdgcn_s_getreg((3 << 11) | 20) & 0xFu; }
#define XB_SPIN(cond, bar) do { unsigned _sp = 0; while (cond) { __builtin_amdgcn_s_sleep(1); \
    if ((++_sp & 255u) == 0u) { if (xb_ld(&(bar)[XB_TMO])) break; if (_sp > XB_SPIN_CAP) { atomicAdd(&(bar)[XB_TMO], 1u); break; } } } } while (0)
struct XcdBarrier { unsigned* bar; unsigned x; volatile LAS unsigned* st; };
__device__ __forceinline__ XcdBarrier xcd_barrier_post(unsigned* bar, volatile LAS unsigned* st) {
    XcdBarrier b; b.bar = bar; b.x = xb_xcc_id(); b.st = st;
    if (threadIdx.x == 0) (void)xb_add(&bar[XB_XCNT(b.x)], 1u);
    return b;
}
__device__ __forceinline__ void xcd_barrier_complete(unsigned* bar, unsigned x, unsigned& nloc, unsigned& nx) {
    const unsigned G = gridDim.x * gridDim.y * gridDim.z;
    unsigned sum, cnt, mine, sp = 0u;
    for (;;) {
        sum = 0u; cnt = 0u; mine = 0u;
#pragma unroll
        for (unsigned j = 0; j < 16; ++j) { const unsigned c = xb_ld(&bar[XB_XCNT(j)]); sum += c; cnt += (c > 0u) ? 1u : 0u; mine = (j == x) ? c : mine; }
        if (sum == G) break;
        __builtin_amdgcn_s_sleep(1);
        if ((++sp & 255u) == 0u) { if (xb_ld(&bar[XB_TMO])) break; if (sp > XB_SPIN_CAP) { atomicAdd(&bar[XB_TMO], 1u); break; } }
    }
    nloc = mine > 0u ? mine : 1u; nx = cnt > 0u ? cnt : 1u;
}
__device__ __forceinline__ void xcd_barrier(unsigned* bar_, volatile LAS unsigned* st_, int wv) {
    const int tid0 = otid(wv);
    asm volatile("" : "+s"(bar_));
    XcdBarrier b; b.bar = bar_; b.st = st_; b.x = 0;
    asm volatile("s_waitcnt vmcnt(0)" ::: "memory");
    __syncthreads();
    if (tid0 == 0) {
        unsigned* bar = b.bar; b.x = xb_xcc_id();
        __builtin_amdgcn_s_waitcnt(0);
        unsigned nloc = b.st[0], nx = b.st[1];
        if (nloc == 0u) { xcd_barrier_complete(bar, b.x, nloc, nx); b.st[0] = nloc; b.st[1] = nx; }
        const unsigned old = xb_add(&bar[XB_XSUB(b.x)], 1u);
        const unsigned gen = old / nloc;
        if (old + 1u == (gen + 1u) * nloc) {
            __builtin_amdgcn_fence(__ATOMIC_RELEASE, "agent");
            asm volatile("s_waitcnt vmcnt(0)" ::: "memory");
            const unsigned og = xb_add(&bar[XB_TOP], 1u);
            const unsigned tg = og / nx;
            if (og + 1u == (tg + 1u) * nx) xb_add(&bar[XB_TOPGEN], 1u);
            else XB_SPIN(xb_ld(&bar[XB_TOPGEN]) == tg, bar);
            __builtin_amdgcn_fence(__ATOMIC_ACQUIRE, "agent");
            xb_add(&bar[XB_XGEN(b.x)], 1u);
            asm volatile("s_waitcnt vmcnt(0)" ::: "memory");
        } else {
            XB_SPIN(xb_ld(&bar[XB_XGEN(b.x)]) == gen, bar);
            __builtin_amdgcn_fence(__ATOMIC_ACQUIRE, "agent");
            asm volatile("s_waitcnt vmcnt(0)" ::: "memory");
        }
    }
    __syncthreads();
}

__global__ void __launch_bounds__(512, 2) yoco_fwd(Args a) {
    extern __shared__ __attribute__((aligned(16))) unsigned char lds_raw[];
    char* lds = (char*)lds_raw; LAS unsigned char* ldsl = (LAS unsigned char*)lds_raw;
    cg::grid_group grid = cg::this_grid();
    const int wv = __builtin_amdgcn_readfirstlane((int)threadIdx.x >> 6);
    unsigned char* ws = a.ws;
    bf16_t* R0 = (bf16_t*)(ws + WS_R0); bf16_t* R1 = (bf16_t*)(ws + WS_R1); bf16_t* R2 = (bf16_t*)(ws + WS_R2);
    bf16_t* XA = (bf16_t*)(ws + WS_XA); bf16_t* H0 = (bf16_t*)a.out;
    const float* MOD0 = (const float*)(ws + WS_MOD0); const float* MOD1 = (const float*)(ws + WS_MOD1); const float* KVMOD = (const float*)(ws + WS_KVMOD);
    float* LSG = (float*)(ws + WS_LSG);
    const int G = gridDim.x, c = blockIdx.x;
    constexpr size_t TS = 64 * MiB;

    unsigned* barw = (unsigned*)(ws + WS_SM + 786432);
    volatile LAS unsigned* bst = (volatile LAS unsigned*)(ldsl + 143360);
    if (threadIdx.x == 0) { bst[0] = 0u; bst[1] = 0u; }
    if (a.one == 0) grid.sync();
    (void)xcd_barrier_post(barw, bst);
#define GSYNC() xcd_barrier((unsigned*)(a.ws + WS_SM + 786432), (volatile LAS unsigned*)(ldsl + 143360), wv)
    p0_prologue(a, lds, wv);
    GSYNC();
    norm_phase<false, false>(a.x, a.norm_g, MOD0, MOD0 + 1024, 3072, H0, nullptr, nullptr, nullptr, 0, nullptr, nullptr, nullptr, nullptr, lds, wv);
    GSYNC();
    { pg8::Gemm g{H0, (const bf16_t*)(ws + WS_W1), TOK, 6144, DM, 2048u, 256, (size_t)4096 * 2048}; pg8::StaticOrder S; S.init(TOK, 6144, G, c);
      pg8::EpiHead E{R0, TS}; pg8::gemm_phase(ldsl, g, S, E, wv);
    }
    GSYNC();
    unsigned* prog = (unsigned*)(ws + WS_SM + 819200);
    { pg8::Gemm g{H0, (const bf16_t*)(ws + WS_W1) + (size_t)6144 * DM, TOK, 2048, DM, 2048u, 256, (size_t)4096 * 2048};
      if (G == 256) {
          if (c < 128) p4_scan(a, lds, 0, wv, prog);
          else { pg8::EarlyOrder S{c - 128}; pg8::EpiMulSiluWait E{R0, prog}; pg8::gemm_phase(ldsl, g, S, E, wv); }
          GSYNC();
          { pg8::RestOrder S{c}; pg8::EpiMulSilu E{R0}; pg8::gemm_phase(ldsl, g, S, E, wv); }
      } else {
          p4_scan(a, lds, 0, wv, prog);
          GSYNC();
          { pg8::StaticOrder S; S.init(TOK, 2048, G, c); pg8::EpiMulSilu E{R0}; pg8::gemm_phase(ldsl, g, S, E, wv); }
      } }
    GSYNC();
    { pg8::Gemm g{R0, (const bf16_t*)(ws + WS_W2), TOK, DM, WD, 256u, (size_t)SEQ * 256, (size_t)16 * SEQ * 256}; pg8::StaticOrder S; S.init(TOK, DM, G, c);
      pg8::EpiRes E{a.x, a.out, MOD0 + 2048}; pg8::gemm_phase(ldsl, g, S, E, wv);
    }
    GSYNC();
    norm_phase<true, true>(a.out, a.kv_norm_g, KVMOD, KVMOD + 1024, 2048, R0, a.norm_g + DM, MOD1, MOD1 + 1024, 3072, XA, (const float*)(ws + WS_WFL), a.kv_fb, LSG, lds, wv);
    GSYNC();
    cumsum_phase(LSG, (int*)(ws + WS_SM + 802816), a.k_norm_g, a.b_q_norm_g, lds, wv);
    { pg8::Gemm g{R0, (const bf16_t*)(ws + WS_W3KV), TOK, 4096, DM, 2048u, 256, (size_t)4096 * 2048}; pg8::StaticOrder S; S.init(TOK, 4096, G, c);
      pg8::EpiHeadNorm E{R1, TS, 1, a.k_norm_g, (LAS float*)(ldsl + 131072)}; pg8::gemm_phase(ldsl, g, S, E, wv);
    }
    GSYNC();
    { pg8::Gemm g{XA, (const bf16_t*)(ws + WS_W3Q), TOK, 2048, DM, 2048u, 256, (size_t)4096 * 2048}; pg8::StaticOrder S; S.init(TOK, 2048, G, c);
      pg8::EpiHeadNorm E{R0, TS, 1, a.b_q_norm_g, (LAS float*)(ldsl + 131072)}; pg8::gemm_phase(ldsl, g, S, E, wv); }
    GSYNC();
    att::phase(lds, R0, R1, R2, LSG, (const int*)(ws + WS_SM + 802816), R0, (bf16_t*)(ws + WS_SM + 716800), 2048, wv);
    GSYNC();
    { pg8::Gemm g{XA, (const bf16_t*)(ws + WS_W3G), TOK, 2048, DM, 2048u, 256, (size_t)4096 * 2048}; pg8::StaticOrder S; S.init(TOK, 2048, G, c);
      pg8::EpiMulSilu E{R0}; pg8::gemm_phase(ldsl, g, S, E, wv); }
    GSYNC();
    { pg8::Gemm g{R0, (const bf16_t*)(ws + WS_W4), TOK, DM, WD, 256u, (size_t)SEQ * 256, (size_t)16 * SEQ * 256}; pg8::StaticOrder S; S.init(TOK, DM, G, c);
      pg8::EpiRes E{a.out, a.out, MOD1 + 2048}; pg8::gemm_phase(ldsl, g, S, E, wv); }
}

extern "C" void kernel_launch(void* const* d_in, const int* in_sizes, int n_in, void* d_out, int out_size, void* d_ws, size_t ws_size, hipStream_t stream) {
    static int grid = 0;
    if (grid == 0) {
        int dev = 0, cus = 0, per_cu = 0;
        hipGetDevice(&dev); hipDeviceGetAttribute(&cus, hipDeviceAttributeMultiprocessorCount, dev);
        hipFuncSetAttribute((const void*)yoco_fwd, hipFuncAttributeMaxDynamicSharedMemorySize, LDS_BYTES);
        hipOccupancyMaxActiveBlocksPerMultiprocessor(&per_cu, (const void*)yoco_fwd, 512, LDS_BYTES);
        (void)hipGetLastError();
        if (cus <= 0) cus = 256;
        grid = cus;
        if (per_cu < 1) fprintf(stderr, "kernel_launch: occupancy query reports %d blocks/CU\n", per_cu);
        if (ws_size < 512 * MiB) fprintf(stderr, "kernel_launch: workspace too small (%zu)\n", ws_size);
    }
    if (hipMemsetAsync((char*)d_ws + WS_SM + 786432, 0, 40960, stream) != hipSuccess) fprintf(stderr, "kernel_launch: memset of barrier words failed\n");
    Args a{};
    const float** pp = (const float**)&a;
    for (int i = 0; i < 18; ++i) pp[i] = (const float*)d_in[i];
    a.out = (float*)d_out; a.ws = (unsigned char*)d_ws; a.one = 1;
    void* args[] = {&a};
    hipError_t e = hipLaunchCooperativeKernel((const void*)yoco_fwd, dim3(grid), dim3(512), args, LDS_BYTES, stream);
    if (e != hipSuccess) fprintf(stderr, "cooperative launch failed: %s (grid %d)\n", hipGetErrorString(e), grid);
}
```

```cpp
#include <hip/hip_runtime.h>
#include <hip/hip_cooperative_groups.h>
#include <cstdio>
#include <cstdint>
namespace cg = cooperative_groups;

#define LAS __attribute__((address_space(3)))
typedef unsigned short bf16_t;
typedef short bf16x8 __attribute__((ext_vector_type(8)));
typedef short s16x4 __attribute__((ext_vector_type(4)));
typedef float f32x4 __attribute__((ext_vector_type(4)));
typedef float f32x16 __attribute__((ext_vector_type(16)));
typedef unsigned u32x4 __attribute__((ext_vector_type(4)));
typedef unsigned u32x2 __attribute__((ext_vector_type(2)));

constexpr int NB = 8, SEQ = 4096, DM = 1024, WD = 2048, NH = 16, HD = 128, BH = NB * NH, TOK = NB * SEQ;
constexpr float EPS = 1e-6f;
constexpr size_t MiB = 1u << 20;
constexpr size_t WS_R0 = 0, WS_R1 = 128 * MiB, WS_R2 = 256 * MiB, WS_XA = 384 * MiB;
constexpr size_t WS_W1 = 448 * MiB, WS_W2 = 464 * MiB, WS_W3KV = 468 * MiB, WS_W3Q = 476 * MiB, WS_W3G = 480 * MiB, WS_W4 = 484 * MiB;
constexpr size_t WS_SM = 488 * MiB;
constexpr size_t WS_MOD0 = WS_SM, WS_MOD1 = WS_SM + 98304, WS_KVMOD = WS_SM + 196608, WS_LB = WS_SM + 262144, WS_WFL = WS_SM + 270336;
constexpr size_t WS_LSG = WS_SM + 1 * MiB, WS_DL = WS_SM + 4 * MiB;
constexpr int LDS_BYTES = 147456;

__device__ __forceinline__ float bf2f(unsigned short h) { return __uint_as_float(((unsigned)h) << 16); }
typedef float f32x2_t __attribute__((ext_vector_type(2))); typedef __bf16 bf16x2_t __attribute__((ext_vector_type(2)));
__device__ __forceinline__ unsigned cvt_pk_bf16(float lo, float hi) { f32x2_t v = {lo, hi}; bf16x2_t b = __builtin_convertvector(v, bf16x2_t); return __builtin_bit_cast(unsigned, b); }
__device__ __forceinline__ unsigned short f2bf(float f) { return (unsigned short)(cvt_pk_bf16(f, 0.f) & 0xffffu); }
__device__ __forceinline__ float wave_sum(float v) {
#pragma unroll
    for (int o = 1; o < 64; o <<= 1) v += __shfl_xor(v, o);
    return v;
}
__device__ __forceinline__ int otid(int wv) { int t = wv * 64 + (int)__builtin_amdgcn_mbcnt_hi(~0u, __builtin_amdgcn_mbcnt_lo(~0u, 0u)); asm volatile("" : "+v"(t)); return t; }
__device__ __forceinline__ float silu_f(float x) { return x * __builtin_amdgcn_rcpf(1.f + __builtin_amdgcn_exp2f(-1.4426950408889634f * x)); }

namespace pg8 {
constexpr int BM = 256, BK = 64, HALF = 128, HTB = HALF * BK * 2, STAGE_BYTES = 8 * HTB, NXCD = 8, WGM = 8;
__host__ __device__ __forceinline__ int lds_byte(int r, int c) { const int st = (r >> 4) * 2 + (c >> 5), rr = r & 15, cc = c & 31, ob = rr * 64 + cc * 2; return st * 1024 + (ob ^ (((ob >> 9) & 1) << 5)); }
__host__ __device__ __forceinline__ void stage_rc(int b, int& R, int& C) { const int st = b / 1024, sb = b % 1024, swz = sb ^ (((sb >> 9) & 1) << 5); R = (st >> 1) * 16 + swz / 64; C = (st & 1) * 32 + (swz % 64) / 2; }
__host__ __device__ __forceinline__ int perm32(int rho) { const int n = rho >> 4, i = rho & 15; return 8 * (i >> 2) + 4 * n + (i & 3); }

struct Unit { int pm, pn; };
struct Gemm { const bf16_t* A; const bf16_t* Bt; int M, N, K; unsigned lda; size_t hsA, bsA; };

struct StaticOrder {
    int nM, nN, nwg, G, c;
    __device__ void init(int M, int N, int G_, int c_) { nM = M / BM; nN = N / BM; nwg = nM * nN; G = G_; c = c_; }
    __device__ bool next(int i, Unit& u) const {
        const long L = (long)i * G + c; if (L >= nwg) return false;
        int wgid = (int)L; { const int q = nwg / NXCD, r = nwg % NXCD, xcd = wgid % NXCD, off = wgid / NXCD; wgid = (xcd < r ? xcd * (q + 1) : r * (q + 1) + (xcd - r) * q) + off; }
        const int nig = WGM * nN, gid = wgid / nig, fm = gid * WGM, gsz = (nM - fm) < WGM ? (nM - fm) : WGM;
        u.pm = fm + ((wgid % nig) % gsz); u.pn = (wgid % nig) / gsz; return true;
    }
};

struct EarlyOrder {
    int e;
    __device__ bool next(int i, Unit& u) const { if (i >= 6) return false; const int uu = i * 128 + e, rp = uu >> 6, idx = uu & 63; u.pm = (idx >> 3) * 16 + rp; u.pn = idx & 7; return true; }
};
struct RestOrder {
    int c;
    __device__ bool next(int i, Unit& u) const { if (i >= 1) return false; const int rp = 12 + (c >> 6), idx = c & 63; u.pm = (idx >> 3) * 16 + rp; u.pn = idx & 7; return true; }
};

struct EpiHead {
    bf16_t* base0; size_t tstride;
    __device__ __forceinline__ void operator()(const f32x4 (&acc)[2][2][4][2], const Unit& u, int wr, int wc, int fr, int fq) const {
        const int b = u.pm >> 4, s0 = (u.pm & 15) * 256 + wr * 64 + fr, t = u.pn >> 3, hd0 = (u.pn & 7) * 2;
        bf16_t* base = base0 + (size_t)t * tstride + wc * 32 + 8 * fq;
#pragma unroll
        for (int ai = 0; ai < 2; ++ai)
#pragma unroll
            for (int m = 0; m < 4; ++m)
#pragma unroll
                for (int bj = 0; bj < 2; ++bj) {
                    const f32x4 v0 = acc[ai][bj][m][0], v1 = acc[ai][bj][m][1];
                    u32x4 w; w.x = cvt_pk_bf16(v0[0], v0[1]); w.y = cvt_pk_bf16(v0[2], v0[3]); w.z = cvt_pk_bf16(v1[0], v1[1]); w.w = cvt_pk_bf16(v1[2], v1[3]);
                    *(u32x4*)(base + ((size_t)(b * 16 + hd0 + bj) * SEQ + s0 + ai * HALF + m * 16) * HD) = w;
                }
    }
};
struct EpiHeadNorm {
    bf16_t* base0; size_t tstride; int nnorm; const float* g; LAS float* xch;
    __device__ __forceinline__ void operator()(const f32x4 (&acc)[2][2][4][2], const Unit& u, int wr, int wc, int fr, int fq) const {
        const int b = u.pm >> 4, s0 = (u.pm & 15) * 256 + wr * 64 + fr, t = u.pn >> 3, hd0 = (u.pn & 7) * 2;
        bf16_t* base = base0 + (size_t)t * tstride + wc * 32 + 8 * fq;
        if (t < nnorm) {
#pragma unroll
            for (int ai = 0; ai < 2; ++ai)
#pragma unroll
                for (int m = 0; m < 4; ++m)
#pragma unroll
                    for (int bj = 0; bj < 2; ++bj) { const f32x4 v0 = acc[ai][bj][m][0], v1 = acc[ai][bj][m][1];
                        float sq = ((v0[0] * v0[0] + v0[1] * v0[1]) + (v0[2] * v0[2] + v0[3] * v0[3])) + ((v1[0] * v1[0] + v1[1] * v1[1]) + (v1[2] * v1[2] + v1[3] * v1[3]));
                        sq += __shfl_xor(sq, 16); sq += __shfl_xor(sq, 32);
                        if (fq == 0) xch[((ai * HALF + wr * 64 + m * 16 + fr) * 2 + bj) * 4 + wc] = sq; }
            asm volatile("s_waitcnt lgkmcnt(0)" ::: "memory"); __builtin_amdgcn_s_barrier(); asm volatile("" ::: "memory");
            const f32x4 g0 = *(const f32x4*)(g + wc * 32 + 8 * fq), g1 = *(const f32x4*)(g + wc * 32 + 8 * fq + 4);
#pragma unroll
            for (int ai = 0; ai < 2; ++ai)
#pragma unroll
                for (int m = 0; m < 4; ++m)
#pragma unroll
                    for (int bj = 0; bj < 2; ++bj) {
                        const f32x4 p = *(const LAS f32x4*)(xch + ((ai * HALF + wr * 64 + m * 16 + fr) * 2 + bj) * 4);
                        const float rs = __builtin_amdgcn_rsqf(((p[0] + p[1]) + (p[2] + p[3])) * (1.f / 128.f) + EPS);
                        const f32x4 v0 = acc[ai][bj][m][0] * g0 * rs, v1 = acc[ai][bj][m][1] * g1 * rs;
                        u32x4 w; w.x = cvt_pk_bf16(v0[0], v0[1]); w.y = cvt_pk_bf16(v0[2], v0[3]); w.z = cvt_pk_bf16(v1[0], v1[1]); w.w = cvt_pk_bf16(v1[2], v1[3]);
                        *(u32x4*)(base + ((size_t)(b * 16 + hd0 + bj) * SEQ + s0 + ai * HALF + m * 16) * HD) = w;
                    }
        } else {
#pragma unroll
            for (int ai = 0; ai < 2; ++ai)
#pragma unroll
                for (int m = 0; m < 4; ++m)
#pragma unroll
                    for (int bj = 0; bj < 2; ++bj) {
                        const f32x4 v0 = acc[ai][bj][m][0], v1 = acc[ai][bj][m][1];
                        u32x4 w; w.x = cvt_pk_bf16(v0[0], v0[1]); w.y = cvt_pk_bf16(v0[2], v0[3]); w.z = cvt_pk_bf16(v1[0], v1[1]); w.w = cvt_pk_bf16(v1[2], v1[3]);
                        *(u32x4*)(base + ((size_t)(b * 16 + hd0 + bj) * SEQ + s0 + ai * HALF + m * 16) * HD) = w;
                    }
        }
    }
};
struct EpiMulSilu {
    bf16_t* X;
    __device__ __forceinline__ void operator()(const f32x4 (&acc)[2][2][4][2], const Unit& u, int wr, int wc, int fr, int fq) const {
        const int b = u.pm >> 4, s0 = (u.pm & 15) * 256 + wr * 64 + fr, hd0 = (u.pn & 7) * 2;
        bf16_t* base = X + wc * 32 + 8 * fq;
        u32x4 pre[8][2];
#define EM_PTR(bt, bj) ((u32x4*)(base + ((size_t)(b * 16 + hd0 + (bj)) * SEQ + s0 + ((bt) >> 2) * HALF + ((bt) & 3) * 16) * HD))
#pragma unroll
        for (int bt = 0; bt < 8; ++bt) { pre[bt][0] = *EM_PTR(bt, 0); pre[bt][1] = *EM_PTR(bt, 1); }
        asm volatile("" ::: "memory");
#pragma unroll
        for (int bt = 0; bt < 8; ++bt) {
#pragma unroll
            for (int bj = 0; bj < 2; ++bj) {
                const u32x4 x = pre[bt][bj]; const f32x4 v0 = acc[bt >> 2][bj][bt & 3][0], v1 = acc[bt >> 2][bj][bt & 3][1];
                u32x4 w;
                w.x = cvt_pk_bf16(__uint_as_float(x.x << 16) * silu_f(v0[0]), __uint_as_float(x.x & 0xffff0000u) * silu_f(v0[1]));
                w.y = cvt_pk_bf16(__uint_as_float(x.y << 16) * silu_f(v0[2]), __uint_as_float(x.y & 0xffff0000u) * silu_f(v0[3]));
                w.z = cvt_pk_bf16(__uint_as_float(x.z << 16) * silu_f(v1[0]), __uint_as_float(x.z & 0xffff0000u) * silu_f(v1[1]));
                w.w = cvt_pk_bf16(__uint_as_float(x.w << 16) * silu_f(v1[2]), __uint_as_float(x.w & 0xffff0000u) * silu_f(v1[3]));
                *EM_PTR(bt, bj) = w;
            }
            asm volatile("" ::: "memory");
        }
#undef EM_PTR
    }
};
struct EpiMulSiluWait {
    bf16_t* X; unsigned* prog;
    __device__ __forceinline__ void operator()(const f32x4 (&acc)[2][2][4][2], const Unit& u, int wr, int wc, int fr, int fq) const {
        const int b = u.pm >> 4, s0 = (u.pm & 15) * 256 + wr * 64 + fr, hd0 = (u.pn & 7) * 2;
        { const unsigned need = 4u * (unsigned)(u.pm & 15) + 4u; unsigned* p0 = prog + (b * 16 + hd0) * 16; unsigned* p1 = p0 + 16; unsigned sp = 0;
          while ((__hip_atomic_load(p0, __ATOMIC_RELAXED, __HIP_MEMORY_SCOPE_AGENT) < need || __hip_atomic_load(p1, __ATOMIC_RELAXED, __HIP_MEMORY_SCOPE_AGENT) < need) && ++sp < (1u << 22)) __builtin_amdgcn_s_sleep(8);
          __builtin_amdgcn_fence(__ATOMIC_ACQUIRE, "agent"); asm volatile("s_waitcnt vmcnt(0)" ::: "memory"); }
        bf16_t* base = X + wc * 32 + 8 * fq;
        u32x4 pre[8][2];
#define EM_PTR(bt, bj) ((u32x4*)(base + ((size_t)(b * 16 + hd0 + (bj)) * SEQ + s0 + ((bt) >> 2) * HALF + ((bt) & 3) * 16) * HD))
#pragma unroll
        for (int bt = 0; bt < 8; ++bt) { pre[bt][0] = *EM_PTR(bt, 0); pre[bt][1] = *EM_PTR(bt, 1); }
        asm volatile("" ::: "memory");
#pragma unroll
        for (int bt = 0; bt < 8; ++bt) {
#pragma unroll
            for (int bj = 0; bj < 2; ++bj) {
                const u32x4 x = pre[bt][bj]; const f32x4 v0 = acc[bt >> 2][bj][bt & 3][0], v1 = acc[bt >> 2][bj][bt & 3][1];
                u32x4 w;
                w.x = cvt_pk_bf16(__uint_as_float(x.x << 16) * silu_f(v0[0]), __uint_as_float(x.x & 0xffff0000u) * silu_f(v0[1]));
                w.y = cvt_pk_bf16(__uint_as_float(x.y << 16) * silu_f(v0[2]), __uint_as_float(x.y & 0xffff0000u) * silu_f(v0[3]));
                w.z = cvt_pk_bf16(__uint_as_float(x.z << 16) * silu_f(v1[0]), __uint_as_float(x.z & 0xffff0000u) * silu_f(v1[1]));
                w.w = cvt_pk_bf16(__uint_as_float(x.w << 16) * silu_f(v1[2]), __uint_as_float(x.w & 0xffff0000u) * silu_f(v1[3]));
                *EM_PTR(bt, bj) = w;
            }
            asm volatile("" ::: "memory");
        }
#undef EM_PTR
    }
};
struct EpiRes {
    const float* base; float* out; const float* gate;
    __device__ __forceinline__ void operator()(const f32x4 (&acc)[2][2][4][2], const Unit& u, int wr, int wc, int fr, int fq) const {
        const int b = u.pm >> 4, row0 = u.pm * BM + wr * 64 + fr, col0 = u.pn * BM + wc * 32 + 8 * fq;
        f32x4 gv[2][2];
#pragma unroll
        for (int bj = 0; bj < 2; ++bj)
#pragma unroll
            for (int n = 0; n < 2; ++n) gv[bj][n] = *(const f32x4*)(gate + (size_t)b * 3072 + col0 + bj * HALF + 4 * n);
        f32x4 pre[2][2][2][2];
#define ER_OFF(bt, mm) ((size_t)(row0 + ((bt) >> 1) * HALF + (2 * ((bt) & 1) + (mm)) * 16) * DM + col0)
#define ER_LOAD(bt, sl) do { _Pragma("unroll") for (int mm = 0; mm < 2; ++mm) _Pragma("unroll") for (int bj = 0; bj < 2; ++bj) _Pragma("unroll") for (int n = 0; n < 2; ++n) \
            pre[sl][mm][bj][n] = *(const f32x4*)(base + ER_OFF(bt, mm) + bj * HALF + 4 * n); } while (0)
        ER_LOAD(0, 0);
#pragma unroll
        for (int bt = 0; bt < 4; ++bt) {
            if (bt + 1 < 4) { if (bt & 1) ER_LOAD(bt + 1, 0); else ER_LOAD(bt + 1, 1); }
            asm volatile("" ::: "memory");
#pragma unroll
            for (int mm = 0; mm < 2; ++mm)
#pragma unroll
                for (int bj = 0; bj < 2; ++bj)
#pragma unroll
                    for (int n = 0; n < 2; ++n)
                        *(f32x4*)(out + ER_OFF(bt, mm) + bj * HALF + 4 * n) = pre[bt & 1][mm][bj][n] + gv[bj][n] * acc[bt >> 1][bj][2 * (bt & 1) + mm][n];
            asm volatile("" ::: "memory");
        }
#undef ER_OFF
#undef ER_LOAD
    }
};

template <class Epi, class Sched>
__device__ __forceinline__ void gemm_phase(LAS unsigned char* lds, const Gemm g, const Sched& S, const Epi& E, int wv) {
    const int tid = otid(wv), wid = __builtin_amdgcn_readfirstlane(tid >> 6), lane = tid & 63, wr = wid >> 2, wc = wid & 3, fr = lane & 15, fq = lane >> 4;
    const int K = g.K, nt = K / BK;
    unsigned voffA[2], voffB[2];
#pragma unroll
    for (int i = 0; i < 2; ++i) { int R, C; stage_rc(tid * 16 + i * 8192, R, C); const int Rb = (R & ~31) + perm32(R & 31);
        voffA[i] = (unsigned)R * g.lda + (unsigned)C * 2u; voffB[i] = (unsigned)(Rb * K + C) * 2u; }
    const size_t kstep = (size_t)(BK * 2);
    const size_t hstepA = (size_t)HALF * g.lda, hstepB = (size_t)HALF * K * 2, tstepB = 2 * hstepB, hsA = g.hsA;
    const unsigned ldsw = (unsigned)wid * 1024u;
    const int aoff = lds_byte(wr * 64 + fr, fq * 8), boff = lds_byte(wc * 32 + fr, fq * 8);
#define PG8_SA(b, h) (((b) * 2 + (h)) * HTB)
#define PG8_SB(b, h) ((4 + (b) * 2 + (h)) * HTB)
#define PG8_STAGE(bufoff, gbase, voff) do { _Pragma("unroll") for (int _i = 0; _i < 2; ++_i) \
        __builtin_amdgcn_global_load_lds((const unsigned*)((const char*)(gbase) + (voff)[_i]), (LAS unsigned*)(lds + (bufoff) + ldsw + _i * 8192), 16, 0, 0); } while (0)
#define PG8_LDA(dst, b, h) do { _Pragma("unroll") for (int m = 0; m < 4; ++m) _Pragma("unroll") for (int k = 0; k < 2; ++k) dst[m][k] = *(const LAS bf16x8*)(lds + PG8_SA(b, h) + aoff + m * 2048 + k * 1024); } while (0)
#define PG8_LDB(dst, b, h) do { _Pragma("unroll") for (int n = 0; n < 2; ++n) _Pragma("unroll") for (int k = 0; k < 2; ++k) dst[n][k] = *(const LAS bf16x8*)(lds + PG8_SB(b, h) + boff + n * 2048 + k * 1024); } while (0)
#define PG8_MMA(ai, bj, At, Bt) do { __builtin_amdgcn_s_setprio(1); _Pragma("unroll") for (int m = 0; m < 4; ++m) _Pragma("unroll") for (int n = 0; n < 2; ++n) _Pragma("unroll") for (int k = 0; k < 2; ++k) \
        acc[ai][bj][m][n] = __builtin_amdgcn_mfma_f32_16x16x32_bf16(Bt[n][k], At[m][k], acc[ai][bj][m][n], 0, 0, 0); __builtin_amdgcn_s_setprio(0); } while (0)
#define PG8_WAIT_V(n) asm volatile("s_waitcnt vmcnt(" #n ")" ::: "memory")
#define PG8_WAIT_L(n) asm volatile("s_waitcnt lgkmcnt(" #n ")" ::: "memory")
#define PG8_BAR __builtin_amdgcn_s_barrier()
#define PG8_SCHED __builtin_amdgcn_sched_barrier(0)
#define PG8_ATILE(u) ((const char*)g.A + (size_t)((u).pm >> 4) * g.bsA + (size_t)((u).pm & 15) * 256 * g.lda)
    Unit cur, nxt; int ui = 0;
    if (!S.next(0, cur)) return;
    f32x4 acc[2][2][4][2];
#pragma unroll
    for (int a = 0; a < 2; ++a)
#pragma unroll
        for (int b = 0; b < 2; ++b)
#pragma unroll
            for (int m = 0; m < 4; ++m)
#pragma unroll
                for (int n = 0; n < 2; ++n) acc[a][b][m][n] = (f32x4){0.f, 0.f, 0.f, 0.f};
    bf16x8 At[4][2], B0[2][2], B1[2][2];
    const char* cA = PG8_ATILE(cur); const char* cB = (const char*)g.Bt + (size_t)cur.pn * tstepB;
    PG8_STAGE(PG8_SB(0, 0), cB, voffB); PG8_STAGE(PG8_SB(0, 1), cB + hstepB, voffB); PG8_STAGE(PG8_SA(0, 0), cA, voffA); PG8_STAGE(PG8_SA(0, 1), cA + hstepA, voffA);
    if (wr == 1) PG8_BAR;
    PG8_WAIT_V(2); PG8_BAR;
    PG8_STAGE(PG8_SB(1, 0), cB + kstep, voffB); PG8_STAGE(PG8_SA(1, 0), cA + kstep, voffA); PG8_STAGE(PG8_SB(1, 1), cB + hstepB + kstep, voffB);
    PG8_WAIT_V(6); PG8_BAR;
    for (;;) {
        const bool has_next = S.next(ui + 1, nxt);
        const char* nA = has_next ? PG8_ATILE(nxt) : cA; const char* nB = has_next ? (const char*)g.Bt + (size_t)nxt.pn * tstepB : cB;
        for (int t = 0; t < nt; t += 2) {
            const bool last = (t == nt - 2);
            const char* a1 = cA + (size_t)(t >> 1) * hsA + kstep;
            const char* a2 = last ? nA : cA + (size_t)((t >> 1) + 1) * hsA; const char* b2 = last ? nB : cB + (size_t)(t + 2) * kstep;
            const char* a3 = a2 + kstep; const char* b3 = b2 + kstep;
            PG8_LDB(B0, 0, 0); PG8_LDB(B1, 0, 1); PG8_SCHED; PG8_LDA(At, 0, 0); PG8_STAGE(PG8_SA(1, 1), a1 + hstepA, voffA);
            PG8_WAIT_V(8); PG8_WAIT_L(0); PG8_BAR; PG8_MMA(0, 0, At, B0); PG8_MMA(0, 1, At, B1); PG8_BAR; PG8_SCHED;
            PG8_LDA(At, 0, 1); PG8_STAGE(PG8_SB(0, 0), b2, voffB); PG8_STAGE(PG8_SB(0, 1), b2 + hstepB, voffB); PG8_STAGE(PG8_SA(0, 0), a2, voffA);
            PG8_WAIT_V(8); PG8_WAIT_L(0); PG8_BAR; PG8_MMA(1, 0, At, B0); PG8_MMA(1, 1, At, B1); PG8_BAR; PG8_SCHED;
            PG8_LDB(B0, 1, 0); PG8_LDB(B1, 1, 1); PG8_SCHED; PG8_LDA(At, 1, 0); PG8_STAGE(PG8_SA(0, 1), a2 + hstepA, voffA);
            PG8_WAIT_V(8); PG8_WAIT_L(0); PG8_BAR; PG8_MMA(0, 0, At, B0); PG8_MMA(0, 1, At, B1); PG8_BAR; PG8_SCHED;
            PG8_LDA(At, 1, 1); PG8_STAGE(PG8_SB(1, 0), b3, voffB); PG8_STAGE(PG8_SB(1, 1), b3 + hstepB, voffB); PG8_STAGE(PG8_SA(1, 0), a3, voffA);
            PG8_WAIT_V(8); PG8_WAIT_L(0); PG8_BAR; PG8_MMA(1, 0, At, B0); PG8_MMA(1, 1, At, B1); PG8_BAR; PG8_SCHED;
        }
        if (wr == 0) PG8_BAR;
        E(acc, cur, wr, wc, fr, fq);
        if (!has_next) break;
#pragma unroll
        for (int a = 0; a < 2; ++a)
#pragma unroll
            for (int b = 0; b < 2; ++b)
#pragma unroll
                for (int m = 0; m < 4; ++m)
#pragma unroll
                    for (int n = 0; n < 2; ++n) acc[a][b][m][n] = (f32x4){0.f, 0.f, 0.f, 0.f};
        cur = nxt; cA = nA; cB = nB; ++ui;
        if (wr == 1) PG8_BAR;
    }
    PG8_WAIT_V(0);
    PG8_BAR;
#undef PG8_SA
#undef PG8_SB
#undef PG8_STAGE
#undef PG8_LDA
#undef PG8_LDB
#undef PG8_MMA
#undef PG8_WAIT_V
#undef PG8_WAIT_L
#undef PG8_BAR
#undef PG8_SCHED
#undef PG8_ATILE
}
}

namespace att {
constexpr int D = 128, NW = 8, QBLK = 32, KVBLK = 64, QB = NW * QBLK;
constexpr int SHM_V = KVBLK * D * 2, SHM_K = KVBLK * D * 2;
constexpr int OFF_WS = 2 * SHM_V + 2 * SHM_K, OFF_G = OFF_WS + NW * 64 * 4, ATT_LDS = OFF_G + 512;
constexpr float SCALE = 0.08838834764831845f, C2 = 1.4426950408889634f * SCALE, THR2 = 24.f;
#define KSWZ(row, colB) ((row) * 256 + ((colB) ^ (((row) & 7) << 4)))
#define SBAR() __builtin_amdgcn_sched_barrier(0)
__device__ __forceinline__ int v_st(int k, int c) { const int kk = (k & ~0xC) | ((k & 4) << 1) | ((k & 8) >> 1); return ((kk >> 3) * 4 + (c >> 5)) * 512 + ((kk & 7) * 32 + (c & 31)) * 2; }
__device__ __forceinline__ int v_rd_base(int lane) { return ((lane & 3) << 3) | (((lane >> 2) & 3) << 6) | (((lane >> 4) & 1) << 5) | (((lane >> 5) & 1) << 8); }
constexpr int v_rd_off(int d0, int ks, int half) { return d0 * 512 + ks * 4096 + half * 2048; }
__device__ __forceinline__ int crow(int r, int hi) { return (r & 3) + 8 * (r >> 2) + 4 * hi; }
__device__ __forceinline__ bf16x8 load8(const bf16_t* p) { return *reinterpret_cast<const bf16x8*>(p); }
__device__ __forceinline__ void mask_tile(f32x16& p0, f32x16& p1, int dq, unsigned W) {
    const float NEG = -__builtin_inff();
#pragma unroll
    for (int r = 0; r < 16; ++r) {
        const int c = (r & 3) + 8 * (r >> 2);
        if ((unsigned)(dq - c) >= W) p0[r] = NEG;
        if ((unsigned)(dq - c - 32) >= W) p1[r] = NEG;
    }
}
__device__ __forceinline__ void partialSM(f32x16& p0, f32x16& p1, float& m_reg, float& mn, float& alpha) {
    float pmax = p0[0];
#pragma unroll
    for (int r = 1; r < 16; ++r) pmax = fmaxf(pmax, p0[r]);
#pragma unroll
    for (int r = 0; r < 16; ++r) pmax = fmaxf(pmax, p1[r]);
    { auto rr = __builtin_amdgcn_permlane32_swap(__float_as_uint(pmax), __float_as_uint(pmax), false, false);
      pmax = fmaxf(__uint_as_float(rr[0]), __uint_as_float(rr[1])); }
    if (__builtin_expect(__all((pmax - m_reg) * C2 <= THR2), 1)) { mn = m_reg; alpha = 1.f; }
    else { mn = fmaxf(m_reg, pmax); alpha = __builtin_amdgcn_exp2f((m_reg - mn) * C2); m_reg = mn; }
    const float mnL = -mn * C2;
#pragma unroll
    for (int r = 0; r < 16; ++r) { p0[r] = fmaf(p0[r], C2, mnL); p1[r] = fmaf(p1[r], C2, mnL); }
#pragma unroll
    for (int r = 0; r < 16; ++r) p0[r] = __builtin_amdgcn_exp2f(p0[r]);
}
__device__ __forceinline__ void finishSM(f32x16& p0, f32x16& p1, float alpha, float& l_reg, bf16x8& pa0, bf16x8& pa1, bf16x8& pa2, bf16x8& pa3) {
#pragma unroll
    for (int r = 0; r < 16; ++r) p1[r] = __builtin_amdgcn_exp2f(p1[r]);
    float ps = 0;
#pragma unroll
    for (int r = 0; r < 16; ++r) ps += p0[r];
#pragma unroll
    for (int r = 0; r < 16; ++r) ps += p1[r];
    { auto rr = __builtin_amdgcn_permlane32_swap(__float_as_uint(ps), __float_as_uint(ps), false, false);
      ps = __uint_as_float(rr[0]) + __uint_as_float(rr[1]); }
    l_reg = l_reg * alpha + ps;
#define PK4(P, B_, OUT) do { unsigned a0 = cvt_pk_bf16(P[B_+0], P[B_+1]), a1 = cvt_pk_bf16(P[B_+2], P[B_+3]);                          \
        unsigned b0 = cvt_pk_bf16(P[B_+4], P[B_+5]), b1 = cvt_pk_bf16(P[B_+6], P[B_+7]);                                             \
        auto r0 = __builtin_amdgcn_permlane32_swap(a0, b0, false, false); auto r1 = __builtin_amdgcn_permlane32_swap(a1, b1, false, false); \
        u32x4 w = {r0[0], r1[0], r0[1], r1[1]}; OUT = *reinterpret_cast<bf16x8*>(&w); } while (0)
    PK4(p0, 0, pa0); PK4(p0, 8, pa1); PK4(p1, 0, pa2); PK4(p1, 8, pa3);
#undef PK4
}
template <int KB>
__device__ __forceinline__ void qkt(f32x16& p0, f32x16& p1, const char* K_lds, int r32, int hi, const bf16x8* qr, const float* gl) {
#pragma unroll
    for (int i = 0; i < 4; ++i) { const f32x4 g0 = *(const f32x4*)(gl + 8 * i + 4 * hi), g1 = *(const f32x4*)(gl + 32 + 8 * i + 4 * hi);
#pragma unroll
        for (int j = 0; j < 4; ++j) { p0[4 * i + j] = g0[j]; p1[4 * i + j] = g1[j]; } }
    const char* kb[4];
#pragma unroll
    for (int dd = 0; dd < 4; ++dd) kb[dd] = K_lds + KB * SHM_K + KSWZ(r32, (dd * 16 + hi * 8) * 2);
#pragma unroll
    for (int d0 = 0; d0 < 8; ++d0) { const char* a = kb[d0 & 3] + (d0 >> 2) * 128;
        bf16x8 b0 = *reinterpret_cast<const bf16x8*>(a);
        bf16x8 b1 = *reinterpret_cast<const bf16x8*>(a + 32 * 256);
        p0 = __builtin_amdgcn_mfma_f32_32x32x16_bf16(b0, qr[d0], p0, 0, 0, 0);
        p1 = __builtin_amdgcn_mfma_f32_32x32x16_bf16(b1, qr[d0], p1, 0, 0, 0); }
}
template <int VB>
__device__ __forceinline__ void pv_tile(f32x16* o, int vb0, bf16x8 pa0, bf16x8 pa1, bf16x8 pa2, bf16x8 pa3) {
#define TRRD(dst, off) asm volatile("ds_read_b64_tr_b16 %0, %1 offset:%2" : "=&v"(dst) : "v"(vb0), "i"(off) : "memory")
#define PV_D0(d0) do { s16x4 l0, l1, l2, l3, h0, h1, h2, h3; constexpr int b_ = VB * SHM_V + v_rd_off(d0, 0, 0); \
        TRRD(l0, b_); TRRD(h0, b_ + 2048); TRRD(l1, b_ + 4096); TRRD(h1, b_ + 6144); TRRD(l2, b_ + 8192); TRRD(h2, b_ + 10240); TRRD(l3, b_ + 12288); TRRD(h3, b_ + 14336); \
        asm volatile("s_waitcnt lgkmcnt(0)" ::: "memory"); SBAR();   \
        o[d0] = __builtin_amdgcn_mfma_f32_32x32x16_bf16(pa0, (bf16x8){l0[0], l0[1], l0[2], l0[3], h0[0], h0[1], h0[2], h0[3]}, o[d0], 0, 0, 0);   \
        o[d0] = __builtin_amdgcn_mfma_f32_32x32x16_bf16(pa1, (bf16x8){l1[0], l1[1], l1[2], l1[3], h1[0], h1[1], h1[2], h1[3]}, o[d0], 0, 0, 0);   \
        o[d0] = __builtin_amdgcn_mfma_f32_32x32x16_bf16(pa2, (bf16x8){l2[0], l2[1], l2[2], l2[3], h2[0], h2[1], h2[2], h2[3]}, o[d0], 0, 0, 0);   \
        o[d0] = __builtin_amdgcn_mfma_f32_32x32x16_bf16(pa3, (bf16x8){l3[0], l3[1], l3[2], l3[3], h3[0], h3[1], h3[2], h3[3]}, o[d0], 0, 0, 0); } while (0)
    PV_D0(0); PV_D0(1); PV_D0(2); PV_D0(3);
#undef PV_D0
#undef TRRD
}
struct BlockRef { const bf16_t* Q; const bf16_t* K; const bf16_t* V; const float* G; bf16_t* O; int P0, jlo; };
struct Seam { bf16x8 qr[8]; bf16x8 st_v0, st_v1, st_k0, st_k1; float sg; };
#define ROW(p, k0, rr) ((p) + (size_t)((k0) + (rr)) * D + sc)
#define VMW() asm volatile("s_waitcnt vmcnt(0)" ::: "memory")
#define VMWN(n) asm volatile("s_waitcnt vmcnt(%0)" :: "i"(n) : "memory")
#define SLOAD_H(Kp, Vp, Gp, k0) do { S.st_v0 = load8(ROW(Vp, k0, sr)); S.st_v1 = load8(ROW(Vp, k0, 32 + sr));              \
                         S.st_k0 = load8(ROW(Kp, k0, sr)); S.st_k1 = load8(ROW(Kp, k0, 32 + sr)); S.sg = (Gp)[(k0) + (tid & 63)]; } while (0)
#define SWRITE_HK(bf) do { *(bf16x8*)(K_lds + (bf) * SHM_K + kws) = S.st_k0; *(bf16x8*)(K_lds + (bf) * SHM_K + kws + 32 * 256) = S.st_k1; \
                           if (tid < 64) G_lds[(bf) * 64 + tid] = S.sg; } while (0)
#define SWRITE_HV(bf) do { *(bf16x8*)(V_lds + (bf) * SHM_V + vst0) = S.st_v0; *(bf16x8*)(V_lds + (bf) * SHM_V + vst1) = S.st_v1; } while (0)
#define SWRITE_H(bf) do { SWRITE_HV(bf); SWRITE_HK(bf); } while (0)
__device__ __forceinline__ void prime(const BlockRef& cur, char* lds, Seam& S, int wv) {
    const int tid = otid(wv), wid = __builtin_amdgcn_readfirstlane(tid >> 6), lane = tid & 63, r32 = lane & 31, hi = lane >> 5;
    const int sr = tid >> 4, sc = (tid & 15) * 8, kws = KSWZ(sr, sc * 2); char* K_lds = lds + 2 * SHM_V; float* G_lds = (float*)(lds + OFF_G);
#pragma unroll
    for (int d0 = 0; d0 < 8; ++d0) S.qr[d0] = load8(cur.Q + (size_t)(wid * QBLK + r32) * D + d0 * 16 + hi * 8);
    SLOAD_H(cur.K, cur.V, cur.G, cur.jlo * KVBLK); VMW(); SWRITE_HK(0);
    __syncthreads();
}
__device__ __forceinline__ void block(const BlockRef& cur, const BlockRef& nxt, char* lds, Seam& S, int wv) {
    const int tid = otid(wv), wid = __builtin_amdgcn_readfirstlane(tid >> 6), lane = tid & 63, r32 = lane & 31, hi = lane >> 5;
    const int W = SEQ;
    const int j_hi = (cur.P0 + QB - 1) / KVBLK + 1;
    const int j_lo = cur.jlo, NT = j_hi - j_lo, kbn = nxt.jlo * KVBLK;
    const int qlo = cur.P0 + wid * QBLK, qm = qlo + r32 - 4 * hi;
    char* V_lds = lds; char* K_lds = lds + 2 * SHM_V; float* G_lds = (float*)(lds + OFF_G);
    float* ws = (float*)(lds + OFF_WS) + wid * 64; float* li_l = ws, * al_l = ws + 32;
    float m_reg = -1e30f, l_reg = 0; f32x16 o[4] = {};
    const int sr = tid >> 4, sc = (tid & 15) * 8, vst0 = v_st(sr, sc), vst1 = v_st(32 + sr, sc), kws = KSWZ(sr, sc * 2);
    const int vb0 = (int)(uintptr_t)V_lds + v_rd_base(lane);
    const bf16_t* Kh = cur.K; const bf16_t* Vh = cur.V; const float* Gh = cur.G;
#define RESC(a) do { if (__any((a) < 1.f)) { if (hi == 0) al_l[r32] = (a); asm volatile("s_waitcnt lgkmcnt(0)" ::: "memory");              \
                     _Pragma("unroll") for (int d_ = 0; d_ < 4; ++d_) _Pragma("unroll") for (int r = 0; r < 16; ++r) o[d_][r] *= al_l[crow(r, hi)]; } } while (0)
#define KBASE(t) ((j_lo + (t)) * KVBLK)
#define MASKT(P0_, P1_, t) do { const int kb_ = KBASE(t); if (kb_ + KVBLK - 1 > qlo) mask_tile(P0_, P1_, qm - kb_, (unsigned)W); } while (0)
    constexpr int NQL = 8;
#define SEAM_K0() do { VMWN(NQL); SWRITE_HK(0); SBAR(); } while (0)
    f32x16 pA0, pA1, pB0, pB1; float mnA, mnB, alA, alB; bf16x8 pa0, pa1, pa2, pa3;
    SWRITE_HV(0); SBAR();
    if (NT > 1) SLOAD_H(Kh, Vh, Gh, KBASE(1));
    SBAR(); qkt<0>(pA0, pA1, K_lds, r32, hi, S.qr, G_lds);
    MASKT(pA0, pA1, 0); partialSM(pA0, pA1, m_reg, mnA, alA);
    if (NT > 1) { VMW(); SWRITE_H(1); }
    __syncthreads();
#define HALF_STEP(PX0, PX1, mnX, alX, PY0, PY1, alY, t, KB, VB, SB) do {                                                      \
        SBAR(); qkt<KB>(PX0, PX1, K_lds, r32, hi, S.qr, G_lds + (KB) * 64);                                             \
        finishSM(PY0, PY1, alY, l_reg, pa0, pa1, pa2, pa3); SBAR();                                                           \
        if ((t) + 1 < NT) { SLOAD_H(Kh, Vh, Gh, KBASE((t) + 1)); SBAR(); }                                               \
        pv_tile<VB>(o, vb0, pa0, pa1, pa2, pa3); MASKT(PX0, PX1, (t)); partialSM(PX0, PX1, m_reg, mnX, alX);                                        \
        __syncthreads();                                                                                                      \
        if ((t) + 1 < NT) { VMW(); SWRITE_H(SB); }                                                                          \
        RESC(alX); __syncthreads(); } while (0)
    for (int t = 1; t + 1 < NT; t += 2) {
        HALF_STEP(pB0, pB1, mnB, alB, pA0, pA1, alA, t, 1, 0, 0);
        HALF_STEP(pA0, pA1, mnA, alA, pB0, pB1, alB, t + 1, 0, 1, 1);
    }
    const bool even = (NT & 1) == 0;
    if (even) { SBAR(); qkt<1>(pB0, pB1, K_lds, r32, hi, S.qr, G_lds + 64); SBAR(); }
    SLOAD_H(nxt.K, nxt.V, nxt.G, kbn); SBAR();
#pragma unroll
    for (int d0 = 0; d0 < 8; ++d0) S.qr[d0] = load8(nxt.Q + (size_t)(wid * QBLK + r32) * D + d0 * 16 + hi * 8);
    SBAR();
    finishSM(pA0, pA1, alA, l_reg, pa0, pa1, pa2, pa3); SBAR();
    pv_tile<0>(o, vb0, pa0, pa1, pa2, pa3);
    if (even) { MASKT(pB0, pB1, NT - 1); partialSM(pB0, pB1, m_reg, mnB, alB); __syncthreads(); RESC(alB);
        finishSM(pB0, pB1, alB, l_reg, pa0, pa1, pa2, pa3); SBAR(); pv_tile<1>(o, vb0, pa0, pa1, pa2, pa3); }
    SBAR(); SEAM_K0();
    if (hi == 0) li_l[r32] = l_reg; asm volatile("s_waitcnt lgkmcnt(0)" ::: "memory");
    float rli[16];
#pragma unroll
    for (int r = 0; r < 16; ++r) rli[r] = __builtin_amdgcn_rcpf(li_l[crow(r, hi)]);
    bf16_t* Ow = cur.O + (size_t)(wid * QBLK) * D;
#pragma unroll
    for (int r = 0; r < 16; ++r) { const int orow = crow(r, hi);
#pragma unroll
        for (int d0 = 0; d0 < 4; ++d0) { const float v = o[d0][r] * rli[r];
            const float vn = __shfl_xor(v, 1);
            if ((r32 & 1) == 0) *(unsigned*)(Ow + (size_t)orow * D + d0 * 32 + r32) = cvt_pk_bf16(v, vn); } }
    __syncthreads();
#undef RESC
#undef KBASE
#undef MASKT
#undef SEAM_K0
#undef HALF_STEP
}
#undef ROW
#undef VMW
#undef VMWN
#undef SLOAD_H
#undef SWRITE_HK
#undef SWRITE_HV
#undef SWRITE_H
struct Item { int bh, qb0, qb1; };
__device__ __forceinline__ Item decode(int L) {
    const int c = L & 255, i = L >> 8, xcd = c & 7, cc = c >> 3, gi = (cc & 1) + 2 * i, qb = ((cc >> 1) + 2 * i + (i >> 2)) & 15;
    Item it; it.bh = ((xcd - gi) & 7) * 16 + gi; it.qb0 = qb; it.qb1 = qb; return it;
}
__device__ __forceinline__ BlockRef mkref(const Item& it, int pass, const bf16_t* Q, const bf16_t* K, const bf16_t* V, const float* G, const int* JLO, bf16_t* O, bf16_t* Odummy, bool dummy) {
    const int qb = pass ? it.qb1 : it.qb0; BlockRef r;
    r.Q = Q + ((size_t)it.bh * SEQ + (size_t)qb * QB) * D; r.O = dummy ? Odummy : O + ((size_t)it.bh * SEQ + (size_t)qb * QB) * D;
    r.K = K + (size_t)it.bh * SEQ * D; r.V = V + (size_t)it.bh * SEQ * D; r.G = G + (size_t)it.bh * SEQ; r.P0 = qb * QB; r.jlo = JLO[it.bh * 16 + qb]; return r;
}
__device__ __forceinline__ void phase(char* lds, const bf16_t* Q, const bf16_t* K, const bf16_t* V, const float* G, const int* JLO, bf16_t* O, bf16_t* Odummy, int total, int wv) {
    const int stride = gridDim.x;
    int L = blockIdx.x; if (L >= total) return;
    Item it = decode(L); int pass = 0;
    BlockRef cur = mkref(it, 0, Q, K, V, G, JLO, O, Odummy, false);
    Seam S;
    prime(cur, lds, S, wv);
    for (;;) {
        const bool more_pass = pass == 0 && it.qb1 != it.qb0, more_item = L + stride < total, last = !more_pass && !more_item;
        Item itn = it; int passn = pass + 1, Ln = L;
        if (!more_pass) { passn = 0; Ln = more_item ? L + stride : L; itn = decode(Ln); }
        const BlockRef nxt = last ? cur : mkref(itn, passn, Q, K, V, G, JLO, O, Odummy, false);
        block(cur, nxt, lds, S, wv);
        if (last) break;
        cur = nxt; it = itn; pass = passn; L = Ln;
    }
}
#undef SBAR
}

struct Args {
    const float *x, *c, *mod_w, *mod_b, *norm_g, *a_w_in, *a_lb, *a_onorm_g, *a_w_out, *kv_mod_w, *kv_mod_b, *kv_norm_g, *kv_w, *kv_fb, *k_norm_g, *b_w_in, *b_q_norm_g, *b_w_out;
    float* out; unsigned char* ws; int one, pad;
};

__device__ __forceinline__ void transpose_item(const float* W, int K, int ldw, int N, bf16_t* WT, float* scr, int item, int lane) {
    const int nblk = N / 32, kb = item / nblk, nb = item % nblk, k0 = 64 * kb, n0 = 32 * nb;
#pragma unroll 8
    for (int i = 0; i < 32; ++i) { const int kk = 2 * i + (lane >> 5); scr[kk * 33 + (lane & 31)] = W[(size_t)(k0 + kk) * ldw + n0 + (lane & 31)]; }
    asm volatile("s_waitcnt lgkmcnt(0)" ::: "memory");
    const int c = lane & 7;
#pragma unroll
    for (int j = 0; j < 4; ++j) { const int n = (lane >> 3) + 8 * j; const float* s = scr + (8 * c) * 33 + n;
        u32x4 o; o.x = cvt_pk_bf16(s[0 * 33], s[1 * 33]); o.y = cvt_pk_bf16(s[2 * 33], s[3 * 33]); o.z = cvt_pk_bf16(s[4 * 33], s[5 * 33]); o.w = cvt_pk_bf16(s[6 * 33], s[7 * 33]);
        *(u32x4*)(WT + (size_t)(n0 + n) * K + k0 + 8 * c) = o; }
    asm volatile("s_waitcnt lgkmcnt(0)" ::: "memory");
}

__device__ __forceinline__ void p0_prologue(const Args& a, char* lds, int wv) {
    const int tid = otid(wv), lane = tid & 63, wave = tid >> 6, G = gridDim.x;
    unsigned char* ws = a.ws;
    float* sc = (float*)lds;
    float* red = (float*)(lds + 32768);
    for (int i = tid; i < NB * DM; i += 512) sc[i] = silu_f(a.c[i]);
    __syncthreads();
    for (int cgp = blockIdx.x; cgp < 256; cgp += G) {
        const int n0 = cgp * 32; const float* Wm; const float* bias; float* outp; int ldn, nloc;
        if (n0 < 3072) { Wm = a.mod_w; bias = a.mod_b; outp = (float*)(ws + WS_MOD0); ldn = 3072; nloc = n0; }
        else if (n0 < 6144) { Wm = a.mod_w + (size_t)DM * 3072; bias = a.mod_b + 3072; outp = (float*)(ws + WS_MOD1); ldn = 3072; nloc = n0 - 3072; }
        else { Wm = a.kv_mod_w; bias = a.kv_mod_b; outp = (float*)(ws + WS_KVMOD); ldn = 2048; nloc = n0 - 6144; }
        const int col = lane & 31, ksub = wave * 2 + (lane >> 5);
        float accb[8];
#pragma unroll
        for (int b = 0; b < 8; ++b) accb[b] = 0.f;
#pragma unroll 8
        for (int kk = 0; kk < 64; ++kk) { const int k = ksub * 64 + kk; const float w = Wm[(size_t)k * ldn + nloc + col];
#pragma unroll
            for (int b = 0; b < 8; ++b) accb[b] = fmaf(sc[b * DM + k], w, accb[b]); }
#pragma unroll
        for (int b = 0; b < 8; ++b) red[(ksub * 8 + b) * 32 + col] = accb[b];
        __syncthreads();
        if (tid < 256) { const int b = tid >> 5, cc = tid & 31; float s = bias[nloc + cc];
#pragma unroll
            for (int j = 0; j < 16; ++j) s += red[(j * 8 + b) * 32 + cc];
            outp[(size_t)b * ldn + nloc + cc] = s; }
        __syncthreads();
    }
    const int gtid = blockIdx.x * 512 + tid, NT = G * 512;
    for (int j = gtid; j < WD; j += NT) ((float*)(ws + WS_LB))[j] = 1.f / (1.f + __expf(a.a_lb[WD + j] - a.a_lb[j]));
    for (int i = gtid; i < NH * DM; i += NT) { const int h = i >> 10, k = i & 1023; ((float*)(ws + WS_WFL))[i] = a.kv_w[(size_t)k * 4112 + 4096 + h]; }
    __syncthreads();
    float* scr = (float*)(lds + wave * 16384);
    const int gw = blockIdx.x * 8 + wave, NGW = G * 8;
    constexpr int I1 = 16 * 256, I2 = 32 * 32, I3 = 16 * 128, I4 = 16 * 128, I5 = 32 * 32, NIT = I1 + I2 + I3 + I4 + I5;
    for (int it = gw; it < NIT; it += NGW) {
        int r = it;
        if (r < I1) { transpose_item(a.a_w_in, 1024, 8192, 8192, (bf16_t*)(ws + WS_W1), scr, r, lane); continue; } r -= I1;
        if (r < I2) { transpose_item(a.a_w_out, 2048, 1024, 1024, (bf16_t*)(ws + WS_W2), scr, r, lane); continue; } r -= I2;
        if (r < I3) { transpose_item(a.kv_w, 1024, 4112, 4096, (bf16_t*)(ws + WS_W3KV), scr, r, lane); continue; } r -= I3;
        if (r < I4) { transpose_item(a.b_w_in, 1024, 4096, 4096, (bf16_t*)(ws + WS_W3Q), scr, r, lane); continue; } r -= I4;
        transpose_item(a.b_w_out, 2048, 1024, 1024, (bf16_t*)(ws + WS_W4), scr, r, lane);
    }
}

template <bool FL, bool DUAL>
__device__ __forceinline__ void norm_phase(const float* x, const float* g, const float* shiftp, const float* scalep, int mstride, bf16_t* outp,
                                           const float* g2, const float* shiftp2, const float* scalep2, int mstride2, bf16_t* outp2,
                                           const float* wfl_g, const float* fb, float* LS, char* lds, int wv) {
    const int tid = otid(wv), lane = tid & 63, wave = tid >> 6;
    float* wfl = (float*)lds;
    if (FL) { for (int i = tid; i < NH * DM / 4; i += 512) ((f32x4*)wfl)[i] = ((const f32x4*)wfl_g)[i]; __syncthreads(); }
    const int gw = blockIdx.x * 8 + wave, NGW = gridDim.x * 8, rpw = (((TOK + NGW - 1) / NGW) + 3) & ~3;
    int curb = -1; f32x4 al[4], be[4], al2[4], be2[4];
    for (int i0 = 0; i0 < rpw; i0 += 4) {
        const int m0 = gw * rpw + i0; if (m0 >= TOK) break;
        const int b = m0 >> 12;
        if (b != curb) { curb = b;
#pragma unroll
            for (int j = 0; j < 4; ++j) { const int col = 4 * lane + 256 * j; const f32x4 gg = *(const f32x4*)(g + col), sc = *(const f32x4*)(scalep + (size_t)b * mstride + col);
                al[j] = gg * (sc + 1.f); be[j] = *(const f32x4*)(shiftp + (size_t)b * mstride + col);
                if (DUAL) { const f32x4 gg2 = *(const f32x4*)(g2 + col), sc2 = *(const f32x4*)(scalep2 + (size_t)b * mstride2 + col);
                    al2[j] = gg2 * (sc2 + 1.f); be2[j] = *(const f32x4*)(shiftp2 + (size_t)b * mstride2 + col); } } }
        f32x4 v[4][4];
#pragma unroll
        for (int q = 0; q < 4; ++q) { const f32x4* xr = (const f32x4*)(x + (size_t)(m0 + q) * DM) + lane;
#pragma unroll
            for (int j = 0; j < 4; ++j) v[q][j] = xr[64 * j]; }
#pragma unroll
        for (int q = 0; q < 4; ++q) { float s2 = 0.f;
#pragma unroll
            for (int j = 0; j < 4; ++j) s2 += (v[q][j].x * v[q][j].x + v[q][j].y * v[q][j].y) + (v[q][j].z * v[q][j].z + v[q][j].w * v[q][j].w);
            const float rstd = __builtin_amdgcn_rsqf(wave_sum(s2) * (1.f / DM) + EPS);
            unsigned long long* o8 = (unsigned long long*)(outp + (size_t)(m0 + q) * DM) + lane;
            unsigned long long* o82 = (unsigned long long*)(outp2 + (size_t)(m0 + q) * DM) + lane;
#pragma unroll
            for (int j = 0; j < 4; ++j) { const f32x4 xh = v[q][j] * rstd;
                if (DUAL) { const f32x4 w2 = xh * al2[j] + be2[j];
                    o82[64 * j] = (unsigned long long)cvt_pk_bf16(w2.x, w2.y) | ((unsigned long long)cvt_pk_bf16(w2.z, w2.w) << 32); }
                v[q][j] = xh * al[j] + be[j];
                o8[64 * j] = (unsigned long long)cvt_pk_bf16(v[q][j].x, v[q][j].y) | ((unsigned long long)cvt_pk_bf16(v[q][j].z, v[q][j].w) << 32); } }
        if (FL) {
            float mine[4] = {0.f, 0.f, 0.f, 0.f};
#pragma unroll 2
            for (int h = 0; h < NH; ++h) { f32x4 w[4];
#pragma unroll
                for (int j = 0; j < 4; ++j) w[j] = *(const f32x4*)(wfl + h * DM + 4 * lane + 256 * j);
#pragma unroll
                for (int q = 0; q < 4; ++q) { float p = 0.f;
#pragma unroll
                    for (int j = 0; j < 4; ++j) p += (v[q][j].x * w[j].x + v[q][j].y * w[j].y) + (v[q][j].z * w[j].z + v[q][j].w * w[j].w);
                    p = wave_sum(p); if (lane == h) mine[q] = p; } }
            if (lane < NH) { const float fbv = fb[lane];
#pragma unroll
                for (int q = 0; q < 4; ++q) { const float z = mine[q] + fbv; const float ls = z < 0.f ? z - log1pf(__expf(z)) : -log1pf(__expf(-z));
                    LS[(size_t)(b * NH + lane) * SEQ + ((m0 + q) & (SEQ - 1))] = ls; } }
        }
    }
}

__device__ __forceinline__ void cumsum_phase(float* LS, int* JLO, const float* kg, const float* qg, char* lds, int wv) {
    const int tid = otid(wv), lane = tid & 63, wave = tid >> 6; float* wtot = (float*)lds; float* gl = (float*)(lds + 1024);
    float mk = fmaxf(fabsf(kg[lane]), fabsf(kg[lane + 64])), mq = fmaxf(fabsf(qg[lane]), fabsf(qg[lane + 64]));
#pragma unroll
    for (int o = 1; o < 64; o <<= 1) { mk = fmaxf(mk, __shfl_xor(mk, o)); mq = fmaxf(mq, __shfl_xor(mq, o)); }
    const float TH = (40.f + 2.f * (1.05f * 128.f * 1.4426950408889634f * 0.08838834764831845f * mk * mq)) / (1.4426950408889634f * 0.08838834764831845f);
    for (int bh = blockIdx.x; bh < BH; bh += gridDim.x) {
        float* p = LS + (size_t)bh * SEQ + tid * 8; f32x4 a = *(f32x4*)p, b = *(f32x4*)(p + 4);
        float v[8] = {a.x, a.y, a.z, a.w, b.x, b.y, b.z, b.w};
#pragma unroll
        for (int i = 1; i < 8; ++i) v[i] += v[i - 1];
        float run = v[7];
#pragma unroll
        for (int o = 1; o < 64; o <<= 1) { const float t = __shfl_up(run, o); if (lane >= o) run += t; }
        if (lane == 63) wtot[wave] = run;
        __syncthreads();
        float off = run - v[7];
        for (int w = 0; w < wave; ++w) off += wtot[w];
        const float k = -11.313708498984761f;
        a = (f32x4){(v[0] + off) * k, (v[1] + off) * k, (v[2] + off) * k, (v[3] + off) * k}; b = (f32x4){(v[4] + off) * k, (v[5] + off) * k, (v[6] + off) * k, (v[7] + off) * k};
        *(f32x4*)p = a; *(f32x4*)(p + 4) = b;
        *(f32x4*)(gl + tid * 8) = a; *(f32x4*)(gl + tid * 8 + 4) = b;
        __syncthreads();
#pragma unroll
        for (int rep = 0; rep < 2; ++rep) { const int qb = wave + 8 * rep, P0 = qb * 256;
            const bool skip = (64 * lane + 63 < P0) && (gl[P0] - gl[64 * lane + 63] > TH);
            const unsigned long long mask = __ballot(skip);
            if (lane == 0) JLO[bh * 16 + qb] = __popcll(mask); }
        __syncthreads();
    }
}

__device__ __forceinline__ void p4_scan(const Args& a, char* lds, int dry, int wv, unsigned* prog) {
    const int tid = otid(wv), lane = tid & 63, w = tid >> 6, r = lane & 15, gq = lane >> 4, vg = w & 3, kh = w >> 2;
    unsigned char* ws = a.ws;
    bf16_t* R0 = (bf16_t*)(ws + WS_R0); const bf16_t* R1 = (const bf16_t*)(ws + WS_R1); const bf16_t* R2 = (const bf16_t*)(ws + WS_R2);
    const float* LB = (const float*)(ws + WS_LB);
    constexpr int BUF = 45568, O_QD = 0, O_KT = 17408, O_AT = 35840, O_DL = 45056, O_XS = 2 * BUF, O_PART = O_XS + 32768, O_V = O_PART + 2048;
    typedef short v4i16_t __attribute__((ext_vector_type(4)));
    const LAS char* const vtr0 = (const LAS char*)(LAS unsigned char*)(lds) + O_V + (8 * gq + (r >> 2)) * 272 + (32 * vg + 4 * (r & 3)) * 2;
    const int pk0 = 4 * (tid & 31), prg = tid >> 5, pc0 = 4 * prg;
    bf16_t* const tf = (bf16_t*)(lds + O_V);
    for (int bh = blockIdx.x; bh < BH; bh += gridDim.x) {
        const int h = bh & 15;
        const f32x4 og0 = *(const f32x4*)(a.a_onorm_g + h * HD + 32 * vg + 4 * gq), og1 = *(const f32x4*)(a.a_onorm_g + h * HD + 32 * vg + 16 + 4 * gq);
        const f32x4 lbv4 = *(const f32x4*)(LB + h * HD + pk0), om4 = 1.f - lbv4;
        f32x4 st[4][2];
#pragma unroll
        for (int i = 0; i < 4; ++i) { st[i][0] = (f32x4){0.f, 0.f, 0.f, 0.f}; st[i][1] = (f32x4){0.f, 0.f, 0.f, 0.f}; }
        u32x2 sqA[4], sfA[4], sqB[4], sfB[4]; u32x4 svA[2], svB[2]; bf16x8 vb[2][2];
        char* const xs_own = lds + O_XS + w * 4096 + lane * 16; const char* const xs_par = lds + O_XS + (w ^ 4) * 4096 + lane * 16;
        { const u32x4 z = {0u, 0u, 0u, 0u};
#pragma unroll
          for (int f = 0; f < 4; ++f) *(u32x4*)(xs_own + f * 1024) = z; }
#define P4_LOAD(X, n_) do { const size_t blk_ = ((size_t)bh * SEQ + (size_t)(n_) * 64) * HD; \
            _Pragma("unroll") for (int i = 0; i < 4; ++i) { sq##X[i] = *(const u32x2*)(R0 + blk_ + (size_t)(pc0 + i) * HD + pk0); sf##X[i] = *(const u32x2*)(R1 + blk_ + (size_t)(pc0 + i) * HD + pk0); } \
            _Pragma("unroll") for (int rep = 0; rep < 2; ++rep) { const int i = tid + rep * 512; sv##X[rep] = *(const u32x4*)(R2 + blk_ + (size_t)i * 8); } } while (0)
#define P4_WRITE_V(X) do { _Pragma("unroll") for (int rep = 0; rep < 2; ++rep) { const int i = tid + rep * 512; *(u32x4*)(lds + O_V + (i >> 4) * 272 + (i & 15) * 16) = sv##X[rep]; } } while (0)
#define P4_PACK(DST, ksl, vt) do { u32x4 bw_; bw_.x = cvt_pk_bf16(st[2 * (ksl)][vt][0], st[2 * (ksl)][vt][1]); bw_.y = cvt_pk_bf16(st[2 * (ksl)][vt][2], st[2 * (ksl)][vt][3]); \
            bw_.z = cvt_pk_bf16(st[2 * (ksl) + 1][vt][0], st[2 * (ksl) + 1][vt][1]); bw_.w = cvt_pk_bf16(st[2 * (ksl) + 1][vt][2], st[2 * (ksl) + 1][vt][3]); DST = bw_; } while (0)
#define P4_PREP(X, bf_, PUB) do { char* B_ = lds + (bf_) * BUF; bf16_t* tq = (bf16_t*)(B_ + O_QD); float* part2 = (float*)(B_ + O_AT); \
              \
            float ee[4][4]; f32x4 kq_[4]; f32x4 run = {1.f, 1.f, 1.f, 1.f}; \
            _Pragma("unroll") for (int i = 0; i < 4; ++i) { const u32x2 wz = sf##X[i]; \
                const f32x4 fz = {__uint_as_float(wz.x << 16), __uint_as_float(wz.x & 0xffff0000u), __uint_as_float(wz.y << 16), __uint_as_float(wz.y & 0xffff0000u)}; \
                _Pragma("unroll") for (int j = 0; j < 4; ++j) { const float sg = __builtin_amdgcn_rcpf(1.f + __expf(-fz[j])); const float f = lbv4[j] + om4[j] * sg; run[j] *= f; ee[i][j] = run[j]; kq_[i][j] = 1.f - f; } } \
            *(f32x4*)(part2 + prg * 128 + pk0) = run; \
            __syncthreads(); \
            _Pragma("unroll") for (int ksl = 0; ksl < 2; ++ksl) _Pragma("unroll") for (int vt = 0; vt < 2; ++vt) { u32x4 t_; P4_PACK(t_, ksl, vt); *(u32x4*)(xs_own + (ksl * 2 + vt) * 1024) = t_; } \
            if (tid < 32) { f32x4 pa_ = {1.f, 1.f, 1.f, 1.f};     \
                _Pragma("unroll") for (int g = 0; g < 16; ++g) { f32x4* pp_ = (f32x4*)(part2 + g * 128 + 4 * tid); const f32x4 pg = *pp_; *pp_ = pa_; pa_ = pa_ * pg; } \
                *(f32x4*)(part2 + 16 * 128 + 4 * tid) = pa_; } \
            __syncthreads(); \
            const f32x4 offp = *(const f32x4*)(part2 + prg * 128 + pk0), totp = *(const f32x4*)(part2 + 16 * 128 + pk0); \
            float ks_[4][4]; \
            _Pragma("unroll") for (int i = 0; i < 4; ++i) { const u32x2 wq = sq##X[i]; \
                const f32x4 qv = {__uint_as_float(wq.x << 16), __uint_as_float(wq.x & 0xffff0000u), __uint_as_float(wq.y << 16), __uint_as_float(wq.y & 0xffff0000u)}; f32x4 qd, ki; \
                  \
                const u32x2 wk = {cvt_pk_bf16(kq_[i][0], kq_[i][1]), cvt_pk_bf16(kq_[i][2], kq_[i][3])}; \
                const f32x4 kv = {__uint_as_float(wk.x << 16), __uint_as_float(wk.x & 0xffff0000u), __uint_as_float(wk.y << 16), __uint_as_float(wk.y & 0xffff0000u)}; \
                _Pragma("unroll") for (int j = 0; j < 4; ++j) { const float ea = offp[j] * ee[i][j]; const float ie = __builtin_amdgcn_rcpf(ea); qd[j] = qv[j] * ea; ki[j] = kv[j] * ie; ks_[j][i] = ki[j] * totp[j]; } \
                u32x2 o1, o2; o1.x = cvt_pk_bf16(qd[0], qd[1]); o1.y = cvt_pk_bf16(qd[2], qd[3]); o2.x = cvt_pk_bf16(ki[0], ki[1]); o2.y = cvt_pk_bf16(ki[2], ki[3]); \
                *(u32x2*)(tq + (pc0 + i) * 136 + pk0) = o1; *(u32x2*)(tf + (pc0 + i) * 136 + pk0) = o2; } \
            _Pragma("unroll") for (int j = 0; j < 4; ++j) { u32x2 wk; wk.x = cvt_pk_bf16(ks_[j][0], ks_[j][1]); wk.y = cvt_pk_bf16(ks_[j][2], ks_[j][3]); *(u32x2*)(B_ + O_KT + (pk0 + j) * 144 + pc0 * 2) = wk; } \
            if (prg == 0) *(f32x4*)(B_ + O_DL + pk0 * 4) = totp; \
            __syncthreads(); \
            { const int mt = w >> 1, nt0 = (w & 1) * 2; f32x4 acc2[2] = {{0.f, 0.f, 0.f, 0.f}, {0.f, 0.f, 0.f, 0.f}}; \
              _Pragma("unroll") for (int ks = 0; ks < 4; ++ks) { const bf16x8 Aq = *(const bf16x8*)(tq + (16 * mt + r) * 136 + ks * 32 + gq * 8); \
                  _Pragma("unroll") for (int j = 0; j < 2; ++j) { const bf16x8 Bk = *(const bf16x8*)(tf + (16 * (nt0 + j) + r) * 136 + ks * 32 + gq * 8); \
                      acc2[j] = __builtin_amdgcn_mfma_f32_16x16x32_bf16(Bk, Aq, acc2[j], 0, 0, 0); } }     \
              char* ap = B_ + O_AT; \
              __syncthreads();     \
              _Pragma("unroll") for (int j = 0; j < 2; ++j) { const int c = 16 * mt + r, s0_ = 16 * (nt0 + j) + 4 * gq; \
                  u32x2 wa; wa.x = cvt_pk_bf16(s0_ <= c ? acc2[j][0] : 0.f, s0_ + 1 <= c ? acc2[j][1] : 0.f); wa.y = cvt_pk_bf16(s0_ + 2 <= c ? acc2[j][2] : 0.f, s0_ + 3 <= c ? acc2[j][3] : 0.f); \
                  *(u32x2*)(ap + c * 144 + s0_ * 2) = wa; } } \
            P4_WRITE_V(X); \
            asm volatile("s_waitcnt vmcnt(0)" ::: "memory");     \
            __syncthreads(); \
            if ((PUB) > 0 && tid == 0) __hip_atomic_store(prog + bh * 16, (unsigned)(PUB), __ATOMIC_RELAXED, __HIP_MEMORY_SCOPE_AGENT); } while (0)
#define P4_STEP(n_, CUR, X, Y) do { const char* B = lds + (CUR) * BUF; \
            _Pragma("unroll") for (int vt = 0; vt < 2; ++vt) _Pragma("unroll") for (int cs = 0; cs < 2; ++cs) { \
                const v4i16_t lo_ = __builtin_amdgcn_ds_read_tr16_b64_v4i16((LAS v4i16_t*)(vtr0 + cs * 32 * 272 + vt * 32)); \
                const v4i16_t hi_ = __builtin_amdgcn_ds_read_tr16_b64_v4i16((LAS v4i16_t*)(vtr0 + cs * 32 * 272 + vt * 32 + 4 * 272)); \
                vb[vt][cs] = (bf16x8){lo_[0], lo_[1], lo_[2], lo_[3], hi_[0], hi_[1], hi_[2], hi_[3]}; } \
            P4_LOAD(X, ((n_) + 2 < 64) ? (n_) + 2 : 63); \
            f32x4 oo[2][2]; \
            _Pragma("unroll") for (int ml = 0; ml < 2; ++ml) { oo[ml][0] = (f32x4){0.f, 0.f, 0.f, 0.f}; oo[ml][1] = (f32x4){0.f, 0.f, 0.f, 0.f}; \
                _Pragma("unroll") for (int ks = 0; ks < 2; ++ks) { const bf16x8 Bq = *(const bf16x8*)(B + O_AT + (32 * kh + 16 * ml + r) * 144 + ks * 64 + gq * 16); \
                    _Pragma("unroll") for (int vt = 0; vt < 2; ++vt) oo[ml][vt] = __builtin_amdgcn_mfma_f32_16x16x32_bf16(vb[vt][ks], Bq, oo[ml][vt], 0, 0, 0); } } \
            _Pragma("unroll") for (int hf = 0; hf < 2; ++hf) _Pragma("unroll") for (int ksl = 0; ksl < 2; ++ksl) { const int ksg = 2 * (hf == 0 ? kh : 1 - kh) + ksl; u32x4 sf_[2]; \
                _Pragma("unroll") for (int vt = 0; vt < 2; ++vt) sf_[vt] = *(const u32x4*)((hf == 0 ? (const char*)xs_own : xs_par) + (ksl * 2 + vt) * 1024); \
                _Pragma("unroll") for (int ml = 0; ml < 2; ++ml) { const char* qa = B + O_QD + (32 * kh + 16 * ml + r) * 272 + ksg * 64 + gq * 8; \
                    const u32x2 a0 = *(const u32x2*)qa, a1 = *(const u32x2*)(qa + 32); const u32x4 aw = {a0.x, a0.y, a1.x, a1.y}; \
                    _Pragma("unroll") for (int vt = 0; vt < 2; ++vt) oo[ml][vt] = __builtin_amdgcn_mfma_f32_16x16x32_bf16(__builtin_bit_cast(bf16x8, sf_[vt]), __builtin_bit_cast(bf16x8, aw), oo[ml][vt], 0, 0, 0); } } \
            float* part = (float*)(lds + O_PART) + (CUR) * 256; \
            _Pragma("unroll") for (int ml = 0; ml < 2; ++ml) { float s_ = 0.f; \
                _Pragma("unroll") for (int vt = 0; vt < 2; ++vt) s_ += (oo[ml][vt][0] * oo[ml][vt][0] + oo[ml][vt][1] * oo[ml][vt][1]) + (oo[ml][vt][2] * oo[ml][vt][2] + oo[ml][vt][3] * oo[ml][vt][3]); \
                s_ += __shfl_xor(s_, 16); s_ += __shfl_xor(s_, 32); if (gq == 0) part[(32 * kh + 16 * ml + r) * 4 + vg] = s_; } \
            _Pragma("unroll") for (int i = 0; i < 4; ++i) { const f32x4 dlv = *(const f32x4*)(B + O_DL + (64 * kh + 16 * i + 4 * gq) * 4); st[i][0] = st[i][0] * dlv; st[i][1] = st[i][1] * dlv; \
                _Pragma("unroll") for (int cs = 0; cs < 2; ++cs) { const bf16x8 A = *(const bf16x8*)(B + O_KT + (64 * kh + 16 * i + r) * 144 + cs * 64 + gq * 16); \
                    _Pragma("unroll") for (int vt = 0; vt < 2; ++vt) st[i][vt] = __builtin_amdgcn_mfma_f32_16x16x32_bf16(A, vb[vt][cs], st[i][vt], 0, 0, 0); } } \
            P4_PREP(Y, (CUR) ^ 1, (n_)); \
            { bf16_t* op = R0 + ((size_t)bh * SEQ + (size_t)(n_) * 64) * HD + 32 * vg + 4 * gq; \
              _Pragma("unroll") for (int ml = 0; ml < 2; ++ml) { const int c = 32 * kh + 16 * ml + r; const f32x4 p0 = *(const f32x4*)(part + c * 4); \
                const float rs = __builtin_amdgcn_rsqf(((p0.x + p0.y) + (p0.z + p0.w)) * (1.f / HD) + EPS); \
                const f32x4 ov0 = oo[ml][0] * og0 * rs, ov1 = oo[ml][1] * og1 * rs; u32x2 pk0, pk1; pk0.x = cvt_pk_bf16(ov0[0], ov0[1]); pk0.y = cvt_pk_bf16(ov0[2], ov0[3]); pk1.x = cvt_pk_bf16(ov1[0], ov1[1]); pk1.y = cvt_pk_bf16(ov1[2], ov1[3]); \
                if (!dry) { __hip_atomic_store((unsigned long long*)(op + (size_t)c * HD), __builtin_bit_cast(unsigned long long, pk0), __ATOMIC_RELAXED, __HIP_MEMORY_SCOPE_AGENT); \
                            __hip_atomic_store((unsigned long long*)(op + (size_t)c * HD + 16), __builtin_bit_cast(unsigned long long, pk1), __ATOMIC_RELAXED, __HIP_MEMORY_SCOPE_AGENT); } else asm volatile("" :: "v"(pk0), "v"(pk1)); } } } while (0)
        P4_LOAD(A, 0); P4_LOAD(B, 1);
        __syncthreads();
        P4_PREP(A, 0, 0);
        for (int n = 0; n < 64; n += 2) { P4_STEP(n, 0, A, B); P4_STEP(n + 1, 1, B, A); }
        asm volatile("s_waitcnt vmcnt(0)" ::: "memory");
        __syncthreads();
        if (tid == 0) __hip_atomic_store(prog + bh * 16, 64u, __ATOMIC_RELAXED, __HIP_MEMORY_SCOPE_AGENT);
#undef P4_LOAD
#undef P4_WRITE_V
#undef P4_PREP
#undef P4_PACK
#undef P4_STEP
    }
}

#define XB_TMO      128
#define XB_XCNT(j)  (256  + 64 * (j))
#define XB_XSUB(j)  (1280 + 64 * (j))
#define XB_XGEN(j)  (2304 + 64 * (j))
#define XB_TOP      3328
#define XB_TOPGEN   3392
#define XCD_BAR_WORDS 3456
#define XB_SPIN_CAP (1u << 22)
__device__ __forceinline__ unsigned xb_ld(unsigned* p)              { return __hip_atomic_load(p, __ATOMIC_RELAXED, __HIP_MEMORY_SCOPE_AGENT); }
__device__ __forceinline__ unsigned xb_add(unsigned* p, unsigned v) { return __hip_atomic_fetch_add(p, v, __ATOMIC_RELAXED, __HIP_MEMORY_SCOPE_AGENT); }
__device__ __forceinline__ unsigned xb_xcc_id() { return (unsigned)__builtin_amdgcn_s_getreg((3 << 11) | 20) & 0xFu; }
#define XB_SPIN(cond, bar) do { unsigned _sp = 0; while (cond) { __builtin_amdgcn_s_sleep(1); \
    if ((++_sp & 255u) == 0u) { if (xb_ld(&(bar)[XB_TMO])) break; if (_sp > XB_SPIN_CAP) { atomicAdd(&(bar)[XB_TMO], 1u); break; } } } } while (0)
struct XcdBarrier { unsigned* bar; unsigned x; volatile LAS unsigned* st; };
__device__ __forceinline__ XcdBarrier xcd_barrier_post(unsigned* bar, volatile LAS unsigned* st) {
    XcdBarrier b; b.bar = bar; b.x = xb_xcc_id(); b.st = st;
    if (threadIdx.x == 0) (void)xb_add(&bar[XB_XCNT(b.x)], 1u);
    return b;
}
__device__ __forceinline__ void xcd_barrier_complete(unsigned* bar, unsigned x, unsigned& nloc, unsigned& nx) {
    const unsigned G = gridDim.x * gridDim.y * gridDim.z;
    unsigned sum, cnt, mine, sp = 0u;
    for (;;) {
        sum = 0u; cnt = 0u; mine = 0u;
#pragma unroll
        for (unsigned j = 0; j < 16; ++j) { const unsigned c = xb_ld(&bar[XB_XCNT(j)]); sum += c; cnt += (c > 0u) ? 1u : 0u; mine = (j == x) ? c : mine; }
        if (sum == G) break;
        __builtin_amdgcn_s_sleep(1);
        if ((++sp & 255u) == 0u) { if (xb_ld(&bar[XB_TMO])) break; if (sp > XB_SPIN_CAP) { atomicAdd(&bar[XB_TMO], 1u); break; } }
    }
    nloc = mine > 0u ? mine : 1u; nx = cnt > 0u ? cnt : 1u;
}
__device__ __forceinline__ void xcd_barrier(unsigned* bar_, volatile LAS unsigned* st_, int wv) {
    const int tid0 = otid(wv);
    asm volatile("" : "+s"(bar_));
    XcdBarrier b; b.bar = bar_; b.st = st_; b.x = 0;
    asm volatile("s_waitcnt vmcnt(0)" ::: "memory");
    __syncthreads();
    if (tid0 == 0) {
        unsigned* bar = b.bar; b.x = xb_xcc_id();
        __builtin_amdgcn_s_waitcnt(0);
        unsigned nloc = b.st[0], nx = b.st[1];
        if (nloc == 0u) { xcd_barrier_complete(bar, b.x, nloc, nx); b.st[0] = nloc; b.st[1] = nx; }
        const unsigned old = xb_add(&bar[XB_XSUB(b.x)], 1u);
        const unsigned gen = old / nloc;
        if (old + 1u == (gen + 1u) * nloc) {
            __builtin_amdgcn_fence(__ATOMIC_RELEASE, "agent");
            asm volatile("s_waitcnt vmcnt(0)" ::: "memory");
            const unsigned og = xb_add(&bar[XB_TOP], 1u);
            const unsigned tg = og / nx;
            if (og + 1u == (tg + 1u) * nx) xb_add(&bar[XB_TOPGEN], 1u);
            else XB_SPIN(xb_ld(&bar[XB_TOPGEN]) == tg, bar);
            __builtin_amdgcn_fence(__ATOMIC_ACQUIRE, "agent");
            xb_add(&bar[XB_XGEN(b.x)], 1u);
            asm volatile("s_waitcnt vmcnt(0)" ::: "memory");
        } else {
            XB_SPIN(xb_ld(&bar[XB_XGEN(b.x)]) == gen, bar);
            __builtin_amdgcn_fence(__ATOMIC_ACQUIRE, "agent");
            asm volatile("s_waitcnt vmcnt(0)" ::: "memory");
        }
    }
    __syncthreads();
}

__global__ void __launch_bounds__(512, 2) yoco_fwd(Args a) {
    extern __shared__ __attribute__((aligned(16))) unsigned char lds_raw[];
    char* lds = (char*)lds_raw; LAS unsigned char* ldsl = (LAS unsigned char*)lds_raw;
    cg::grid_group grid = cg::this_grid();
    const int wv = __builtin_amdgcn_readfirstlane((int)threadIdx.x >> 6);
    unsigned char* ws = a.ws;
    bf16_t* R0 = (bf16_t*)(ws + WS_R0); bf16_t* R1 = (bf16_t*)(ws + WS_R1); bf16_t* R2 = (bf16_t*)(ws + WS_R2);
    bf16_t* XA = (bf16_t*)(ws + WS_XA); bf16_t* H0 = (bf16_t*)a.out;
    const float* MOD0 = (const float*)(ws + WS_MOD0); const float* MOD1 = (const float*)(ws + WS_MOD1); const float* KVMOD = (const float*)(ws + WS_KVMOD);
    float* LSG = (float*)(ws + WS_LSG);
    const int G = gridDim.x, c = blockIdx.x;
    constexpr size_t TS = 64 * MiB;

    unsigned* barw = (unsigned*)(ws + WS_SM + 786432);
    volatile LAS unsigned* bst = (volatile LAS unsigned*)(ldsl + 143360);
    if (threadIdx.x == 0) { bst[0] = 0u; bst[1] = 0u; }
    if (a.one == 0) grid.sync();
    (void)xcd_barrier_post(barw, bst);
#define GSYNC() xcd_barrier((unsigned*)(a.ws + WS_SM + 786432), (volatile LAS unsigned*)(ldsl + 143360), wv)
    p0_prologue(a, lds, wv);
    GSYNC();
    norm_phase<false, false>(a.x, a.norm_g, MOD0, MOD0 + 1024, 3072, H0, nullptr, nullptr, nullptr, 0, nullptr, nullptr, nullptr, nullptr, lds, wv);
    GSYNC();
    { pg8::Gemm g{H0, (const bf16_t*)(ws + WS_W1), TOK, 6144, DM, 2048u, 256, (size_t)4096 * 2048}; pg8::StaticOrder S; S.init(TOK, 6144, G, c);
      pg8::EpiHead E{R0, TS}; pg8::gemm_phase(ldsl, g, S, E, wv);
    }
    GSYNC();
    unsigned* prog = (unsigned*)(ws + WS_SM + 819200);
    { pg8::Gemm g{H0, (const bf16_t*)(ws + WS_W1) + (size_t)6144 * DM, TOK, 2048, DM, 2048u, 256, (size_t)4096 * 2048};
      if (G == 256) {
          if (c < 128) p4_scan(a, lds, 0, wv, prog);
          else { pg8::EarlyOrder S{c - 128}; pg8::EpiMulSiluWait E{R0, prog}; pg8::gemm_phase(ldsl, g, S, E, wv); }
          GSYNC();
          { pg8::RestOrder S{c}; pg8::EpiMulSilu E{R0}; pg8::gemm_phase(ldsl, g, S, E, wv); }
      } else {
          p4_scan(a, lds, 0, wv, prog);
          GSYNC();
          { pg8::StaticOrder S; S.init(TOK, 2048, G, c); pg8::EpiMulSilu E{R0}; pg8::gemm_phase(ldsl, g, S, E, wv); }
      } }
    GSYNC();
    { pg8::Gemm g{R0, (const bf16_t*)(ws + WS_W2), TOK, DM, WD, 256u, (size_t)SEQ * 256, (size_t)16 * SEQ * 256}; pg8::StaticOrder S; S.init(TOK, DM, G, c);
      pg8::EpiRes E{a.x, a.out, MOD0 + 2048}; pg8::gemm_phase(ldsl, g, S, E, wv);
    }
    GSYNC();
    norm_phase<true, true>(a.out, a.kv_norm_g, KVMOD, KVMOD + 1024, 2048, R0, a.norm_g + DM, MOD1, MOD1 + 1024, 3072, XA, (const float*)(ws + WS_WFL), a.kv_fb, LSG, lds, wv);
    GSYNC();
    cumsum_phase(LSG, (int*)(ws + WS_SM + 802816), a.k_norm_g, a.b_q_norm_g, lds, wv);
    { pg8::Gemm g{R0, (const bf16_t*)(ws + WS_W3KV), TOK, 4096, DM, 2048u, 256, (size_t)4096 * 2048}; pg8::StaticOrder S; S.init(TOK, 4096, G, c);
      pg8::EpiHeadNorm E{R1, TS, 1, a.k_norm_g, (LAS float*)(ldsl + 131072)}; pg8::gemm_phase(ldsl, g, S, E, wv);
    }
    GSYNC();
    { pg8::Gemm g{XA, (const bf16_t*)(ws + WS_W3Q), TOK, 2048, DM, 2048u, 256, (size_t)4096 * 2048}; pg8::StaticOrder S; S.init(TOK, 2048, G, c);
      pg8::EpiHeadNorm E{R0, TS, 1, a.b_q_norm_g, (LAS float*)(ldsl + 131072)}; pg8::gemm_phase(ldsl, g, S, E, wv); }
    GSYNC();
    att::phase(lds, R0, R1, R2, LSG, (const int*)(ws + WS_SM + 802816), R0, (bf16_t*)(ws + WS_SM + 716800), 2048, wv);
    GSYNC();
    { pg8::Gemm g{XA, (const bf16_t*)(ws + WS_W3G), TOK, 2048, DM, 2048u, 256, (size_t)4096 * 2048}; pg8::StaticOrder S; S.init(TOK, 2048, G, c);
      pg8::EpiMulSilu E{R0}; pg8::gemm_phase(ldsl, g, S, E, wv); }
    GSYNC();
    { pg8::Gemm g{R0, (const bf16_t*)(ws + WS_W4), TOK, DM, WD, 256u, (size_t)SEQ * 256, (size_t)16 * SEQ * 256}; pg8::StaticOrder S; S.init(TOK, DM, G, c);
      pg8::EpiRes E{a.out, a.out, MOD1 + 2048}; pg8::gemm_phase(ldsl, g, S, E, wv); }
}

extern "C" void kernel_launch(void* const* d_in, const int* in_sizes, int n_in, void* d_out, int out_size, void* d_ws, size_t ws_size, hipStream_t stream) {
    static int grid = 0;
    if (grid == 0) {
        int dev = 0, cus = 0, per_cu = 0;
        hipGetDevice(&dev); hipDeviceGetAttribute(&cus, hipDeviceAttributeMultiprocessorCount, dev);
        hipFuncSetAttribute((const void*)yoco_fwd, hipFuncAttributeMaxDynamicSharedMemorySize, LDS_BYTES);
        hipOccupancyMaxActiveBlocksPerMultiprocessor(&per_cu, (const void*)yoco_fwd, 512, LDS_BYTES);
        (void)hipGetLastError();
        if (cus <= 0) cus = 256;
        grid = cus;
        if (per_cu < 1) fprintf(stderr, "kernel_launch: occupancy query reports %d blocks/CU\n", per_cu);
        if (ws_size < 512 * MiB) fprintf(stderr, "kernel_launch: workspace too small (%zu)\n", ws_size);
    }
    if (hipMemsetAsync((char*)d_ws + WS_SM + 786432, 0, 40960, stream) != hipSuccess) fprintf(stderr, "kernel_launch: memset of barrier words failed\n");
    Args a{};
    const float** pp = (const float**)&a;
    for (int i = 0; i < 18; ++i) pp[i] = (const float*)d_in[i];
    a.out = (float*)d_out; a.ws = (unsigned char*)d_ws; a.one = 1;
    void* args[] = {&a};
    hipError_t e = hipLaunchCooperativeKernel((const void*)yoco_fwd, dim3(grid), dim3(512), args, LDS_BYTES, stream);
    if (e != hipSuccess) fprintf(stderr, "cooperative launch failed: %s (grid %d)\n", hipGetErrorString(e), grid);
}
```

```cpp
#include <hip/hip_runtime.h>
#include <hip/hip_cooperative_groups.h>
#include <cstdio>
#include <cstdint>
namespace cg = cooperative_groups;

#define LAS __attribute__((address_space(3)))
typedef unsigned short bf16_t;
typedef short bf16x8 __attribute__((ext_vector_type(8)));
typedef short s16x4 __attribute__((ext_vector_type(4)));
typedef float f32x4 __attribute__((ext_vector_type(4)));
typedef float f32x16 __attribute__((ext_vector_type(16)));
typedef unsigned u32x4 __attribute__((ext_vector_type(4)));
typedef unsigned u32x2 __attribute__((ext_vector_type(2)));

constexpr int NB = 8, SEQ = 4096, DM = 1024, WD = 2048, NH = 16, HD = 128, BH = NB * NH, TOK = NB * SEQ;
constexpr float EPS = 1e-6f;
constexpr size_t MiB = 1u << 20;
constexpr size_t WS_R0 = 0, WS_R1 = 128 * MiB, WS_R2 = 256 * MiB, WS_XA = 384 * MiB;
constexpr size_t WS_W1 = 448 * MiB, WS_W2 = 464 * MiB, WS_W3KV = 468 * MiB, WS_W3Q = 476 * MiB, WS_W3G = 480 * MiB, WS_W4 = 484 * MiB;
constexpr size_t WS_SM = 488 * MiB;
constexpr size_t WS_MOD0 = WS_SM, WS_MOD1 = WS_SM + 98304, WS_KVMOD = WS_SM + 196608, WS_LB = WS_SM + 262144, WS_WFL = WS_SM + 270336;
constexpr size_t WS_LSG = WS_SM + 1 * MiB, WS_DL = WS_SM + 4 * MiB;
constexpr int LDS_BYTES = 147456;

__device__ __forceinline__ float bf2f(unsigned short h) { return __uint_as_float(((unsigned)h) << 16); }
typedef float f32x2_t __attribute__((ext_vector_type(2))); typedef __bf16 bf16x2_t __attribute__((ext_vector_type(2)));
__device__ __forceinline__ unsigned cvt_pk_bf16(float lo, float hi) { f32x2_t v = {lo, hi}; bf16x2_t b = __builtin_convertvector(v, bf16x2_t); return __builtin_bit_cast(unsigned, b); }
__device__ __forceinline__ unsigned short f2bf(float f) { return (unsigned short)(cvt_pk_bf16(f, 0.f) & 0xffffu); }
__device__ __forceinline__ float wave_sum(float v) {
#pragma unroll
    for (int o = 1; o < 64; o <<= 1) v += __shfl_xor(v, o);
    return v;
}
__device__ __forceinline__ int otid(int wv) { int t = wv * 64 + (int)__builtin_amdgcn_mbcnt_hi(~0u, __builtin_amdgcn_mbcnt_lo(~0u, 0u)); asm volatile("" : "+v"(t)); return t; }
__device__ __forceinline__ float silu_f(float x) { return x * __builtin_amdgcn_rcpf(1.f + __builtin_amdgcn_exp2f(-1.4426950408889634f * x)); }

namespace pg8 {
constexpr int BM = 256, BK = 64, HALF = 128, HTB = HALF * BK * 2, STAGE_BYTES = 8 * HTB, NXCD = 8, WGM = 8;
__host__ __device__ __forceinline__ int lds_byte(int r, int c) { const int st = (r >> 4) * 2 + (c >> 5), rr = r & 15, cc = c & 31, ob = rr * 64 + cc * 2; return st * 1024 + (ob ^ (((ob >> 9) & 1) << 5)); }
__host__ __device__ __forceinline__ void stage_rc(int b, int& R, int& C) { const int st = b / 1024, sb = b % 1024, swz = sb ^ (((sb >> 9) & 1) << 5); R = (st >> 1) * 16 + swz / 64; C = (st & 1) * 32 + (swz % 64) / 2; }
__host__ __device__ __forceinline__ int perm32(int rho) { const int n = rho >> 4, i = rho & 15; return 8 * (i >> 2) + 4 * n + (i & 3); }

struct Unit { int pm, pn; };
struct Gemm { const bf16_t* A; const bf16_t* Bt; int M, N, K; unsigned lda; size_t hsA, bsA; };

struct StaticOrder {
    int nM, nN, nwg, G, c;
    __device__ void init(int M, int N, int G_, int c_) { nM = M / BM; nN = N / BM; nwg = nM * nN; G = G_; c = c_; }
    __device__ bool next(int i, Unit& u) const {
        const long L = (long)i * G + c; if (L >= nwg) return false;
        int wgid = (int)L; { const int q = nwg / NXCD, r = nwg % NXCD, xcd = wgid % NXCD, off = wgid / NXCD; wgid = (xcd < r ? xcd * (q + 1) : r * (q + 1) + (xcd - r) * q) + off; }
        const int nig = WGM * nN, gid = wgid / nig, fm = gid * WGM, gsz = (nM - fm) < WGM ? (nM - fm) : WGM;
        u.pm = fm + ((wgid % nig) % gsz); u.pn = (wgid % nig) / gsz; return true;
    }
};

struct EarlyOrder {
    int e;
    __device__ bool next(int i, Unit& u) const { if (i >= 7) return false; const int uu = i * 128 + e, rp = uu >> 6, idx = uu & 63; u.pm = (idx >> 3) * 16 + rp; u.pn = idx & 7; return true; }
};
struct RestOrder {
    int c;
    __device__ bool next(int i, Unit& u) const { if (i >= 1) return false; const int rp = 14 + (c >> 6), idx = c & 63; u.pm = (idx >> 3) * 16 + rp; u.pn = idx & 7; return true; }
};

struct EpiHead {
    bf16_t* base0; size_t tstride;
    __device__ __forceinline__ void operator()(const f32x4 (&acc)[2][2][4][2], const Unit& u, int wr, int wc, int fr, int fq) const {
        const int b = u.pm >> 4, s0 = (u.pm & 15) * 256 + wr * 64 + fr, t = u.pn >> 3, hd0 = (u.pn & 7) * 2;
        bf16_t* base = base0 + (size_t)t * tstride + wc * 32 + 8 * fq;
#pragma unroll
        for (int ai = 0; ai < 2; ++ai)
#pragma unroll
            for (int m = 0; m < 4; ++m)
#pragma unroll
                for (int bj = 0; bj < 2; ++bj) {
                    const f32x4 v0 = acc[ai][bj][m][0], v1 = acc[ai][bj][m][1];
                    u32x4 w; w.x = cvt_pk_bf16(v0[0], v0[1]); w.y = cvt_pk_bf16(v0[2], v0[3]); w.z = cvt_pk_bf16(v1[0], v1[1]); w.w = cvt_pk_bf16(v1[2], v1[3]);
                    *(u32x4*)(base + ((size_t)(b * 16 + hd0 + bj) * SEQ + s0 + ai * HALF + m * 16) * HD) = w;
                }
    }
};
struct EpiHeadNorm {
    bf16_t* base0; size_t tstride; int nnorm; const float* g; LAS float* xch;
    __device__ __forceinline__ void operator()(const f32x4 (&acc)[2][2][4][2], const Unit& u, int wr, int wc, int fr, int fq) const {
        const int b = u.pm >> 4, s0 = (u.pm & 15) * 256 + wr * 64 + fr, t = u.pn >> 3, hd0 = (u.pn & 7) * 2;
        bf16_t* base = base0 + (size_t)t * tstride + wc * 32 + 8 * fq;
        if (t < nnorm) {
#pragma unroll
            for (int ai = 0; ai < 2; ++ai)
#pragma unroll
                for (int m = 0; m < 4; ++m)
#pragma unroll
                    for (int bj = 0; bj < 2; ++bj) { const f32x4 v0 = acc[ai][bj][m][0], v1 = acc[ai][bj][m][1];
                        float sq = ((v0[0] * v0[0] + v0[1] * v0[1]) + (v0[2] * v0[2] + v0[3] * v0[3])) + ((v1[0] * v1[0] + v1[1] * v1[1]) + (v1[2] * v1[2] + v1[3] * v1[3]));
                        sq += __shfl_xor(sq, 16); sq += __shfl_xor(sq, 32);
                        if (fq == 0) xch[((ai * HALF + wr * 64 + m * 16 + fr) * 2 + bj) * 4 + wc] = sq; }
            asm volatile("s_waitcnt lgkmcnt(0)" ::: "memory"); __builtin_amdgcn_s_barrier(); asm volatile("" ::: "memory");
            const f32x4 g0 = *(const f32x4*)(g + wc * 32 + 8 * fq), g1 = *(const f32x4*)(g + wc * 32 + 8 * fq + 4);
#pragma unroll
            for (int ai = 0; ai < 2; ++ai)
#pragma unroll
                for (int m = 0; m < 4; ++m)
#pragma unroll
                    for (int bj = 0; bj < 2; ++bj) {
                        const f32x4 p = *(const LAS f32x4*)(xch + ((ai * HALF + wr * 64 + m * 16 + fr) * 2 + bj) * 4);
                        const float rs = __builtin_amdgcn_rsqf(((p[0] + p[1]) + (p[2] + p[3])) * (1.f / 128.f) + EPS);
                        const f32x4 v0 = acc[ai][bj][m][0] * g0 * rs, v1 = acc[ai][bj][m][1] * g1 * rs;
                        u32x4 w; w.x = cvt_pk_bf16(v0[0], v0[1]); w.y = cvt_pk_bf16(v0[2], v0[3]); w.z = cvt_pk_bf16(v1[0], v1[1]); w.w = cvt_pk_bf16(v1[2], v1[3]);
                        *(u32x4*)(base + ((size_t)(b * 16 + hd0 + bj) * SEQ + s0 + ai * HALF + m * 16) * HD) = w;
                    }
        } else {
#pragma unroll
            for (int ai = 0; ai < 2; ++ai)
#pragma unroll
                for (int m = 0; m < 4; ++m)
#pragma unroll
                    for (int bj = 0; bj < 2; ++bj) {
                        const f32x4 v0 = acc[ai][bj][m][0], v1 = acc[ai][bj][m][1];
                        u32x4 w; w.x = cvt_pk_bf16(v0[0], v0[1]); w.y = cvt_pk_bf16(v0[2], v0[3]); w.z = cvt_pk_bf16(v1[0], v1[1]); w.w = cvt_pk_bf16(v1[2], v1[3]);
                        *(u32x4*)(base + ((size_t)(b * 16 + hd0 + bj) * SEQ + s0 + ai * HALF + m * 16) * HD) = w;
                    }
        }
    }
};
struct EpiMulSilu {
    bf16_t* X;
    __device__ __forceinline__ void operator()(const f32x4 (&acc)[2][2][4][2], const Unit& u, int wr, int wc, int fr, int fq) const {
        const int b = u.pm >> 4, s0 = (u.pm & 15) * 256 + wr * 64 + fr, hd0 = (u.pn & 7) * 2;
        bf16_t* base = X + wc * 32 + 8 * fq;
        u32x4 pre[8][2];
#define EM_PTR(bt, bj) ((u32x4*)(base + ((size_t)(b * 16 + hd0 + (bj)) * SEQ + s0 + ((bt) >> 2) * HALF + ((bt) & 3) * 16) * HD))
#pragma unroll
        for (int bt = 0; bt < 8; ++bt) { pre[bt][0] = *EM_PTR(bt, 0); pre[bt][1] = *EM_PTR(bt, 1); }
        asm volatile("" ::: "memory");
#pragma unroll
        for (int bt = 0; bt < 8; ++bt) {
#pragma unroll
            for (int bj = 0; bj < 2; ++bj) {
                const u32x4 x = pre[bt][bj]; const f32x4 v0 = acc[bt >> 2][bj][bt & 3][0], v1 = acc[bt >> 2][bj][bt & 3][1];
                u32x4 w;
                w.x = cvt_pk_bf16(__uint_as_float(x.x << 16) * silu_f(v0[0]), __uint_as_float(x.x & 0xffff0000u) * silu_f(v0[1]));
                w.y = cvt_pk_bf16(__uint_as_float(x.y << 16) * silu_f(v0[2]), __uint_as_float(x.y & 0xffff0000u) * silu_f(v0[3]));
                w.z = cvt_pk_bf16(__uint_as_float(x.z << 16) * silu_f(v1[0]), __uint_as_float(x.z & 0xffff0000u) * silu_f(v1[1]));
                w.w = cvt_pk_bf16(__uint_as_float(x.w << 16) * silu_f(v1[2]), __uint_as_float(x.w & 0xffff0000u) * silu_f(v1[3]));
                *EM_PTR(bt, bj) = w;
            }
            asm volatile("" ::: "memory");
        }
#undef EM_PTR
    }
};
struct EpiMulSiluWait {
    bf16_t* X; unsigned* prog;
    __device__ __forceinline__ void operator()(const f32x4 (&acc)[2][2][4][2], const Unit& u, int wr, int wc, int fr, int fq) const {
        const int b = u.pm >> 4, s0 = (u.pm & 15) * 256 + wr * 64 + fr, hd0 = (u.pn & 7) * 2;
        { const unsigned need = 4u * (unsigned)(u.pm & 15) + 4u; unsigned* p0 = prog + (b * 16 + hd0) * 16; unsigned* p1 = p0 + 16; unsigned sp = 0;
          while ((__hip_atomic_load(p0, __ATOMIC_RELAXED, __HIP_MEMORY_SCOPE_AGENT) < need || __hip_atomic_load(p1, __ATOMIC_RELAXED, __HIP_MEMORY_SCOPE_AGENT) < need) && ++sp < (1u << 22)) __builtin_amdgcn_s_sleep(8);
          __builtin_amdgcn_fence(__ATOMIC_ACQUIRE, "agent"); asm volatile("s_waitcnt vmcnt(0)" ::: "memory"); }
        bf16_t* base = X + wc * 32 + 8 * fq;
        u32x4 pre[8][2];
#define EM_PTR(bt, bj) ((u32x4*)(base + ((size_t)(b * 16 + hd0 + (bj)) * SEQ + s0 + ((bt) >> 2) * HALF + ((bt) & 3) * 16) * HD))
#pragma unroll
        for (int bt = 0; bt < 8; ++bt) { pre[bt][0] = *EM_PTR(bt, 0); pre[bt][1] = *EM_PTR(bt, 1); }
        asm volatile("" ::: "memory");
#pragma unroll
        for (int bt = 0; bt < 8; ++bt) {
#pragma unroll
            for (int bj = 0; bj < 2; ++bj) {
                const u32x4 x = pre[bt][bj]; const f32x4 v0 = acc[bt >> 2][bj][bt & 3][0], v1 = acc[bt >> 2][bj][bt & 3][1];
                u32x4 w;
                w.x = cvt_pk_bf16(__uint_as_float(x.x << 16) * silu_f(v0[0]), __uint_as_float(x.x & 0xffff0000u) * silu_f(v0[1]));
                w.y = cvt_pk_bf16(__uint_as_float(x.y << 16) * silu_f(v0[2]), __uint_as_float(x.y & 0xffff0000u) * silu_f(v0[3]));
                w.z = cvt_pk_bf16(__uint_as_float(x.z << 16) * silu_f(v1[0]), __uint_as_float(x.z & 0xffff0000u) * silu_f(v1[1]));
                w.w = cvt_pk_bf16(__uint_as_float(x.w << 16) * silu_f(v1[2]), __uint_as_float(x.w & 0xffff0000u) * silu_f(v1[3]));
                *EM_PTR(bt, bj) = w;
            }
            asm volatile("" ::: "memory");
        }
#undef EM_PTR
    }
};
struct EpiRes {
    const float* base; float* out; const float* gate;
    __device__ __forceinline__ void operator()(const f32x4 (&acc)[2][2][4][2], const Unit& u, int wr, int wc, int fr, int fq) const {
        const int b = u.pm >> 4, row0 = u.pm * BM + wr * 64 + fr, col0 = u.pn * BM + wc * 32 + 8 * fq;
        f32x4 gv[2][2];
#pragma unroll
        for (int bj = 0; bj < 2; ++bj)
#pragma unroll
            for (int n = 0; n < 2; ++n) gv[bj][n] = *(const f32x4*)(gate + (size_t)b * 3072 + col0 + bj * HALF + 4 * n);
        f32x4 pre[2][2][2][2];
#define ER_OFF(bt, mm) ((size_t)(row0 + ((bt) >> 1) * HALF + (2 * ((bt) & 1) + (mm)) * 16) * DM + col0)
#define ER_LOAD(bt, sl) do { _Pragma("unroll") for (int mm = 0; mm < 2; ++mm) _Pragma("unroll") for (int bj = 0; bj < 2; ++bj) _Pragma("unroll") for (int n = 0; n < 2; ++n) \
            pre[sl][mm][bj][n] = *(const f32x4*)(base + ER_OFF(bt, mm) + bj * HALF + 4 * n); } while (0)
        ER_LOAD(0, 0);
#pragma unroll
        for (int bt = 0; bt < 4; ++bt) {
            if (bt + 1 < 4) { if (bt & 1) ER_LOAD(bt + 1, 0); else ER_LOAD(bt + 1, 1); }
            asm volatile("" ::: "memory");
#pragma unroll
            for (int mm = 0; mm < 2; ++mm)
#pragma unroll
                for (int bj = 0; bj < 2; ++bj)
#pragma unroll
                    for (int n = 0; n < 2; ++n)
                        *(f32x4*)(out + ER_OFF(bt, mm) + bj * HALF + 4 * n) = pre[bt & 1][mm][bj][n] + gv[bj][n] * acc[bt >> 1][bj][2 * (bt & 1) + mm][n];
            asm volatile("" ::: "memory");
        }
#undef ER_OFF
#undef ER_LOAD
    }
};

template <class Epi, class Sched>
__device__ __forceinline__ void gemm_phase(LAS unsigned char* lds, const Gemm g, const Sched& S, const Epi& E, int wv) {
    const int tid = otid(wv), wid = __builtin_amdgcn_readfirstlane(tid >> 6), lane = tid & 63, wr = wid >> 2, wc = wid & 3, fr = lane & 15, fq = lane >> 4;
    const int K = g.K, nt = K / BK;
    unsigned voffA[2], voffB[2];
#pragma unroll
    for (int i = 0; i < 2; ++i) { int R, C; stage_rc(tid * 16 + i * 8192, R, C); const int Rb = (R & ~31) + perm32(R & 31);
        voffA[i] = (unsigned)R * g.lda + (unsigned)C * 2u; voffB[i] = (unsigned)(Rb * K + C) * 2u; }
    const size_t kstep = (size_t)(BK * 2);
    const size_t hstepA = (size_t)HALF * g.lda, hstepB = (size_t)HALF * K * 2, tstepB = 2 * hstepB, hsA = g.hsA;
    const unsigned ldsw = (unsigned)wid * 1024u;
    const int aoff = lds_byte(wr * 64 + fr, fq * 8), boff = lds_byte(wc * 32 + fr, fq * 8);
#define PG8_SA(b, h) (((b) * 2 + (h)) * HTB)
#define PG8_SB(b, h) ((4 + (b) * 2 + (h)) * HTB)
#define PG8_STAGE(bufoff, gbase, voff) do { _Pragma("unroll") for (int _i = 0; _i < 2; ++_i) \
        __builtin_amdgcn_global_load_lds((const unsigned*)((const char*)(gbase) + (voff)[_i]), (LAS unsigned*)(lds + (bufoff) + ldsw + _i * 8192), 16, 0, 0); } while (0)
#define PG8_LDA(dst, b, h) do { _Pragma("unroll") for (int m = 0; m < 4; ++m) _Pragma("unroll") for (int k = 0; k < 2; ++k) dst[m][k] = *(const LAS bf16x8*)(lds + PG8_SA(b, h) + aoff + m * 2048 + k * 1024); } while (0)
#define PG8_LDB(dst, b, h) do { _Pragma("unroll") for (int n = 0; n < 2; ++n) _Pragma("unroll") for (int k = 0; k < 2; ++k) dst[n][k] = *(const LAS bf16x8*)(lds + PG8_SB(b, h) + boff + n * 2048 + k * 1024); } while (0)
#define PG8_MMA(ai, bj, At, Bt) do { __builtin_amdgcn_s_setprio(1); _Pragma("unroll") for (int m = 0; m < 4; ++m) _Pragma("unroll") for (int n = 0; n < 2; ++n) _Pragma("unroll") for (int k = 0; k < 2; ++k) \
        acc[ai][bj][m][n] = __builtin_amdgcn_mfma_f32_16x16x32_bf16(Bt[n][k], At[m][k], acc[ai][bj][m][n], 0, 0, 0); __builtin_amdgcn_s_setprio(0); } while (0)
#define PG8_WAIT_V(n) asm volatile("s_waitcnt vmcnt(" #n ")" ::: "memory")
#define PG8_WAIT_L(n) asm volatile("s_waitcnt lgkmcnt(" #n ")" ::: "memory")
#define PG8_BAR __builtin_amdgcn_s_barrier()
#define PG8_SCHED __builtin_amdgcn_sched_barrier(0)
#define PG8_ATILE(u) ((const char*)g.A + (size_t)((u).pm >> 4) * g.bsA + (size_t)((u).pm & 15) * 256 * g.lda)
    Unit cur, nxt; int ui = 0;
    if (!S.next(0, cur)) return;
    f32x4 acc[2][2][4][2];
#pragma unroll
    for (int a = 0; a < 2; ++a)
#pragma unroll
        for (int b = 0; b < 2; ++b)
#pragma unroll
            for (int m = 0; m < 4; ++m)
#pragma unroll
                for (int n = 0; n < 2; ++n) acc[a][b][m][n] = (f32x4){0.f, 0.f, 0.f, 0.f};
    bf16x8 At[4][2], B0[2][2], B1[2][2];
    const char* cA = PG8_ATILE(cur); const char* cB = (const char*)g.Bt + (size_t)cur.pn * tstepB;
    PG8_STAGE(PG8_SB(0, 0), cB, voffB); PG8_STAGE(PG8_SB(0, 1), cB + hstepB, voffB); PG8_STAGE(PG8_SA(0, 0), cA, voffA); PG8_STAGE(PG8_SA(0, 1), cA + hstepA, voffA);
    if (wr == 1) PG8_BAR;
    PG8_WAIT_V(2); PG8_BAR;
    PG8_STAGE(PG8_SB(1, 0), cB + kstep, voffB); PG8_STAGE(PG8_SA(1, 0), cA + kstep, voffA); PG8_STAGE(PG8_SB(1, 1), cB + hstepB + kstep, voffB);
    PG8_WAIT_V(6); PG8_BAR;
    for (;;) {
        const bool has_next = S.next(ui + 1, nxt);
        const char* nA = has_next ? PG8_ATILE(nxt) : cA; const char* nB = has_next ? (const char*)g.Bt + (size_t)nxt.pn * tstepB : cB;
        for (int t = 0; t < nt; t += 2) {
            const bool last = (t == nt - 2);
            const char* a1 = cA + (size_t)(t >> 1) * hsA + kstep;
            const char* a2 = last ? nA : cA + (size_t)((t >> 1) + 1) * hsA; const char* b2 = last ? nB : cB + (size_t)(t + 2) * kstep;
            const char* a3 = a2 + kstep; const char* b3 = b2 + kstep;
            PG8_LDB(B0, 0, 0); PG8_LDB(B1, 0, 1); PG8_SCHED; PG8_LDA(At, 0, 0); PG8_STAGE(PG8_SA(1, 1), a1 + hstepA, voffA);
            PG8_WAIT_V(8); PG8_WAIT_L(0); PG8_BAR; PG8_MMA(0, 0, At, B0); PG8_MMA(0, 1, At, B1); PG8_BAR; PG8_SCHED;
            PG8_LDA(At, 0, 1); PG8_STAGE(PG8_SB(0, 0), b2, voffB); PG8_STAGE(PG8_SB(0, 1), b2 + hstepB, voffB); PG8_STAGE(PG8_SA(0, 0), a2, voffA);
            PG8_WAIT_V(8); PG8_WAIT_L(0); PG8_BAR; PG8_MMA(1, 0, At, B0); PG8_MMA(1, 1, At, B1); PG8_BAR; PG8_SCHED;
            PG8_LDB(B0, 1, 0); PG8_LDB(B1, 1, 1); PG8_SCHED; PG8_LDA(At, 1, 0); PG8_STAGE(PG8_SA(0, 1), a2 + hstepA, voffA);
            PG8_WAIT_V(8); PG8_WAIT_L(0); PG8_BAR; PG8_MMA(0, 0, At, B0); PG8_MMA(0, 1, At, B1); PG8_BAR; PG8_SCHED;
            PG8_LDA(At, 1, 1); PG8_STAGE(PG8_SB(1, 0), b3, voffB); PG8_STAGE(PG8_SB(1, 1), b3 + hstepB, voffB); PG8_STAGE(PG8_SA(1, 0), a3, voffA);
            PG8_WAIT_V(8); PG8_WAIT_L(0); PG8_BAR; PG8_MMA(1, 0, At, B0); PG8_MMA(1, 1, At, B1); PG8_BAR; PG8_SCHED;
        }
        if (wr == 0) PG8_BAR;
        E(acc, cur, wr, wc, fr, fq);
        if (!has_next) break;
#pragma unroll
        for (int a = 0; a < 2; ++a)
#pragma unroll
            for (int b = 0; b < 2; ++b)
#pragma unroll
                for (int m = 0; m < 4; ++m)
#pragma unroll
                    for (int n = 0; n < 2; ++n) acc[a][b][m][n] = (f32x4){0.f, 0.f, 0.f, 0.f};
        cur = nxt; cA = nA; cB = nB; ++ui;
        if (wr == 1) PG8_BAR;
    }
    PG8_WAIT_V(0);
    PG8_BAR;
#undef PG8_SA
#undef PG8_SB
#undef PG8_STAGE
#undef PG8_LDA
#undef PG8_LDB
#undef PG8_MMA
#undef PG8_WAIT_V
#undef PG8_WAIT_L
#undef PG8_BAR
#undef PG8_SCHED
#undef PG8_ATILE
}
}

namespace att {
constexpr int D = 128, NW = 8, QBLK = 32, KVBLK = 64, QB = NW * QBLK;
constexpr int SHM_V = KVBLK * D * 2, SHM_K = KVBLK * D * 2;
constexpr int OFF_WS = 2 * SHM_V + 2 * SHM_K, OFF_G = OFF_WS + NW * 64 * 4, ATT_LDS = OFF_G + 512;
constexpr float SCALE = 0.08838834764831845f, C2 = 1.4426950408889634f * SCALE, THR2 = 24.f;
#define KSWZ(row, colB) ((row) * 256 + ((colB) ^ (((row) & 7) << 4)))
#define SBAR() __builtin_amdgcn_sched_barrier(0)
__device__ __forceinline__ int v_st(int k, int c) { const int kk = (k & ~0xC) | ((k & 4) << 1) | ((k & 8) >> 1); return ((kk >> 3) * 4 + (c >> 5)) * 512 + ((kk & 7) * 32 + (c & 31)) * 2; }
__device__ __forceinline__ int v_rd_base(int lane) { return ((lane & 3) << 3) | (((lane >> 2) & 3) << 6) | (((lane >> 4) & 1) << 5) | (((lane >> 5) & 1) << 8); }
constexpr int v_rd_off(int d0, int ks, int half) { return d0 * 512 + ks * 4096 + half * 2048; }
__device__ __forceinline__ int crow(int r, int hi) { return (r & 3) + 8 * (r >> 2) + 4 * hi; }
__device__ __forceinline__ bf16x8 load8(const bf16_t* p) { return *reinterpret_cast<const bf16x8*>(p); }
__device__ __forceinline__ void mask_tile(f32x16& p0, f32x16& p1, int dq, unsigned W) {
    const float NEG = -__builtin_inff();
#pragma unroll
    for (int r = 0; r < 16; ++r) {
        const int c = (r & 3) + 8 * (r >> 2);
        if ((unsigned)(dq - c) >= W) p0[r] = NEG;
        if ((unsigned)(dq - c - 32) >= W) p1[r] = NEG;
    }
}
__device__ __forceinline__ void partialSM(f32x16& p0, f32x16& p1, float& m_reg, float& mn, float& alpha) {
    float pmax = p0[0];
#pragma unroll
    for (int r = 1; r < 16; ++r) pmax = fmaxf(pmax, p0[r]);
#pragma unroll
    for (int r = 0; r < 16; ++r) pmax = fmaxf(pmax, p1[r]);
    { auto rr = __builtin_amdgcn_permlane32_swap(__float_as_uint(pmax), __float_as_uint(pmax), false, false);
      pmax = fmaxf(__uint_as_float(rr[0]), __uint_as_float(rr[1])); }
    if (__builtin_expect(__all((pmax - m_reg) * C2 <= THR2), 1)) { mn = m_reg; alpha = 1.f; }
    else { mn = fmaxf(m_reg, pmax); alpha = __builtin_amdgcn_exp2f((m_reg - mn) * C2); m_reg = mn; }
    const float mnL = -mn * C2;
#pragma unroll
    for (int r = 0; r < 16; ++r) { p0[r] = fmaf(p0[r], C2, mnL); p1[r] = fmaf(p1[r], C2, mnL); }
#pragma unroll
    for (int r = 0; r < 16; ++r) p0[r] = __builtin_amdgcn_exp2f(p0[r]);
}
__device__ __forceinline__ void finishSM(f32x16& p0, f32x16& p1, float alpha, float& l_reg, bf16x8& pa0, bf16x8& pa1, bf16x8& pa2, bf16x8& pa3) {
#pragma unroll
    for (int r = 0; r < 16; ++r) p1[r] = __builtin_amdgcn_exp2f(p1[r]);
    float ps = 0;
#pragma unroll
    for (int r = 0; r < 16; ++r) ps += p0[r];
#pragma unroll
    for (int r = 0; r < 16; ++r) ps += p1[r];
    { auto rr = __builtin_amdgcn_permlane32_swap(__float_as_uint(ps), __float_as_uint(ps), false, false);
      ps = __uint_as_float(rr[0]) + __uint_as_float(rr[1]); }
    l_reg = l_reg * alpha + ps;
#define PK4(P, B_, OUT) do { unsigned a0 = cvt_pk_bf16(P[B_+0], P[B_+1]), a1 = cvt_pk_bf16(P[B_+2], P[B_+3]);                          \
        unsigned b0 = cvt_pk_bf16(P[B_+4], P[B_+5]), b1 = cvt_pk_bf16(P[B_+6], P[B_+7]);                                             \
        auto r0 = __builtin_amdgcn_permlane32_swap(a0, b0, false, false); auto r1 = __builtin_amdgcn_permlane32_swap(a1, b1, false, false); \
        u32x4 w = {r0[0], r1[0], r0[1], r1[1]}; OUT = *reinterpret_cast<bf16x8*>(&w); } while (0)
    PK4(p0, 0, pa0); PK4(p0, 8, pa1); PK4(p1, 0, pa2); PK4(p1, 8, pa3);
#undef PK4
}
template <int KB>
__device__ __forceinline__ void qkt(f32x16& p0, f32x16& p1, const char* K_lds, int r32, int hi, const bf16x8* qr, const float* gl) {
#pragma unroll
    for (int i = 0; i < 4; ++i) { const f32x4 g0 = *(const f32x4*)(gl + 8 * i + 4 * hi), g1 = *(const f32x4*)(gl + 32 + 8 * i + 4 * hi);
#pragma unroll
        for (int j = 0; j < 4; ++j) { p0[4 * i + j] = g0[j]; p1[4 * i + j] = g1[j]; } }
    const char* kb[4];
#pragma unroll
    for (int dd = 0; dd < 4; ++dd) kb[dd] = K_lds + KB * SHM_K + KSWZ(r32, (dd * 16 + hi * 8) * 2);
#pragma unroll
    for (int d0 = 0; d0 < 8; ++d0) { const char* a = kb[d0 & 3] + (d0 >> 2) * 128;
        bf16x8 b0 = *reinterpret_cast<const bf16x8*>(a);
        bf16x8 b1 = *reinterpret_cast<const bf16x8*>(a + 32 * 256);
        p0 = __builtin_amdgcn_mfma_f32_32x32x16_bf16(b0, qr[d0], p0, 0, 0, 0);
        p1 = __builtin_amdgcn_mfma_f32_32x32x16_bf16(b1, qr[d0], p1, 0, 0, 0); }
}
template <int VB>
__device__ __forceinline__ void pv_tile(f32x16* o, int vb0, bf16x8 pa0, bf16x8 pa1, bf16x8 pa2, bf16x8 pa3) {
#define TRRD(dst, off) asm volatile("ds_read_b64_tr_b16 %0, %1 offset:%2" : "=&v"(dst) : "v"(vb0), "i"(off) : "memory")
#define PV_D0(d0) do { s16x4 l0, l1, l2, l3, h0, h1, h2, h3; constexpr int b_ = VB * SHM_V + v_rd_off(d0, 0, 0); \
        TRRD(l0, b_); TRRD(h0, b_ + 2048); TRRD(l1, b_ + 4096); TRRD(h1, b_ + 6144); TRRD(l2, b_ + 8192); TRRD(h2, b_ + 10240); TRRD(l3, b_ + 12288); TRRD(h3, b_ + 14336); \
        asm volatile("s_waitcnt lgkmcnt(0)" ::: "memory"); SBAR();   \
        o[d0] = __builtin_amdgcn_mfma_f32_32x32x16_bf16(pa0, (bf16x8){l0[0], l0[1], l0[2], l0[3], h0[0], h0[1], h0[2], h0[3]}, o[d0], 0, 0, 0);   \
        o[d0] = __builtin_amdgcn_mfma_f32_32x32x16_bf16(pa1, (bf16x8){l1[0], l1[1], l1[2], l1[3], h1[0], h1[1], h1[2], h1[3]}, o[d0], 0, 0, 0);   \
        o[d0] = __builtin_amdgcn_mfma_f32_32x32x16_bf16(pa2, (bf16x8){l2[0], l2[1], l2[2], l2[3], h2[0], h2[1], h2[2], h2[3]}, o[d0], 0, 0, 0);   \
        o[d0] = __builtin_amdgcn_mfma_f32_32x32x16_bf16(pa3, (bf16x8){l3[0], l3[1], l3[2], l3[3], h3[0], h3[1], h3[2], h3[3]}, o[d0], 0, 0, 0); } while (0)
    PV_D0(0); PV_D0(1); PV_D0(2); PV_D0(3);
#undef PV_D0
#undef TRRD
}
struct BlockRef { const bf16_t* Q; const bf16_t* K; const bf16_t* V; const float* G; bf16_t* O; int P0, jlo; };
struct Seam { bf16x8 qr[8]; bf16x8 st_v0, st_v1, st_k0, st_k1; float sg; };
#define ROW(p, k0, rr) ((p) + (size_t)((k0) + (rr)) * D + sc)
#define VMW() asm volatile("s_waitcnt vmcnt(0)" ::: "memory")
#define VMWN(n) asm volatile("s_waitcnt vmcnt(%0)" :: "i"(n) : "memory")
#define SLOAD_H(Kp, Vp, Gp, k0) do { S.st_v0 = load8(ROW(Vp, k0, sr)); S.st_v1 = load8(ROW(Vp, k0, 32 + sr));              \
                         S.st_k0 = load8(ROW(Kp, k0, sr)); S.st_k1 = load8(ROW(Kp, k0, 32 + sr)); S.sg = (Gp)[(k0) + (tid & 63)]; } while (0)
#define SWRITE_HK(bf) do { *(bf16x8*)(K_lds + (bf) * SHM_K + kws) = S.st_k0; *(bf16x8*)(K_lds + (bf) * SHM_K + kws + 32 * 256) = S.st_k1; \
                           if (tid < 64) G_lds[(bf) * 64 + tid] = S.sg; } while (0)
#define SWRITE_HV(bf) do { *(bf16x8*)(V_lds + (bf) * SHM_V + vst0) = S.st_v0; *(bf16x8*)(V_lds + (bf) * SHM_V + vst1) = S.st_v1; } while (0)
#define SWRITE_H(bf) do { SWRITE_HV(bf); SWRITE_HK(bf); } while (0)
__device__ __forceinline__ void prime(const BlockRef& cur, char* lds, Seam& S, int wv) {
    const int tid = otid(wv), wid = __builtin_amdgcn_readfirstlane(tid >> 6), lane = tid & 63, r32 = lane & 31, hi = lane >> 5;
    const int sr = tid >> 4, sc = (tid & 15) * 8, kws = KSWZ(sr, sc * 2); char* K_lds = lds + 2 * SHM_V; float* G_lds = (float*)(lds + OFF_G);
#pragma unroll
    for (int d0 = 0; d0 < 8; ++d0) S.qr[d0] = load8(cur.Q + (size_t)(wid * QBLK + r32) * D + d0 * 16 + hi * 8);
    SLOAD_H(cur.K, cur.V, cur.G, cur.jlo * KVBLK); VMW(); SWRITE_HK(0);
    __syncthreads();
}
__device__ __forceinline__ void block(const BlockRef& cur, const BlockRef& nxt, char* lds, Seam& S, int wv) {
    const int tid = otid(wv), wid = __builtin_amdgcn_readfirstlane(tid >> 6), lane = tid & 63, r32 = lane & 31, hi = lane >> 5;
    const int W = SEQ;
    const int j_hi = (cur.P0 + QB - 1) / KVBLK + 1;
    const int j_lo = cur.jlo, NT = j_hi - j_lo, kbn = nxt.jlo * KVBLK;
    const int qlo = cur.P0 + wid * QBLK, qm = qlo + r32 - 4 * hi;
    char* V_lds = lds; char* K_lds = lds + 2 * SHM_V; float* G_lds = (float*)(lds + OFF_G);
    float* ws = (float*)(lds + OFF_WS) + wid * 64; float* li_l = ws, * al_l = ws + 32;
    float m_reg = -1e30f, l_reg = 0; f32x16 o[4] = {};
    const int sr = tid >> 4, sc = (tid & 15) * 8, vst0 = v_st(sr, sc), vst1 = v_st(32 + sr, sc), kws = KSWZ(sr, sc * 2);
    const int vb0 = (int)(uintptr_t)V_lds + v_rd_base(lane);
    const bf16_t* Kh = cur.K; const bf16_t* Vh = cur.V; const float* Gh = cur.G;
#define RESC(a) do { if (__any((a) < 1.f)) { if (hi == 0) al_l[r32] = (a); asm volatile("s_waitcnt lgkmcnt(0)" ::: "memory");              \
                     _Pragma("unroll") for (int d_ = 0; d_ < 4; ++d_) _Pragma("unroll") for (int r = 0; r < 16; ++r) o[d_][r] *= al_l[crow(r, hi)]; } } while (0)
#define KBASE(t) ((j_lo + (t)) * KVBLK)
#define MASKT(P0_, P1_, t) do { const int kb_ = KBASE(t); if (kb_ + KVBLK - 1 > qlo) mask_tile(P0_, P1_, qm - kb_, (unsigned)W); } while (0)
    constexpr int NQL = 8;
#define SEAM_K0() do { VMWN(NQL); SWRITE_HK(0); SBAR(); } while (0)
    f32x16 pA0, pA1, pB0, pB1; float mnA, mnB, alA, alB; bf16x8 pa0, pa1, pa2, pa3;
    SWRITE_HV(0); SBAR();
    if (NT > 1) SLOAD_H(Kh, Vh, Gh, KBASE(1));
    SBAR(); qkt<0>(pA0, pA1, K_lds, r32, hi, S.qr, G_lds);
    MASKT(pA0, pA1, 0); partialSM(pA0, pA1, m_reg, mnA, alA);
    if (NT > 1) { VMW(); SWRITE_H(1); }
    __syncthreads();
#define HALF_STEP(PX0, PX1, mnX, alX, PY0, PY1, alY, t, KB, VB, SB) do {                                                      \
        SBAR(); qkt<KB>(PX0, PX1, K_lds, r32, hi, S.qr, G_lds + (KB) * 64);                                             \
        finishSM(PY0, PY1, alY, l_reg, pa0, pa1, pa2, pa3); SBAR();                                                           \
        if ((t) + 1 < NT) { SLOAD_H(Kh, Vh, Gh, KBASE((t) + 1)); SBAR(); }                                               \
        pv_tile<VB>(o, vb0, pa0, pa1, pa2, pa3); MASKT(PX0, PX1, (t)); partialSM(PX0, PX1, m_reg, mnX, alX);                                        \
        __syncthreads();                                                                                                      \
        if ((t) + 1 < NT) { VMW(); SWRITE_H(SB); }                                                                          \
        RESC(alX); __syncthreads(); } while (0)
    for (int t = 1; t + 1 < NT; t += 2) {
        HALF_STEP(pB0, pB1, mnB, alB, pA0, pA1, alA, t, 1, 0, 0);
        HALF_STEP(pA0, pA1, mnA, alA, pB0, pB1, alB, t + 1, 0, 1, 1);
    }
    const bool even = (NT & 1) == 0;
    if (even) { SBAR(); qkt<1>(pB0, pB1, K_lds, r32, hi, S.qr, G_lds + 64); SBAR(); }
    SLOAD_H(nxt.K, nxt.V, nxt.G, kbn); SBAR();
#pragma unroll
    for (int d0 = 0; d0 < 8; ++d0) S.qr[d0] = load8(nxt.Q + (size_t)(wid * QBLK + r32) * D + d0 * 16 + hi * 8);
    SBAR();
    finishSM(pA0, pA1, alA, l_reg, pa0, pa1, pa2, pa3); SBAR();
    pv_tile<0>(o, vb0, pa0, pa1, pa2, pa3);
    if (even) { MASKT(pB0, pB1, NT - 1); partialSM(pB0, pB1, m_reg, mnB, alB); __syncthreads(); RESC(alB);
        finishSM(pB0, pB1, alB, l_reg, pa0, pa1, pa2, pa3); SBAR(); pv_tile<1>(o, vb0, pa0, pa1, pa2, pa3); }
    SBAR(); SEAM_K0();
    if (hi == 0) li_l[r32] = l_reg; asm volatile("s_waitcnt lgkmcnt(0)" ::: "memory");
    float rli[16];
#pragma unroll
    for (int r = 0; r < 16; ++r) rli[r] = __builtin_amdgcn_rcpf(li_l[crow(r, hi)]);
    bf16_t* Ow = cur.O + (size_t)(wid * QBLK) * D;
#pragma unroll
    for (int r = 0; r < 16; ++r) { const int orow = crow(r, hi);
#pragma unroll
        for (int d0 = 0; d0 < 4; ++d0) { const float v = o[d0][r] * rli[r];
            const float vn = __shfl_xor(v, 1);
            if ((r32 & 1) == 0) *(unsigned*)(Ow + (size_t)orow * D + d0 * 32 + r32) = cvt_pk_bf16(v, vn); } }
    __syncthreads();
#undef RESC
#undef KBASE
#undef MASKT
#undef SEAM_K0
#undef HALF_STEP
}
#undef ROW
#undef VMW
#undef VMWN
#undef SLOAD_H
#undef SWRITE_HK
#undef SWRITE_HV
#undef SWRITE_H
struct Item { int bh, qb0, qb1; };
__device__ __forceinline__ Item decode(int L) {
    const int c = L & 255, i = L >> 8, xcd = c & 7, cc = c >> 3, gi = (cc & 1) + 2 * i, qb = ((cc >> 1) + 2 * i + (i >> 2)) & 15;
    Item it; it.bh = ((xcd - gi) & 7) * 16 + gi; it.qb0 = qb; it.qb1 = qb; return it;
}
__device__ __forceinline__ BlockRef mkref(const Item& it, int pass, const bf16_t* Q, const bf16_t* K, const bf16_t* V, const float* G, const int* JLO, bf16_t* O, bf16_t* Odummy, bool dummy) {
    const int qb = pass ? it.qb1 : it.qb0; BlockRef r;
    r.Q = Q + ((size_t)it.bh * SEQ + (size_t)qb * QB) * D; r.O = dummy ? Odummy : O + ((size_t)it.bh * SEQ + (size_t)qb * QB) * D;
    r.K = K + (size_t)it.bh * SEQ * D; r.V = V + (size_t)it.bh * SEQ * D; r.G = G + (size_t)it.bh * SEQ; r.P0 = qb * QB; r.jlo = JLO[it.bh * 16 + qb]; return r;
}
__device__ __forceinline__ void phase(char* lds, const bf16_t* Q, const bf16_t* K, const bf16_t* V, const float* G, const int* JLO, bf16_t* O, bf16_t* Odummy, int total, int wv) {
    const int stride = gridDim.x;
    int L = blockIdx.x; if (L >= total) return;
    Item it = decode(L); int pass = 0;
    BlockRef cur = mkref(it, 0, Q, K, V, G, JLO, O, Odummy, false);
    Seam S;
    prime(cur, lds, S, wv);
    for (;;) {
        const bool more_pass = pass == 0 && it.qb1 != it.qb0, more_item = L + stride < total, last = !more_pass && !more_item;
        Item itn = it; int passn = pass + 1, Ln = L;
        if (!more_pass) { passn = 0; Ln = more_item ? L + stride : L; itn = decode(Ln); }
        const BlockRef nxt = last ? cur : mkref(itn, passn, Q, K, V, G, JLO, O, Odummy, false);
        block(cur, nxt, lds, S, wv);
        if (last) break;
        cur = nxt; it = itn; pass = passn; L = Ln;
    }
}
#undef SBAR
}

struct Args {
    const float *x, *c, *mod_w, *mod_b, *norm_g, *a_w_in, *a_lb, *a_onorm_g, *a_w_out, *kv_mod_w, *kv_mod_b, *kv_norm_g, *kv_w, *kv_fb, *k_norm_g, *b_w_in, *b_q_norm_g, *b_w_out;
    float* out; unsigned char* ws; int one, pad;
};

__device__ __forceinline__ void transpose_item(const float* W, int K, int ldw, int N, bf16_t* WT, float* scr, int item, int lane) {
    const int nblk = N / 32, kb = item / nblk, nb = item % nblk, k0 = 64 * kb, n0 = 32 * nb;
#pragma unroll 8
    for (int i = 0; i < 32; ++i) { const int kk = 2 * i + (lane >> 5); scr[kk * 33 + (lane & 31)] = W[(size_t)(k0 + kk) * ldw + n0 + (lane & 31)]; }
    asm volatile("s_waitcnt lgkmcnt(0)" ::: "memory");
    const int c = lane & 7;
#pragma unroll
    for (int j = 0; j < 4; ++j) { const int n = (lane >> 3) + 8 * j; const float* s = scr + (8 * c) * 33 + n;
        u32x4 o; o.x = cvt_pk_bf16(s[0 * 33], s[1 * 33]); o.y = cvt_pk_bf16(s[2 * 33], s[3 * 33]); o.z = cvt_pk_bf16(s[4 * 33], s[5 * 33]); o.w = cvt_pk_bf16(s[6 * 33], s[7 * 33]);
        *(u32x4*)(WT + (size_t)(n0 + n) * K + k0 + 8 * c) = o; }
    asm volatile("s_waitcnt lgkmcnt(0)" ::: "memory");
}

__device__ __forceinline__ void p0_prologue(const Args& a, char* lds, int wv) {
    const int tid = otid(wv), lane = tid & 63, wave = tid >> 6, G = gridDim.x;
    unsigned char* ws = a.ws;
    float* sc = (float*)lds;
    float* red = (float*)(lds + 32768);
    for (int i = tid; i < NB * DM; i += 512) sc[i] = silu_f(a.c[i]);
    __syncthreads();
    for (int cgp = blockIdx.x; cgp < 256; cgp += G) {
        const int n0 = cgp * 32; const float* Wm; const float* bias; float* outp; int ldn, nloc;
        if (n0 < 3072) { Wm = a.mod_w; bias = a.mod_b; outp = (float*)(ws + WS_MOD0); ldn = 3072; nloc = n0; }
        else if (n0 < 6144) { Wm = a.mod_w + (size_t)DM * 3072; bias = a.mod_b + 3072; outp = (float*)(ws + WS_MOD1); ldn = 3072; nloc = n0 - 3072; }
        else { Wm = a.kv_mod_w; bias = a.kv_mod_b; outp = (float*)(ws + WS_KVMOD); ldn = 2048; nloc = n0 - 6144; }
        const int col = lane & 31, ksub = wave * 2 + (lane >> 5);
        float accb[8];
#pragma unroll
        for (int b = 0; b < 8; ++b) accb[b] = 0.f;
#pragma unroll 8
        for (int kk = 0; kk < 64; ++kk) { const int k = ksub * 64 + kk; const float w = Wm[(size_t)k * ldn + nloc + col];
#pragma unroll
            for (int b = 0; b < 8; ++b) accb[b] = fmaf(sc[b * DM + k], w, accb[b]); }
#pragma unroll
        for (int b = 0; b < 8; ++b) red[(ksub * 8 + b) * 32 + col] = accb[b];
        __syncthreads();
        if (tid < 256) { const int b = tid >> 5, cc = tid & 31; float s = bias[nloc + cc];
#pragma unroll
            for (int j = 0; j < 16; ++j) s += red[(j * 8 + b) * 32 + cc];
            outp[(size_t)b * ldn + nloc + cc] = s; }
        __syncthreads();
    }
    const int gtid = blockIdx.x * 512 + tid, NT = G * 512;
    for (int j = gtid; j < WD; j += NT) ((float*)(ws + WS_LB))[j] = 1.f / (1.f + __expf(a.a_lb[WD + j] - a.a_lb[j]));
    for (int i = gtid; i < NH * DM; i += NT) { const int h = i >> 10, k = i & 1023; ((float*)(ws + WS_WFL))[i] = a.kv_w[(size_t)k * 4112 + 4096 + h]; }
    __syncthreads();
    float* scr = (float*)(lds + wave * 16384);
    const int gw = blockIdx.x * 8 + wave, NGW = G * 8;
    constexpr int I1 = 16 * 256, I2 = 32 * 32, I3 = 16 * 128, I4 = 16 * 128, I5 = 32 * 32, NIT = I1 + I2 + I3 + I4 + I5;
    for (int it = gw; it < NIT; it += NGW) {
        int r = it;
        if (r < I1) { transpose_item(a.a_w_in, 1024, 8192, 8192, (bf16_t*)(ws + WS_W1), scr, r, lane); continue; } r -= I1;
        if (r < I2) { transpose_item(a.a_w_out, 2048, 1024, 1024, (bf16_t*)(ws + WS_W2), scr, r, lane); continue; } r -= I2;
        if (r < I3) { transpose_item(a.kv_w, 1024, 4112, 4096, (bf16_t*)(ws + WS_W3KV), scr, r, lane); continue; } r -= I3;
        if (r < I4) { transpose_item(a.b_w_in, 1024, 4096, 4096, (bf16_t*)(ws + WS_W3Q), scr, r, lane); continue; } r -= I4;
        transpose_item(a.b_w_out, 2048, 1024, 1024, (bf16_t*)(ws + WS_W4), scr, r, lane);
    }
}

template <bool FL, bool DUAL>
__device__ __forceinline__ void norm_phase(const float* x, const float* g, const float* shiftp, const float* scalep, int mstride, bf16_t* outp,
                                           const float* g2, const float* shiftp2, const float* scalep2, int mstride2, bf16_t* outp2,
                                           const float* wfl_g, const float* fb, float* LS, char* lds, int wv) {
    const int tid = otid(wv), lane = tid & 63, wave = tid >> 6;
    float* wfl = (float*)lds;
    if (FL) { for (int i = tid; i < NH * DM / 4; i += 512) ((f32x4*)wfl)[i] = ((const f32x4*)wfl_g)[i]; __syncthreads(); }
    const int gw = blockIdx.x * 8 + wave, NGW = gridDim.x * 8, rpw = (((TOK + NGW - 1) / NGW) + 3) & ~3;
    int curb = -1; f32x4 al[4], be[4], al2[4], be2[4];
    for (int i0 = 0; i0 < rpw; i0 += 4) {
        const int m0 = gw * rpw + i0; if (m0 >= TOK) break;
        const int b = m0 >> 12;
        if (b != curb) { curb = b;
#pragma unroll
            for (int j = 0; j < 4; ++j) { const int col = 4 * lane + 256 * j; const f32x4 gg = *(const f32x4*)(g + col), sc = *(const f32x4*)(scalep + (size_t)b * mstride + col);
                al[j] = gg * (sc + 1.f); be[j] = *(const f32x4*)(shiftp + (size_t)b * mstride + col);
                if (DUAL) { const f32x4 gg2 = *(const f32x4*)(g2 + col), sc2 = *(const f32x4*)(scalep2 + (size_t)b * mstride2 + col);
                    al2[j] = gg2 * (sc2 + 1.f); be2[j] = *(const f32x4*)(shiftp2 + (size_t)b * mstride2 + col); } } }
        f32x4 v[4][4];
#pragma unroll
        for (int q = 0; q < 4; ++q) { const f32x4* xr = (const f32x4*)(x + (size_t)(m0 + q) * DM) + lane;
#pragma unroll
            for (int j = 0; j < 4; ++j) v[q][j] = xr[64 * j]; }
#pragma unroll
        for (int q = 0; q < 4; ++q) { float s2 = 0.f;
#pragma unroll
            for (int j = 0; j < 4; ++j) s2 += (v[q][j].x * v[q][j].x + v[q][j].y * v[q][j].y) + (v[q][j].z * v[q][j].z + v[q][j].w * v[q][j].w);
            const float rstd = __builtin_amdgcn_rsqf(wave_sum(s2) * (1.f / DM) + EPS);
            unsigned long long* o8 = (unsigned long long*)(outp + (size_t)(m0 + q) * DM) + lane;
            unsigned long long* o82 = (unsigned long long*)(outp2 + (size_t)(m0 + q) * DM) + lane;
#pragma unroll
            for (int j = 0; j < 4; ++j) { const f32x4 xh = v[q][j] * rstd;
                if (DUAL) { const f32x4 w2 = xh * al2[j] + be2[j];
                    o82[64 * j] = (unsigned long long)cvt_pk_bf16(w2.x, w2.y) | ((unsigned long long)cvt_pk_bf16(w2.z, w2.w) << 32); }
                v[q][j] = xh * al[j] + be[j];
                o8[64 * j] = (unsigned long long)cvt_pk_bf16(v[q][j].x, v[q][j].y) | ((unsigned long long)cvt_pk_bf16(v[q][j].z, v[q][j].w) << 32); } }
        if (FL) {
            float mine[4] = {0.f, 0.f, 0.f, 0.f};
#pragma unroll 2
            for (int h = 0; h < NH; ++h) { f32x4 w[4];
#pragma unroll
                for (int j = 0; j < 4; ++j) w[j] = *(const f32x4*)(wfl + h * DM + 4 * lane + 256 * j);
#pragma unroll
                for (int q = 0; q < 4; ++q) { float p = 0.f;
#pragma unroll
                    for (int j = 0; j < 4; ++j) p += (v[q][j].x * w[j].x + v[q][j].y * w[j].y) + (v[q][j].z * w[j].z + v[q][j].w * w[j].w);
                    p = wave_sum(p); if (lane == h) mine[q] = p; } }
            if (lane < NH) { const float fbv = fb[lane];
#pragma unroll
                for (int q = 0; q < 4; ++q) { const float z = mine[q] + fbv; const float ls = z < 0.f ? z - log1pf(__expf(z)) : -log1pf(__expf(-z));
                    LS[(size_t)(b * NH + lane) * SEQ + ((m0 + q) & (SEQ - 1))] = ls; } }
        }
    }
}

__device__ __forceinline__ void cumsum_phase(float* LS, int* JLO, const float* kg, const float* qg, char* lds, int wv) {
    const int tid = otid(wv), lane = tid & 63, wave = tid >> 6; float* wtot = (float*)lds; float* gl = (float*)(lds + 1024);
    float mk = fmaxf(fabsf(kg[lane]), fabsf(kg[lane + 64])), mq = fmaxf(fabsf(qg[lane]), fabsf(qg[lane + 64]));
#pragma unroll
    for (int o = 1; o < 64; o <<= 1) { mk = fmaxf(mk, __shfl_xor(mk, o)); mq = fmaxf(mq, __shfl_xor(mq, o)); }
    const float TH = (40.f + 2.f * (1.05f * 128.f * 1.4426950408889634f * 0.08838834764831845f * mk * mq)) / (1.4426950408889634f * 0.08838834764831845f);
    for (int bh = blockIdx.x; bh < BH; bh += gridDim.x) {
        float* p = LS + (size_t)bh * SEQ + tid * 8; f32x4 a = *(f32x4*)p, b = *(f32x4*)(p + 4);
        float v[8] = {a.x, a.y, a.z, a.w, b.x, b.y, b.z, b.w};
#pragma unroll
        for (int i = 1; i < 8; ++i) v[i] += v[i - 1];
        float run = v[7];
#pragma unroll
        for (int o = 1; o < 64; o <<= 1) { const float t = __shfl_up(run, o); if (lane >= o) run += t; }
        if (lane == 63) wtot[wave] = run;
        __syncthreads();
        float off = run - v[7];
        for (int w = 0; w < wave; ++w) off += wtot[w];
        const float k = -11.313708498984761f;
        a = (f32x4){(v[0] + off) * k, (v[1] + off) * k, (v[2] + off) * k, (v[3] + off) * k}; b = (f32x4){(v[4] + off) * k, (v[5] + off) * k, (v[6] + off) * k, (v[7] + off) * k};
        *(f32x4*)p = a; *(f32x4*)(p + 4) = b;
        *(f32x4*)(gl + tid * 8) = a; *(f32x4*)(gl + tid * 8 + 4) = b;
        __syncthreads();
#pragma unroll
        for (int rep = 0; rep < 2; ++rep) { const int qb = wave + 8 * rep, P0 = qb * 256;
            const bool skip = (64 * lane + 63 < P0) && (gl[P0] - gl[64 * lane + 63] > TH);
            const unsigned long long mask = __ballot(skip);
            if (lane == 0) JLO[bh * 16 + qb] = __popcll(mask); }
        __syncthreads();
    }
}

__device__ __forceinline__ void p4_scan(const Args& a, char* lds, int dry, int wv, unsigned* prog) {
    const int tid = otid(wv), lane = tid & 63, w = tid >> 6, r = lane & 15, gq = lane >> 4, vg = w & 3, kh = w >> 2;
    unsigned char* ws = a.ws;
    bf16_t* R0 = (bf16_t*)(ws + WS_R0); const bf16_t* R1 = (const bf16_t*)(ws + WS_R1); const bf16_t* R2 = (const bf16_t*)(ws + WS_R2);
    const float* LB = (const float*)(ws + WS_LB);
    constexpr int BUF = 45568, O_QD = 0, O_KT = 17408, O_AT = 35840, O_DL = 45056, O_XS = 2 * BUF, O_PART = O_XS + 32768, O_V = O_PART + 2048;
    typedef short v4i16_t __attribute__((ext_vector_type(4)));
    const LAS char* const vtr0 = (const LAS char*)(LAS unsigned char*)(lds) + O_V + (8 * gq + (r >> 2)) * 272 + (32 * vg + 4 * (r & 3)) * 2;
    const int pk0 = 4 * (tid & 31), prg = tid >> 5, pc0 = 4 * prg;
    bf16_t* const tf = (bf16_t*)(lds + O_V);
    for (int bh = blockIdx.x; bh < BH; bh += gridDim.x) {
        const int h = bh & 15;
        const f32x4 og0 = *(const f32x4*)(a.a_onorm_g + h * HD + 32 * vg + 4 * gq), og1 = *(const f32x4*)(a.a_onorm_g + h * HD + 32 * vg + 16 + 4 * gq);
        const f32x4 lbv4 = *(const f32x4*)(LB + h * HD + pk0), om4 = 1.f - lbv4;
        f32x4 st[4][2];
#pragma unroll
        for (int i = 0; i < 4; ++i) { st[i][0] = (f32x4){0.f, 0.f, 0.f, 0.f}; st[i][1] = (f32x4){0.f, 0.f, 0.f, 0.f}; }
        u32x2 sqA[4], sfA[4], sqB[4], sfB[4]; u32x4 svA[2], svB[2]; bf16x8 vb[2][2];
        char* const xs_own = lds + O_XS + w * 4096 + lane * 16; const char* const xs_par = lds + O_XS + (w ^ 4) * 4096 + lane * 16;
        { const u32x4 z = {0u, 0u, 0u, 0u};
#pragma unroll
          for (int f = 0; f < 4; ++f) *(u32x4*)(xs_own + f * 1024) = z; }
#define P4_LOAD(X, n_) do { const size_t blk_ = ((size_t)bh * SEQ + (size_t)(n_) * 64) * HD; \
            _Pragma("unroll") for (int i = 0; i < 4; ++i) { sq##X[i] = *(const u32x2*)(R0 + blk_ + (size_t)(pc0 + i) * HD + pk0); sf##X[i] = *(const u32x2*)(R1 + blk_ + (size_t)(pc0 + i) * HD + pk0); } \
            _Pragma("unroll") for (int rep = 0; rep < 2; ++rep) { const int i = tid + rep * 512; sv##X[rep] = *(const u32x4*)(R2 + blk_ + (size_t)i * 8); } } while (0)
#define P4_WRITE_V(X) do { _Pragma("unroll") for (int rep = 0; rep < 2; ++rep) { const int i = tid + rep * 512; *(u32x4*)(lds + O_V + (i >> 4) * 272 + (i & 15) * 16) = sv##X[rep]; } } while (0)
#define P4_PACK(DST, ksl, vt) do { u32x4 bw_; bw_.x = cvt_pk_bf16(st[2 * (ksl)][vt][0], st[2 * (ksl)][vt][1]); bw_.y = cvt_pk_bf16(st[2 * (ksl)][vt][2], st[2 * (ksl)][vt][3]); \
            bw_.z = cvt_pk_bf16(st[2 * (ksl) + 1][vt][0], st[2 * (ksl) + 1][vt][1]); bw_.w = cvt_pk_bf16(st[2 * (ksl) + 1][vt][2], st[2 * (ksl) + 1][vt][3]); DST = bw_; } while (0)
#define P4_PREP(X, bf_, PUB) do { char* B_ = lds + (bf_) * BUF; bf16_t* tq = (bf16_t*)(B_ + O_QD); float* part2 = (float*)(B_ + O_AT); \
              \
            float ee[4][4]; f32x4 kq_[4]; f32x4 run = {1.f, 1.f, 1.f, 1.f}; \
            _Pragma("unroll") for (int i = 0; i < 4; ++i) { const u32x2 wz = sf##X[i]; \
                const f32x4 fz = {__uint_as_float(wz.x << 16), __uint_as_float(wz.x & 0xffff0000u), __uint_as_float(wz.y << 16), __uint_as_float(wz.y & 0xffff0000u)}; \
                _Pragma("unroll") for (int j = 0; j < 4; ++j) { const float sg = __builtin_amdgcn_rcpf(1.f + __expf(-fz[j])); const float f = lbv4[j] + om4[j] * sg; run[j] *= f; ee[i][j] = run[j]; kq_[i][j] = 1.f - f; } } \
            *(f32x4*)(part2 + prg * 128 + pk0) = run; \
            __syncthreads(); \
            _Pragma("unroll") for (int ksl = 0; ksl < 2; ++ksl) _Pragma("unroll") for (int vt = 0; vt < 2; ++vt) { u32x4 t_; P4_PACK(t_, ksl, vt); *(u32x4*)(xs_own + (ksl * 2 + vt) * 1024) = t_; } \
            if (tid < 32) { f32x4 pa_ = {1.f, 1.f, 1.f, 1.f};     \
                _Pragma("unroll") for (int g = 0; g < 16; ++g) { f32x4* pp_ = (f32x4*)(part2 + g * 128 + 4 * tid); const f32x4 pg = *pp_; *pp_ = pa_; pa_ = pa_ * pg; } \
                *(f32x4*)(part2 + 16 * 128 + 4 * tid) = pa_; } \
            __syncthreads(); \
            const f32x4 offp = *(const f32x4*)(part2 + prg * 128 + pk0), totp = *(const f32x4*)(part2 + 16 * 128 + pk0); \
            float ks_[4][4]; \
            _Pragma("unroll") for (int i = 0; i < 4; ++i) { const u32x2 wq = sq##X[i]; \
                const f32x4 qv = {__uint_as_float(wq.x << 16), __uint_as_float(wq.x & 0xffff0000u), __uint_as_float(wq.y << 16), __uint_as_float(wq.y & 0xffff0000u)}; f32x4 qd, ki; \
                  \
                const u32x2 wk = {cvt_pk_bf16(kq_[i][0], kq_[i][1]), cvt_pk_bf16(kq_[i][2], kq_[i][3])}; \
                const f32x4 kv = {__uint_as_float(wk.x << 16), __uint_as_float(wk.x & 0xffff0000u), __uint_as_float(wk.y << 16), __uint_as_float(wk.y & 0xffff0000u)}; \
                _Pragma("unroll") for (int j = 0; j < 4; ++j) { const float ea = offp[j] * ee[i][j]; const float ie = __builtin_amdgcn_rcpf(ea); qd[j] = qv[j] * ea; ki[j] = kv[j] * ie; ks_[j][i] = ki[j] * totp[j]; } \
                u32x2 o1, o2; o1.x = cvt_pk_bf16(qd[0], qd[1]); o1.y = cvt_pk_bf16(qd[2], qd[3]); o2.x = cvt_pk_bf16(ki[0], ki[1]); o2.y = cvt_pk_bf16(ki[2], ki[3]); \
                *(u32x2*)(tq + (pc0 + i) * 136 + pk0) = o1; *(u32x2*)(tf + (pc0 + i) * 136 + pk0) = o2; } \
            _Pragma("unroll") for (int j = 0; j < 4; ++j) { u32x2 wk; wk.x = cvt_pk_bf16(ks_[j][0], ks_[j][1]); wk.y = cvt_pk_bf16(ks_[j][2], ks_[j][3]); *(u32x2*)(B_ + O_KT + (pk0 + j) * 144 + pc0 * 2) = wk; } \
            if (prg == 0) *(f32x4*)(B_ + O_DL + pk0 * 4) = totp; \
            __syncthreads(); \
            { const int mt = w >> 1, nt0 = (w & 1) * 2; f32x4 acc2[2] = {{0.f, 0.f, 0.f, 0.f}, {0.f, 0.f, 0.f, 0.f}}; \
              _Pragma("unroll") for (int ks = 0; ks < 4; ++ks) { const bf16x8 Aq = *(const bf16x8*)(tq + (16 * mt + r) * 136 + ks * 32 + gq * 8); \
                  _Pragma("unroll") for (int j = 0; j < 2; ++j) { const bf16x8 Bk = *(const bf16x8*)(tf + (16 * (nt0 + j) + r) * 136 + ks * 32 + gq * 8); \
                      acc2[j] = __builtin_amdgcn_mfma_f32_16x16x32_bf16(Bk, Aq, acc2[j], 0, 0, 0); } }     \
              char* ap = B_ + O_AT; \
              __syncthreads();     \
              _Pragma("unroll") for (int j = 0; j < 2; ++j) { const int c = 16 * mt + r, s0_ = 16 * (nt0 + j) + 4 * gq; \
                  u32x2 wa; wa.x = cvt_pk_bf16(s0_ <= c ? acc2[j][0] : 0.f, s0_ + 1 <= c ? acc2[j][1] : 0.f); wa.y = cvt_pk_bf16(s0_ + 2 <= c ? acc2[j][2] : 0.f, s0_ + 3 <= c ? acc2[j][3] : 0.f); \
                  *(u32x2*)(ap + c * 144 + s0_ * 2) = wa; } } \
            P4_WRITE_V(X); \
            asm volatile("s_waitcnt vmcnt(0)" ::: "memory");     \
            __syncthreads(); \
            if ((PUB) > 0 && tid == 0) __hip_atomic_store(prog + bh * 16, (unsigned)(PUB), __ATOMIC_RELAXED, __HIP_MEMORY_SCOPE_AGENT); } while (0)
#define P4_STEP(n_, CUR, X, Y) do { const char* B = lds + (CUR) * BUF; \
            _Pragma("unroll") for (int vt = 0; vt < 2; ++vt) _Pragma("unroll") for (int cs = 0; cs < 2; ++cs) { \
                const v4i16_t lo_ = __builtin_amdgcn_ds_read_tr16_b64_v4i16((LAS v4i16_t*)(vtr0 + cs * 32 * 272 + vt * 32)); \
                const v4i16_t hi_ = __builtin_amdgcn_ds_read_tr16_b64_v4i16((LAS v4i16_t*)(vtr0 + cs * 32 * 272 + vt * 32 + 4 * 272)); \
                vb[vt][cs] = (bf16x8){lo_[0], lo_[1], lo_[2], lo_[3], hi_[0], hi_[1], hi_[2], hi_[3]}; } \
            P4_LOAD(X, ((n_) + 2 < 64) ? (n_) + 2 : 63); \
            f32x4 oo[2][2]; \
            _Pragma("unroll") for (int ml = 0; ml < 2; ++ml) { oo[ml][0] = (f32x4){0.f, 0.f, 0.f, 0.f}; oo[ml][1] = (f32x4){0.f, 0.f, 0.f, 0.f}; \
                _Pragma("unroll") for (int ks = 0; ks < 2; ++ks) { const bf16x8 Bq = *(const bf16x8*)(B + O_AT + (32 * kh + 16 * ml + r) * 144 + ks * 64 + gq * 16); \
                    _Pragma("unroll") for (int vt = 0; vt < 2; ++vt) oo[ml][vt] = __builtin_amdgcn_mfma_f32_16x16x32_bf16(vb[vt][ks], Bq, oo[ml][vt], 0, 0, 0); } } \
            _Pragma("unroll") for (int hf = 0; hf < 2; ++hf) _Pragma("unroll") for (int ksl = 0; ksl < 2; ++ksl) { const int ksg = 2 * (hf == 0 ? kh : 1 - kh) + ksl; u32x4 sf_[2]; \
                _Pragma("unroll") for (int vt = 0; vt < 2; ++vt) sf_[vt] = *(const u32x4*)((hf == 0 ? (const char*)xs_own : xs_par) + (ksl * 2 + vt) * 1024); \
                _Pragma("unroll") for (int ml = 0; ml < 2; ++ml) { const char* qa = B + O_QD + (32 * kh + 16 * ml + r) * 272 + ksg * 64 + gq * 8; \
                    const u32x2 a0 = *(const u32x2*)qa, a1 = *(const u32x2*)(qa + 32); const u32x4 aw = {a0.x, a0.y, a1.x, a1.y}; \
                    _Pragma("unroll") for (int vt = 0; vt < 2; ++vt) oo[ml][vt] = __builtin_amdgcn_mfma_f32_16x16x32_bf16(__builtin_bit_cast(bf16x8, sf_[vt]), __builtin_bit_cast(bf16x8, aw), oo[ml][vt], 0, 0, 0); } } \
            float* part = (float*)(lds + O_PART) + (CUR) * 256; \
            _Pragma("unroll") for (int ml = 0; ml < 2; ++ml) { float s_ = 0.f; \
                _Pragma("unroll") for (int vt = 0; vt < 2; ++vt) s_ += (oo[ml][vt][0] * oo[ml][vt][0] + oo[ml][vt][1] * oo[ml][vt][1]) + (oo[ml][vt][2] * oo[ml][vt][2] + oo[ml][vt][3] * oo[ml][vt][3]); \
                s_ += __shfl_xor(s_, 16); s_ += __shfl_xor(s_, 32); if (gq == 0) part[(32 * kh + 16 * ml + r) * 4 + vg] = s_; } \
            _Pragma("unroll") for (int i = 0; i < 4; ++i) { const f32x4 dlv = *(const f32x4*)(B + O_DL + (64 * kh + 16 * i + 4 * gq) * 4); st[i][0] = st[i][0] * dlv; st[i][1] = st[i][1] * dlv; \
                _Pragma("unroll") for (int cs = 0; cs < 2; ++cs) { const bf16x8 A = *(const bf16x8*)(B + O_KT + (64 * kh + 16 * i + r) * 144 + cs * 64 + gq * 16); \
                    _Pragma("unroll") for (int vt = 0; vt < 2; ++vt) st[i][vt] = __builtin_amdgcn_mfma_f32_16x16x32_bf16(A, vb[vt][cs], st[i][vt], 0, 0, 0); } } \
            P4_PREP(Y, (CUR) ^ 1, (n_)); \
            { bf16_t* op = R0 + ((size_t)bh * SEQ + (size_t)(n_) * 64) * HD + 32 * vg + 4 * gq; \
              _Pragma("unroll") for (int ml = 0; ml < 2; ++ml) { const int c = 32 * kh + 16 * ml + r; const f32x4 p0 = *(const f32x4*)(part + c * 4); \
                const float rs = __builtin_amdgcn_rsqf(((p0.x + p0.y) + (p0.z + p0.w)) * (1.f / HD) + EPS); \
                const f32x4 ov0 = oo[ml][0] * og0 * rs, ov1 = oo[ml][1] * og1 * rs; u32x2 pk0, pk1; pk0.x = cvt_pk_bf16(ov0[0], ov0[1]); pk0.y = cvt_pk_bf16(ov0[2], ov0[3]); pk1.x = cvt_pk_bf16(ov1[0], ov1[1]); pk1.y = cvt_pk_bf16(ov1[2], ov1[3]); \
                if (!dry) { __hip_atomic_store((unsigned long long*)(op + (size_t)c * HD), __builtin_bit_cast(unsigned long long, pk0), __ATOMIC_RELAXED, __HIP_MEMORY_SCOPE_AGENT); \
                            __hip_atomic_store((unsigned long long*)(op + (size_t)c * HD + 16), __builtin_bit_cast(unsigned long long, pk1), __ATOMIC_RELAXED, __HIP_MEMORY_SCOPE_AGENT); } else asm volatile("" :: "v"(pk0), "v"(pk1)); } } } while (0)
        P4_LOAD(A, 0); P4_LOAD(B, 1);
        __syncthreads();
        P4_PREP(A, 0, 0);
        for (int n = 0; n < 64; n += 2) { P4_STEP(n, 0, A, B); P4_STEP(n + 1, 1, B, A); }
        asm volatile("s_waitcnt vmcnt(0)" ::: "memory");
        __syncthreads();
        if (tid == 0) __hip_atomic_store(prog + bh * 16, 64u, __ATOMIC_RELAXED, __HIP_MEMORY_SCOPE_AGENT);
#undef P4_LOAD
#undef P4_WRITE_V
#undef P4_PREP
#undef P4_PACK
#undef P4_STEP
    }
}

#define XB_TMO      128
#define XB_XCNT(j)  (256  + 64 * (j))
#define XB_XSUB(j)  (1280 + 64 * (j))
#define XB_XGEN(j)  (2304 + 64 * (j))
#define XB_TOP      3328
#define XB_TOPGEN   3392
#define XCD_BAR_WORDS 3456
#define XB_SPIN_CAP (1u << 22)
__device__ __forceinline__ unsigned xb_ld(unsigned* p)              { return __hip_atomic_load(p, __ATOMIC_RELAXED, __HIP_MEMORY_SCOPE_AGENT); }
__device__ __forceinline__ unsigned xb_add(unsigned* p, unsigned v) { return __hip_atomic_fetch_add(p, v, __ATOMIC_RELAXED, __HIP_MEMORY_SCOPE_AGENT); }
__device__ __forceinline__ unsigned xb_xcc_id() { return (unsigned)__builtin_amdgcn_s_getreg((3 << 11) | 20) & 0xFu; }
#define XB_SPIN(cond, bar) do { unsigned _sp = 0; while (cond) { __builtin_amdgcn_s_sleep(1); \
    if ((++_sp & 255u) == 0u) { if (xb_ld(&(bar)[XB_TMO])) break; if (_sp > XB_SPIN_CAP) { atomicAdd(&(bar)[XB_TMO], 1u); break; } } } } while (0)
struct XcdBarrier { unsigned* bar; unsigned x; volatile LAS unsigned* st; };
__device__ __forceinline__ XcdBarrier xcd_barrier_post(unsigned* bar, volatile LAS unsigned* st) {
    XcdBarrier b; b.bar = bar; b.x = xb_xcc_id(); b.st = st;
    if (threadIdx.x == 0) (void)xb_add(&bar[XB_XCNT(b.x)], 1u);
    return b;
}
__device__ __forceinline__ void xcd_barrier_complete(unsigned* bar, unsigned x, unsigned& nloc, unsigned& nx) {
    const unsigned G = gridDim.x * gridDim.y * gridDim.z;
    unsigned sum, cnt, mine, sp = 0u;
    for (;;) {
        sum = 0u; cnt = 0u; mine = 0u;
#pragma unroll
        for (unsigned j = 0; j < 16; ++j) { const unsigned c = xb_ld(&bar[XB_XCNT(j)]); sum += c; cnt += (c > 0u) ? 1u : 0u; mine = (j == x) ? c : mine; }
        if (sum == G) break;
        __builtin_amdgcn_s_sleep(1);
        if ((++sp & 255u) == 0u) { if (xb_ld(&bar[XB_TMO])) break; if (sp > XB_SPIN_CAP) { atomicAdd(&bar[XB_TMO], 1u); break; } }
    }
    nloc = mine > 0u ? mine : 1u; nx = cnt > 0u ? cnt : 1u;
}
__device__ __forceinline__ void xcd_barrier(unsigned* bar_, volatile LAS unsigned* st_, int wv) {
    const int tid0 = otid(wv);
    asm volatile("" : "+s"(bar_));
    XcdBarrier b; b.bar = bar_; b.st = st_; b.x = 0;
    asm volatile("s_waitcnt vmcnt(0)" ::: "memory");
    __syncthreads();
    if (tid0 == 0) {
        unsigned* bar = b.bar; b.x = xb_xcc_id();
        __builtin_amdgcn_s_waitcnt(0);
        unsigned nloc = b.st[0], nx = b.st[1];
        if (nloc == 0u) { xcd_barrier_complete(bar, b.x, nloc, nx); b.st[0] = nloc; b.st[1] = nx; }
        const unsigned old = xb_add(&bar[XB_XSUB(b.x)], 1u);
        const unsigned gen = old / nloc;
        if (old + 1u == (gen + 1u) * nloc) {
            __builtin_amdgcn_fence(__ATOMIC_RELEASE, "agent");
            asm volatile("s_waitcnt vmcnt(0)" ::: "memory");
            const unsigned og = xb_add(&bar[XB_TOP], 1u);
            const unsigned tg = og / nx;
            if (og + 1u == (tg + 1u) * nx) xb_add(&bar[XB_TOPGEN], 1u);
            else XB_SPIN(xb_ld(&bar[XB_TOPGEN]) == tg, bar);
            __builtin_amdgcn_fence(__ATOMIC_ACQUIRE, "agent");
            xb_add(&bar[XB_XGEN(b.x)], 1u);
            asm volatile("s_waitcnt vmcnt(0)" ::: "memory");
        } else {
            XB_SPIN(xb_ld(&bar[XB_XGEN(b.x)]) == gen, bar);
            __builtin_amdgcn_fence(__ATOMIC_ACQUIRE, "agent");
            asm volatile("s_waitcnt vmcnt(0)" ::: "memory");
        }
    }
    __syncthreads();
}

__global__ void __launch_bounds__(512, 2) yoco_fwd(Args a) {
    extern __shared__ __attribute__((aligned(16))) unsigned char lds_raw[];
    char* lds = (char*)lds_raw; LAS unsigned char* ldsl = (LAS unsigned char*)lds_raw;
    cg::grid_group grid = cg::this_grid();
    const int wv = __builtin_amdgcn_readfirstlane((int)threadIdx.x >> 6);
    unsigned char* ws = a.ws;
    bf16_t* R0 = (bf16_t*)(ws + WS_R0); bf16_t* R1 = (bf16_t*)(ws + WS_R1); bf16_t* R2 = (bf16_t*)(ws + WS_R2);
    bf16_t* XA = (bf16_t*)(ws + WS_XA); bf16_t* H0 = (bf16_t*)a.out;
    const float* MOD0 = (const float*)(ws + WS_MOD0); const float* MOD1 = (const float*)(ws + WS_MOD1); const float* KVMOD = (const float*)(ws + WS_KVMOD);
    float* LSG = (float*)(ws + WS_LSG);
    const int G = gridDim.x, c = blockIdx.x;
    constexpr size_t TS = 64 * MiB;

    unsigned* barw = (unsigned*)(ws + WS_SM + 786432);
    volatile LAS unsigned* bst = (volatile LAS unsigned*)(ldsl + 143360);
    if (threadIdx.x == 0) { bst[0] = 0u; bst[1] = 0u; }
    if (a.one == 0) grid.sync();
    (void)xcd_barrier_post(barw, bst);
#define GSYNC() xcd_barrier((unsigned*)(a.ws + WS_SM + 786432), (volatile LAS unsigned*)(ldsl + 143360), wv)
    p0_prologue(a, lds, wv);
    GSYNC();
    norm_phase<false, false>(a.x, a.norm_g, MOD0, MOD0 + 1024, 3072, H0, nullptr, nullptr, nullptr, 0, nullptr, nullptr, nullptr, nullptr, lds, wv);
    GSYNC();
    { pg8::Gemm g{H0, (const bf16_t*)(ws + WS_W1), TOK, 6144, DM, 2048u, 256, (size_t)4096 * 2048}; pg8::StaticOrder S; S.init(TOK, 6144, G, c);
      pg8::EpiHead E{R0, TS}; pg8::gemm_phase(ldsl, g, S, E, wv);
    }
    GSYNC();
    unsigned* prog = (unsigned*)(ws + WS_SM + 819200);
    { pg8::Gemm g{H0, (const bf16_t*)(ws + WS_W1) + (size_t)6144 * DM, TOK, 2048, DM, 2048u, 256, (size_t)4096 * 2048};
      if (G == 256) {
          pg8::EpiMulSiluWait E{R0, prog};
          if (c < 128) { p4_scan(a, lds, 0, wv, prog); pg8::RestOrder S{c}; pg8::gemm_phase(ldsl, g, S, E, wv); }
          else { pg8::EarlyOrder S{c - 128}; pg8::gemm_phase(ldsl, g, S, E, wv); }
      } else {
          p4_scan(a, lds, 0, wv, prog);
          GSYNC();
          { pg8::StaticOrder S; S.init(TOK, 2048, G, c); pg8::EpiMulSilu E{R0}; pg8::gemm_phase(ldsl, g, S, E, wv); }
      } }
    GSYNC();
    { pg8::Gemm g{R0, (const bf16_t*)(ws + WS_W2), TOK, DM, WD, 256u, (size_t)SEQ * 256, (size_t)16 * SEQ * 256}; pg8::StaticOrder S; S.init(TOK, DM, G, c);
      pg8::EpiRes E{a.x, a.out, MOD0 + 2048}; pg8::gemm_phase(ldsl, g, S, E, wv);
    }
    GSYNC();
    norm_phase<true, true>(a.out, a.kv_norm_g, KVMOD, KVMOD + 1024, 2048, R0, a.norm_g + DM, MOD1, MOD1 + 1024, 3072, XA, (const float*)(ws + WS_WFL), a.kv_fb, LSG, lds, wv);
    GSYNC();
    cumsum_phase(LSG, (int*)(ws + WS_SM + 802816), a.k_norm_g, a.b_q_norm_g, lds, wv);
    { pg8::Gemm g{R0, (const bf16_t*)(ws + WS_W3KV), TOK, 4096, DM, 2048u, 256, (size_t)4096 * 2048}; pg8::StaticOrder S; S.init(TOK, 4096, G, c);
      pg8::EpiHeadNorm E{R1, TS, 1, a.k_norm_g, (LAS float*)(ldsl + 131072)}; pg8::gemm_phase(ldsl, g, S, E, wv);
    }
    GSYNC();
    { pg8::Gemm g{XA, (const bf16_t*)(ws + WS_W3Q), TOK, 2048, DM, 2048u, 256, (size_t)4096 * 2048}; pg8::StaticOrder S; S.init(TOK, 2048, G, c);
      pg8::EpiHeadNorm E{R0, TS, 1, a.b_q_norm_g, (LAS float*)(ldsl + 131072)}; pg8::gemm_phase(ldsl, g, S, E, wv); }
    GSYNC();
    att::phase(lds, R0, R1, R2, LSG, (const int*)(ws + WS_SM + 802816), R0, (bf16_t*)(ws + WS_SM + 716800), 2048, wv);
    GSYNC();
    { pg8::Gemm g{XA, (const bf16_t*)(ws + WS_W3G), TOK, 2048, DM, 2048u, 256, (size_t)4096 * 2048}; pg8::StaticOrder S; S.init(TOK, 2048, G, c);
      pg8::EpiMulSilu E{R0}; pg8::gemm_phase(ldsl, g, S, E, wv); }
    GSYNC();
    { pg8::Gemm g{R0, (const bf16_t*)(ws + WS_W4), TOK, DM, WD, 256u, (size_t)SEQ * 256, (size_t)16 * SEQ * 256}; pg8::StaticOrder S; S.init(TOK, DM, G, c);
      pg8::EpiRes E{a.out, a.out, MOD1 + 2048}; pg8::gemm_phase(ldsl, g, S, E, wv); }
}

extern "C" void kernel_launch(void* const* d_in, const int* in_sizes, int n_in, void* d_out, int out_size, void* d_ws, size_t ws_size, hipStream_t stream) {
    static int grid = 0;
    if (grid == 0) {
        int dev = 0, cus = 0, per_cu = 0;
        hipGetDevice(&dev); hipDeviceGetAttribute(&cus, hipDeviceAttributeMultiprocessorCount, dev);
        hipFuncSetAttribute((const void*)yoco_fwd, hipFuncAttributeMaxDynamicSharedMemorySize, LDS_BYTES);
        hipOccupancyMaxActiveBlocksPerMultiprocessor(&per_cu, (const void*)yoco_fwd, 512, LDS_BYTES);
        (void)hipGetLastError();
        if (cus <= 0) cus = 256;
        grid = cus;
        if (per_cu < 1) fprintf(stderr, "kernel_launch: occupancy query reports %d blocks/CU\n", per_cu);
        if (ws_size < 512 * MiB) fprintf(stderr, "kernel_launch: workspace too small (%zu)\n", ws_size);
    }
    if (hipMemsetAsync((char*)d_ws + WS_SM + 786432, 0, 40960, stream) != hipSuccess) fprintf(stderr, "kernel_launch: memset of barrier words failed\n");
    Args a{};
    const float** pp = (const float**)&a;
    for (int i = 0; i < 18; ++i) pp[i] = (const float*)d_in[i];
    a.out = (float*)d_out; a.ws = (unsigned char*)d_ws; a.one = 1;
    void* args[] = {&a};
    hipError_t e = hipLaunchCooperativeKernel((const void*)yoco_fwd, dim3(grid), dim3(512), args, LDS_BYTES, stream);
    if (e != hipSuccess) fprintf(stderr, "cooperative launch failed: %s (grid %d)\n", hipGetErrorString(e), grid);
}
```
